# Optimizing an MI355X kernel written in HIP

```python
import jax, jax.numpy as jnp
from jax import lax
import numpy as np

D_MODEL = 1024
BATCH = 4
SEQ = 8192
DEPTH = 4

N_A = DEPTH // 2
N_B = DEPTH - N_A
N_MEM = 256
HEAD_DIM = 64
RWKV_HEADS = 12
RWKV_DIM = RWKV_HEADS * HEAD_DIM
MEM_HEADS = 4
MEM_DIM = MEM_HEADS * HEAD_DIM
MIX_WIDTH = RWKV_DIM + MEM_DIM
DECAY_LORA = 64
AAA_LORA = 64
MV_LORA = 32
GATE_LORA = 128
RWKV_IN = 3 * RWKV_DIM + DECAY_LORA + AAA_LORA + GATE_LORA
A_IN = RWKV_IN + MEM_DIM
RWKV_SPLITS = (RWKV_DIM, 2 * RWKV_DIM, 3 * RWKV_DIM, 3 * RWKV_DIM + DECAY_LORA,
               3 * RWKV_DIM + DECAY_LORA + AAA_LORA)
MLA_HEADS = 12
QK_NOPE = 64
QK_ROPE = 32
V_HEAD = 64
Q_LORA = 512
KV_LORA = 256
MLA_DIM = MLA_HEADS * V_HEAD
B_IN = Q_LORA + MEM_DIM
FFN_HIDDEN = ((8 * D_MODEL + 3 * 256 - 1) // (3 * 256)) * 256
ROPE_BASE = 10000.0
NORM_EPS = 1e-6
LNX_EPS = 64e-5
Q_BLOCK = 128

kernel_name = 'yoco_rwkv7_mla_memory_trunk'


def rms_norm(x, g, eps=NORM_EPS):
    xf = x.astype(jnp.float32)
    y = xf * lax.rsqrt(jnp.mean(xf * xf, axis=-1, keepdims=True) + eps)
    return (y * g.astype(jnp.float32)).astype(x.dtype)


def token_shift(t):
    return jnp.pad(t, ((0, 0), (1, 0), (0, 0)))[:, :-1]


def l2_normalize(t):
    tf = t.astype(jnp.float32)
    n = jnp.sqrt(jnp.sum(tf * tf, axis=-1, keepdims=True))
    return (tf / jnp.maximum(n, 1e-12)).astype(t.dtype)


def head_group_norm(y, g, b):
    yf = y.astype(jnp.float32)
    mu = jnp.mean(yf, axis=-1, keepdims=True)
    var = jnp.mean(jnp.square(yf - mu), axis=-1, keepdims=True)
    out = (yf - mu) * lax.rsqrt(var + LNX_EPS)
    out = out * g.reshape(RWKV_HEADS, HEAD_DIM).astype(jnp.float32) + b.reshape(RWKV_HEADS, HEAD_DIM).astype(jnp.float32)
    return out.astype(y.dtype)


def swiglu(h, w_gu, w_down):
    gate, up = jnp.split(h @ w_gu, 2, axis=-1)
    return (jax.nn.silu(gate) * up) @ w_down


def rope_tables(positions):
    half = QK_ROPE // 2
    inv_freq = ROPE_BASE ** (-jnp.arange(half, dtype=jnp.float32) / half)
    ang = positions.astype(jnp.float32)[..., None] * inv_freq
    return jnp.cos(ang), jnp.sin(ang)


def rope(t, cos, sin):
    tf = t.astype(jnp.float32)
    t1, t2 = jnp.split(tf, 2, axis=-1)
    return jnp.concatenate([t1 * cos - t2 * sin, t2 * cos + t1 * sin], axis=-1).astype(t.dtype)


def rwkv7_scan(r, decay, k, v, a, b):
    dtype = r.dtype
    bsz, _, nh, n = r.shape
    seqs = tuple(jnp.moveaxis(t.astype(jnp.float32), 1, 0) for t in (r, decay, k, v, a, b))

    def step(state, inp):
        r_t, w_t, k_t, v_t, a_t, b_t = inp
        sa = jnp.einsum('bhvk,bhk->bhv', state, a_t)
        state = (state * w_t[:, :, None, :] + sa[..., None] * b_t[:, :, None, :]
                 + v_t[..., None] * k_t[:, :, None, :])
        return state, jnp.einsum('bhvk,bhk->bhv', state, r_t)

    s0 = jnp.zeros((bsz, nh, n, n), jnp.float32)
    _, ys = lax.scan(step, s0, seqs)
    return jnp.moveaxis(ys, 0, 1).astype(dtype)


def memory_attention(q, mem_n, w_kv):
    bsz, n_mem, _ = mem_n.shape
    mkv = mem_n @ w_kv
    mk = mkv[..., :MEM_DIM].reshape(bsz, n_mem, MEM_HEADS, HEAD_DIM)
    mv = mkv[..., MEM_DIM:].reshape(bsz, n_mem, MEM_HEADS, HEAD_DIM)
    s = jnp.einsum('bshd,bmhd->bhsm', q, mk, preferred_element_type=jnp.float32) * (HEAD_DIM ** -0.5)
    p = jax.nn.softmax(s, axis=-1).astype(mv.dtype)
    o = jnp.einsum('bhsm,bmhd->bshd', p, mv)
    return o.reshape(q.shape[0], q.shape[1], MEM_DIM)


def causal_mla_attention(q_nope, q_rope, k_nope, k_rope, v):
    bsz, s_len, nh, _ = q_nope.shape
    nb = s_len // Q_BLOCK
    key_pos = jnp.arange(s_len)
    scale = (QK_NOPE + QK_ROPE) ** -0.5

    def to_blocks(t):
        return jnp.moveaxis(t.reshape((bsz, nb, Q_BLOCK) + t.shape[2:]), 1, 0)

    def block(args):
        qn, qr, blk = args
        s = (jnp.einsum('bqhd,bkhd->bhqk', qn, k_nope, preferred_element_type=jnp.float32)
             + jnp.einsum('bqhd,bkd->bhqk', qr, k_rope, preferred_element_type=jnp.float32)) * scale
        q_pos = blk * Q_BLOCK + jnp.arange(Q_BLOCK)
        s = jnp.where(key_pos[None, :] <= q_pos[:, None], s, -jnp.inf)
        p = jax.nn.softmax(s, axis=-1).astype(v.dtype)
        return jnp.einsum('bhqk,bkhd->bqhd', p, v)

    out = lax.map(block, (to_blocks(q_nope), to_blocks(q_rope), jnp.arange(nb)))
    return jnp.moveaxis(out, 0, 1).reshape(bsz, s_len, nh * v.shape[-1])


def setup_inputs(seed: int = 0) -> dict:
    key = jax.random.key(seed)
    keys = iter(jax.random.split(key, 64))

    def nrm(shape, scale):
        return jax.random.normal(next(keys), shape, jnp.float32) * scale

    def gain(shape):
        return 1.0 + nrm(shape, 0.02)

    def unif(shape, lo, hi):
        return jax.random.uniform(next(keys), shape, jnp.float32, lo, hi)

    nv = max(N_A - 1, 0)
    qk_up = MLA_HEADS * (QK_NOPE + QK_ROPE)
    kv_up = MLA_HEADS * (QK_NOPE + V_HEAD)
    return {
        'x': nrm((BATCH, SEQ, D_MODEL), 1.0),
        'mem': nrm((BATCH, N_MEM, D_MODEL), 1.0),
        'positions': (jnp.arange(SEQ, dtype=jnp.int32)[None, :]
                      + jax.random.randint(next(keys), (BATCH, 1), 0, 1024, jnp.int32)),
        'mem_norm_g': gain((D_MODEL,)),
        'a_norm1_g': gain((N_A, D_MODEL)),
        'a_w_in': nrm((N_A, D_MODEL, A_IN), D_MODEL ** -0.5),
        'a_shift_mu': unif((N_A, RWKV_IN), 0.0, 1.0),
        'a_decay_up': nrm((N_A, DECAY_LORA, RWKV_DIM), 0.5 * DECAY_LORA ** -0.5),
        'a_decay_bias': unif((N_A, RWKV_DIM), -6.0, 0.5),
        'a_aaa_up': nrm((N_A, AAA_LORA, RWKV_DIM), AAA_LORA ** -0.5),
        'a_aaa_bias': nrm((N_A, RWKV_DIM), 0.1),
        'a_gate_up': nrm((N_A, GATE_LORA, RWKV_DIM), GATE_LORA ** -0.5),
        'a_k_k': 0.85 + nrm((N_A, RWKV_DIM), 0.05),
        'a_k_a': 1.0 + nrm((N_A, RWKV_DIM), 0.05),
        'a_r_k': nrm((N_A, RWKV_HEADS, HEAD_DIM), 0.1),
        'a_lnx_g': gain((N_A, RWKV_DIM)),
        'a_lnx_b': nrm((N_A, RWKV_DIM), 0.02),
        'a_mem_kv': nrm((N_A, D_MODEL, 2 * MEM_DIM), D_MODEL ** -0.5),
        'a_w_out': nrm((N_A, MIX_WIDTH, D_MODEL), MIX_WIDTH ** -0.5),
        'a_norm2_g': gain((N_A, D_MODEL)),
        'a_ffn_gu': nrm((N_A, D_MODEL, 2 * FFN_HIDDEN), D_MODEL ** -0.5),
        'a_ffn_down': nrm((N_A, FFN_HIDDEN, D_MODEL), FFN_HIDDEN ** -0.5),
        'vres_mu': unif((nv, D_MODEL), 0.0, 1.0),
        'vres_down': nrm((nv, D_MODEL, MV_LORA), D_MODEL ** -0.5),
        'vres_up': nrm((nv, MV_LORA, RWKV_DIM), MV_LORA ** -0.5),
        'vres_bias': nrm((nv, RWKV_DIM), 0.1),
        'kv_norm_g': gain((D_MODEL,)),
        'kv_w_down': nrm((D_MODEL, KV_LORA + QK_ROPE), D_MODEL ** -0.5),
        'kv_latent_g': gain((KV_LORA,)),
        'kv_w_up': nrm((KV_LORA, kv_up), KV_LORA ** -0.5),
        'b_norm1_g': gain((N_B, D_MODEL)),
        'b_w_in': nrm((N_B, D_MODEL, B_IN), D_MODEL ** -0.5),
        'b_q_norm_g': gain((N_B, Q_LORA)),
        'b_q_up': nrm((N_B, Q_LORA, qk_up), Q_LORA ** -0.5),
        'b_mem_kv': nrm((N_B, D_MODEL, 2 * MEM_DIM), D_MODEL ** -0.5),
        'b_w_out': nrm((N_B, MIX_WIDTH, D_MODEL), MIX_WIDTH ** -0.5),
        'b_norm2_g': gain((N_B, D_MODEL)),
        'b_ffn_gu': nrm((N_B, D_MODEL, 2 * FFN_HIDDEN), D_MODEL ** -0.5),
        'b_ffn_down': nrm((N_B, FFN_HIDDEN, D_MODEL), FFN_HIDDEN ** -0.5),
        'final_norm_g': gain((D_MODEL,)),
    }


def reference(x, mem, positions, mem_norm_g,
              a_norm1_g, a_w_in, a_shift_mu, a_decay_up, a_decay_bias, a_aaa_up, a_aaa_bias,
              a_gate_up, a_k_k, a_k_a, a_r_k, a_lnx_g, a_lnx_b, a_mem_kv, a_w_out, a_norm2_g,
              a_ffn_gu, a_ffn_down,
              vres_mu, vres_down, vres_up, vres_bias,
              kv_norm_g, kv_w_down, kv_latent_g, kv_w_up,
              b_norm1_g, b_w_in, b_q_norm_g, b_q_up, b_mem_kv, b_w_out, b_norm2_g,
              b_ffn_gu, b_ffn_down,
              final_norm_g):
    bsz, s_len, _ = x.shape

    def heads(t, nh):
        return t.reshape(bsz, s_len, nh, HEAD_DIM)

    mem_n = rms_norm(mem, mem_norm_g)
    cos, sin = rope_tables(positions)
    v_first = None
    k_nope = k_rope = v_mla = None

    for layer in range(DEPTH):
        if layer < N_A:
            i = layer
            h = rms_norm(x, a_norm1_g[i])
            proj = h @ a_w_in[i]
            p_tm, q_mem = proj[..., :RWKV_IN], proj[..., RWKV_IN:]
            p_tm = p_tm + (token_shift(p_tm) - p_tm) * a_shift_mu[i]
            r, k, v, d_lo, a_lo, g_lo = jnp.split(p_tm, RWKV_SPLITS, axis=-1)
            log_w = -jax.nn.softplus(-(a_decay_bias[i] + jnp.tanh(d_lo) @ a_decay_up[i])) - 0.5
            decay = jnp.exp(-jnp.exp(log_w.astype(jnp.float32)))
            lr = jax.nn.sigmoid(a_aaa_bias[i] + a_lo @ a_aaa_up[i])
            gate = jax.nn.sigmoid(g_lo) @ a_gate_up[i]
            if i == 0:
                v_first = v
            else:
                hv = h + (token_shift(h) - h) * vres_mu[i - 1]
                v = v + (v_first - v) * jax.nn.sigmoid(
                    vres_bias[i - 1] + (hv @ vres_down[i - 1]) @ vres_up[i - 1])
            kk = l2_normalize(heads(k * a_k_k[i], RWKV_HEADS))
            k = k * (1.0 + (lr - 1.0) * a_k_a[i])
            rh, kh, vh, lrh = (heads(t, RWKV_HEADS) for t in (r, k, v, lr))
            y = rwkv7_scan(rh, heads(decay, RWKV_HEADS), kh, vh, -kk, kk * lrh)
            y = head_group_norm(y, a_lnx_g[i], a_lnx_b[i])
            y = y + jnp.sum(rh * kh * a_r_k[i], axis=-1, keepdims=True) * vh
            y_mix = y.reshape(bsz, s_len, RWKV_DIM) * gate
            m = memory_attention(heads(q_mem, MEM_HEADS), mem_n, a_mem_kv[i])
            x = x + jnp.concatenate([y_mix, m], axis=-1) @ a_w_out[i]
            x = x + swiglu(rms_norm(x, a_norm2_g[i]), a_ffn_gu[i], a_ffn_down[i])
        else:
            j = layer - N_A
            if j == 0:
                hk = rms_norm(x, kv_norm_g)
                ckr = hk @ kv_w_down
                c_kv = rms_norm(ckr[..., :KV_LORA], kv_latent_g)
                k_rope = rope(ckr[..., KV_LORA:], cos, sin)
                kv = (c_kv @ kv_w_up).reshape(bsz, s_len, MLA_HEADS, QK_NOPE + V_HEAD)
                k_nope, v_mla = kv[..., :QK_NOPE], kv[..., QK_NOPE:]
            h = rms_norm(x, b_norm1_g[j])
            proj = h @ b_w_in[j]
            c_q = rms_norm(proj[..., :Q_LORA], b_q_norm_g[j])
            q_mem = proj[..., Q_LORA:]
            q = (c_q @ b_q_up[j]).reshape(bsz, s_len, MLA_HEADS, QK_NOPE + QK_ROPE)
            q_nope = q[..., :QK_NOPE]
            q_rope = rope(q[..., QK_NOPE:], cos[:, :, None, :], sin[:, :, None, :])
            o = causal_mla_attention(q_nope, q_rope, k_nope, k_rope, v_mla)
            m = memory_attention(heads(q_mem, MEM_HEADS), mem_n, b_mem_kv[j])
            x = x + jnp.concatenate([o, m], axis=-1) @ b_w_out[j]
            x = x + swiglu(rms_norm(x, b_norm2_g[j]), b_ffn_gu[j], b_ffn_down[j])

    return rms_norm(x, final_norm_g)
```

```cpp
#include <hip/hip_runtime.h>
#include <hip/hip_cooperative_groups.h>
#include <cstdio>
#include <cstdint>
namespace cg = cooperative_groups;

typedef unsigned short bf16_t;
typedef short bf16x8 __attribute__((ext_vector_type(8)));
typedef float f32x16 __attribute__((ext_vector_type(16)));
typedef _Float16 h8 __attribute__((ext_vector_type(8)));
typedef unsigned u32x4 __attribute__((ext_vector_type(4)));

constexpr int T = 32768, S = 8192;
constexpr int LDP = 2944;
constexpr int LDS_BYTES = 73728;

constexpr size_t WS_WA = 0;
constexpr size_t WS_WF = WS_WA + 10485760;
constexpr size_t WS_H = WS_WF + 17825792;
constexpr size_t WS_P = WS_H + 67108864;
constexpr size_t WS_Z = WS_P + 192937984;
constexpr size_t ZSZ = 50331648;
constexpr size_t WS_LIN = WS_Z + 4 * ZSZ;
constexpr size_t WS_RK = WS_LIN + 20971520;
constexpr size_t WS_ROPE = WS_RK + 1572864;
constexpr size_t WS_KMEM = WS_ROPE + 4194304;
constexpr size_t WS_VTMEM = WS_KMEM + 524288;
constexpr size_t WS_MEMN = WS_VTMEM + 524288;
constexpr size_t WS_HALO = WS_MEMN + 2097152;
constexpr size_t WS_END = WS_HALO + 1507328;
constexpr size_t WS_KFULL = WS_Z;
constexpr size_t WS_VT = WS_KFULL + 75497472;
constexpr size_t WS_PROJB = WS_VT + 50331648;
constexpr size_t WS_QFULL = WS_P;
constexpr size_t WS_CQ = WS_QFULL + 75497472;
constexpr size_t WS_CKR = WS_CQ + 33554432;
constexpr size_t WS_CKV = WS_CKR + 50331648;
constexpr size_t A_WIN = 0, A_DEC = 3014656, A_AAA = 3063808, A_GATE = 3112960, A_VUP = 3211264, A_MKV = 3260416, A_WOUT = 3784704;
constexpr size_t B_WIN = 0, B_QUP = 786432, B_MKV = 1376256, B_WOUT = 1900544, B_KVD = 2949120, B_KVU = 3342336;
constexpr size_t F_GU = 0, F_DOWN = 5767168;

struct Params { const float* in[40]; float* out; char* ws; int ph_lo, ph_hi; };

__device__ __forceinline__ bf16_t f2bf(float f) { unsigned u = __float_as_uint(f); u += 0x7fffu + ((u >> 16) & 1u); return (bf16_t)(u >> 16); }
__device__ __forceinline__ unsigned pk2(float lo, float hi) { return (unsigned)f2bf(lo) | ((unsigned)f2bf(hi) << 16); }
__device__ __forceinline__ float bflo(unsigned u) { return __uint_as_float(u << 16); }
__device__ __forceinline__ float bfhi(unsigned u) { return __uint_as_float(u & 0xffff0000u); }
__device__ __forceinline__ float bf2f(bf16_t v) { return __uint_as_float((unsigned)v << 16); }
__device__ __forceinline__ float wave_sum(float v) {
#pragma unroll
    for (int o = 32; o; o >>= 1) v += __shfl_xor(v, o);
    return v;
}
template <int CTRL> __device__ __forceinline__ float dppmov(float x) { return __int_as_float(__builtin_amdgcn_update_dpp(0, __float_as_int(x), CTRL, 0xF, 0xF, true)); }
__device__ __forceinline__ float reduce16(float x) {
    x += dppmov<0xB1>(x); x += dppmov<0x4E>(x); x += dppmov<0x141>(x); x += dppmov<0x140>(x); return x;
}
__device__ __forceinline__ int opaque_tid() { int t = threadIdx.x; asm volatile("" : "+v"(t)); return t; }
__device__ __forceinline__ float sigmoidf_(float x) { return 1.f / (1.f + __expf(-x)); }

__device__ void rmsnorm_phase(const float* x, int nrows, const float* g1, bf16_t* o1, const float* g2, bf16_t* o2, float* of) {
    const int tid_ = opaque_tid(), lane = tid_ & 63, gw = blockIdx.x * 4 + (tid_ >> 6), nw = gridDim.x * 4;
    for (int row = gw; row < nrows; row += nw) {
        const float4* xr = (const float4*)(x + (size_t)row * 1024);
        float4 v[4]; float ss = 0.f;
#pragma unroll
        for (int i = 0; i < 4; ++i) { v[i] = xr[lane + 64 * i]; ss += v[i].x * v[i].x + v[i].y * v[i].y + v[i].z * v[i].z + v[i].w * v[i].w; }
        ss = wave_sum(ss);
        const float rs = rsqrtf(ss * (1.f / 1024.f) + 1e-6f);
#pragma unroll
        for (int i = 0; i < 4; ++i) {
            const float4 g = ((const float4*)g1)[lane + 64 * i];
            const float a = v[i].x * rs, b = v[i].y * rs, c = v[i].z * rs, d = v[i].w * rs;
            if (of) { float4 o; o.x = a * g.x; o.y = b * g.y; o.z = c * g.z; o.w = d * g.w; ((float4*)(of + (size_t)row * 1024))[lane + 64 * i] = o; }
            else {
                uint2 w; w.x = pk2(a * g.x, b * g.y); w.y = pk2(c * g.z, d * g.w);
                *(uint2*)(o1 + (size_t)row * 1024 + (lane + 64 * i) * 4) = w;
                if (o2) { const float4 h = ((const float4*)g2)[lane + 64 * i]; uint2 w2; w2.x = pk2(a * h.x, b * h.y); w2.y = pk2(c * h.z, d * h.w);
                    *(uint2*)(o2 + (size_t)row * 1024 + (lane + 64 * i) * 4) = w2; }
            }
        }
    }
}

struct ConvJob { const float* src; int ld; int ncols; int kvalid; bf16_t* dst; int dstK; int ngran; int swiglu; const float* rscale; int rsmode; };
__device__ void run_conv(const ConvJob& j, int& rot, char* smem) {
#ifdef NO_CONV
    return;
#endif

    bf16_t* lds = (bf16_t*)smem;
    const int G = gridDim.x, tid = opaque_tid(), nkt = j.dstK >> 6, units = j.ngran * nkt;
    for (int u = (blockIdx.x + G - rot) % G; u < units; u += G) {
        const int g = u / nkt, kt = u - g * nkt, k0 = kt * 64;
        int col0 = j.swiglu ? ((g & 1) * 2816 + 32 * (g >> 1)) : 32 * g;
        const bool colok = (col0 + 32 <= j.ncols);
#pragma unroll
        for (int i = 0; i < 8; ++i) {
            const int kr = (tid >> 5) + 8 * i, c = tid & 31, k = k0 + kr;
            float v = 0.f;
            if (colok && k < j.kvalid) {
                v = j.src[(size_t)k * j.ld + col0 + c];
                if (j.rsmode == 1) v *= (1.f - j.rscale[k]); else if (j.rsmode == 2) v *= j.rscale[k];
            }
            lds[c * 72 + kr] = f2bf(v);
        }
        __syncthreads();
        { const int c = tid >> 3, kc = (tid & 7) * 8;
          const uint4 w = *(const uint4*)(lds + c * 72 + kc);
          *(uint4*)(j.dst + (size_t)(g * 32 + c) * j.dstK + k0 + kc) = w; }
        __syncthreads();
    }
    rot = (rot + units) % G;
}
__device__ bool get_conv_job(const Params& p, int kind, int L, int idx, ConvJob& c) {
    bf16_t* WA = (bf16_t*)(p.ws + WS_WA); bf16_t* WF = (bf16_t*)(p.ws + WS_WF);
    c.swiglu = 0; c.rscale = nullptr; c.rsmode = 0;
    if (kind == 1) {
        if (idx == 0) { c.src = (L < 2) ? p.in[20] + (size_t)L * 1024 * 5632 : p.in[37] + (size_t)(L - 2) * 1024 * 5632; c.ld = 5632; c.ncols = 5632; c.kvalid = 1024; c.dst = WF + F_GU; c.dstK = 1024; c.ngran = 176; c.swiglu = 1; return true; }
        if (idx == 1) { c.src = (L < 2) ? p.in[21] + (size_t)L * 2816 * 1024 : p.in[38] + (size_t)(L - 2) * 2816 * 1024; c.ld = 1024; c.ncols = 1024; c.kvalid = 2816; c.dst = WF + F_DOWN; c.dstK = 2816; c.ngran = 32; return true; }
        return false;
    }
    if (L < 2) {
        const int i = L;
        switch (idx) {
        case 0: c.src = p.in[5] + (size_t)i * 1024 * 2816; c.ld = 2816; c.ncols = 2816; c.kvalid = 1024; c.dst = WA + A_WIN; c.dstK = 1024; c.ngran = 88; return true;
        case 1: c.src = p.in[7] + (size_t)i * 64 * 768; c.ld = 768; c.ncols = 768; c.kvalid = 64; c.dst = WA + A_DEC; c.dstK = 64; c.ngran = 24; return true;
        case 2: c.src = p.in[9] + (size_t)i * 64 * 768; c.ld = 768; c.ncols = 768; c.kvalid = 64; c.dst = WA + A_AAA; c.dstK = 64; c.ngran = 24; return true;
        case 3: c.src = p.in[11] + (size_t)i * 128 * 768; c.ld = 768; c.ncols = 768; c.kvalid = 128; c.dst = WA + A_GATE; c.dstK = 128; c.ngran = 24; return true;
        case 4: c.src = p.in[17] + (size_t)i * 1024 * 512; c.ld = 512; c.ncols = 512; c.kvalid = 1024; c.dst = WA + A_MKV; c.dstK = 1024; c.ngran = 16; return true;
        case 5: c.src = p.in[18] + (size_t)i * 1024 * 1024; c.ld = 1024; c.ncols = 1024; c.kvalid = 1024; c.dst = WA + A_WOUT; c.dstK = 1024; c.ngran = 32; return true;
        }
        if (i == 0) return false;
        switch (idx) {
        case 6: c.src = p.in[23]; c.ld = 32; c.ncols = 32; c.kvalid = 1024; c.dst = WA + A_WIN + (size_t)2816 * 1024; c.dstK = 1024; c.ngran = 1; c.rscale = p.in[22]; c.rsmode = 1; return true;
        case 7: c.src = p.in[23]; c.ld = 32; c.ncols = 32; c.kvalid = 1024; c.dst = WA + A_WIN + (size_t)2848 * 1024; c.dstK = 1024; c.ngran = 1; c.rscale = p.in[22]; c.rsmode = 2; return true;
        case 8: c.src = p.in[23]; c.ld = 32; c.ncols = 0; c.kvalid = 1024; c.dst = WA + A_WIN + (size_t)2880 * 1024; c.dstK = 1024; c.ngran = 2; return true;
        case 9: c.src = p.in[24]; c.ld = 768; c.ncols = 768; c.kvalid = 32; c.dst = WA + A_VUP; c.dstK = 64; c.ngran = 24; return true;
        }
        return false;
    }
    const int j = L - 2;
    switch (idx) {
    case 0: c.src = p.in[31] + (size_t)j * 1024 * 768; c.ld = 768; c.ncols = 768; c.kvalid = 1024; c.dst = WA + B_WIN; c.dstK = 1024; c.ngran = 24; return true;
    case 1: c.src = p.in[33] + (size_t)j * 512 * 1152; c.ld = 1152; c.ncols = 1152; c.kvalid = 512; c.dst = WA + B_QUP; c.dstK = 512; c.ngran = 36; return true;
    case 2: c.src = p.in[34] + (size_t)j * 1024 * 512; c.ld = 512; c.ncols = 512; c.kvalid = 1024; c.dst = WA + B_MKV; c.dstK = 1024; c.ngran = 16; return true;
    case 3: c.src = p.in[35] + (size_t)j * 1024 * 1024; c.ld = 1024; c.ncols = 1024; c.kvalid = 1024; c.dst = WA + B_WOUT; c.dstK = 1024; c.ngran = 32; return true;
    }
    if (j != 0) return false;
    if (idx == 4) { c.src = p.in[27]; c.ld = 288; c.ncols = 288; c.kvalid = 1024; c.dst = WA + B_KVD; c.dstK = 1024; c.ngran = 12; return true; }
    if (idx == 5) { c.src = p.in[29]; c.ld = 1536; c.ncols = 1536; c.kvalid = 256; c.dst = WA + B_KVU; c.dstK = 256; c.ngran = 48; return true; }
    return false;
}

enum { E_BF16 = 0, E_F32, E_RESID, E_SWIGLU, E_DECAY, E_SIGB, E_KV, E_MEMKV, E_MULG };
struct Epi { void* o0; void* o1; const float* bias; const float* resid; int ldc; bf16_t* halo; };
struct GemmJob { const bf16_t* A; int lda; const bf16_t* W; int K, M, N, kind; Epi e; };

template <int E> __device__ __forceinline__ void epilogue(const f32x16 (&acc)[2][2], int m0, int n0, int wm, int wn, int lane, const Epi& e) {
    const int half = lane >> 5, l31 = lane & 31;
    if (E == E_SWIGLU) {
        bf16_t* o = (bf16_t*)e.o0; const int col = (n0 >> 1) + wn * 32 + l31;
#pragma unroll
        for (int mi = 0; mi < 2; ++mi)
#pragma unroll
            for (int i = 0; i < 16; ++i) {
                const int row = m0 + wm * 64 + mi * 32 + 8 * (i >> 2) + 4 * half + (i & 3);
                const float g = acc[mi][0][i], u = acc[mi][1][i];
                o[(size_t)row * 2816 + col] = f2bf(g * sigmoidf_(g) * u);
            }
        return;
    }
#pragma unroll
    for (int mi = 0; mi < 2; ++mi)
#pragma unroll
        for (int ni = 0; ni < 2; ++ni) {
            const int col = n0 + wn * 64 + ni * 32 + l31;
            const int rbase = m0 + wm * 64 + mi * 32 + 4 * half;
            if (E == E_KV || E == E_MEMKV) {
                const bool isv = (E == E_KV) ? ((col & 127) >= 64) : (col >= 256);
                if (isv) {
#pragma unroll
                    for (int g = 0; g < 4; ++g) {
                        const int row = rbase + 8 * g;
                        uint2 w; w.x = pk2(acc[mi][ni][4 * g], acc[mi][ni][4 * g + 1]); w.y = pk2(acc[mi][ni][4 * g + 2], acc[mi][ni][4 * g + 3]);
                        size_t idx;
                        if (E == E_KV) { const int b = row >> 13, s = row & 8191, head = col >> 7, d = (col & 127) - 64; idx = ((size_t)(b * 12 + head) * 64 + d) * 8192 + s; }
                        else { const int b = row >> 8, mi_ = row & 255, head = (col - 256) >> 6, d = col & 63; idx = ((size_t)(b * 4 + head) * 64 + d) * 256 + mi_; }
                        *(uint2*)((bf16_t*)e.o1 + idx) = w;
                    }
                } else {
#pragma unroll
                    for (int i = 0; i < 16; ++i) {
                        const int row = rbase + 8 * (i >> 2) + (i & 3);
                        size_t idx;
                        if (E == E_KV) { const int b = row >> 13, s = row & 8191, head = col >> 7, c = col & 127; idx = ((size_t)(b * 12 + head) * 8192 + s) * 96 + c; }
                        else { const int b = row >> 8, mi_ = row & 255, head = col >> 6, d = col & 63; idx = ((size_t)(b * 4 + head) * 256 + mi_) * 64 + d; }
                        ((bf16_t*)e.o0)[idx] = f2bf(acc[mi][ni][i]);
                    }
                }
                continue;
            }
            float bias = 0.f;
            if (E == E_DECAY || E == E_SIGB) bias = e.bias[col];
#pragma unroll
            for (int i = 0; i < 16; ++i) {
                const int row = rbase + 8 * (i >> 2) + (i & 3);
                const float v = acc[mi][ni][i];
                const size_t idx = (size_t)row * e.ldc + col;
                if (E == E_BF16) {
                    const bf16_t b = f2bf(v);
                    ((bf16_t*)e.o0)[idx] = b;
                    if (e.halo && (row & 127) == 127) e.halo[(size_t)(row >> 7) * e.ldc + col] = b;
                } else if (E == E_F32) ((float*)e.o0)[idx] = v;
                else if (E == E_RESID) ((float*)e.o0)[idx] = e.resid[idx] + v;
                else if (E == E_DECAY) ((_Float16*)e.o0)[idx] = (_Float16)(0.60653066f * sigmoidf_(bias + v));
                else if (E == E_SIGB) ((bf16_t*)e.o0)[idx] = f2bf(sigmoidf_(bias + v));
                else if (E == E_MULG) { bf16_t* o = (bf16_t*)e.o0; o[idx] = f2bf(bf2f(o[idx]) * v); }
            }
        }
}

__device__ void gemm_job(const GemmJob& gj, int& rot, char* smem) {
    const bf16_t* A = gj.A; const bf16_t* W = gj.W; const int lda = gj.lda, K = gj.K, M = gj.M, N = gj.N; const Epi& e = gj.e;
#ifdef NO_GEMM
    return;
#endif

    const int tid = opaque_tid(), lane = tid & 63, wave = tid >> 6, wm = wave >> 1, wn = wave & 1;
    const int ntn = N >> 7, ntiles = (M >> 7) * ntn, KT = K >> 6, G = gridDim.x;
    bf16_t* sA = (bf16_t*)smem;
    bf16_t* sB = sA + 2 * 128 * 72;
    const int half = lane >> 5, l31 = lane & 31;
    for (int t = (blockIdx.x + G - rot) % G; t < ntiles; t += G) {
        const int tm = t / ntn, tn = t - tm * ntn, m0 = tm << 7, n0 = tn << 7;
        f32x16 acc[2][2];
#pragma unroll
        for (int a = 0; a < 2; ++a)
#pragma unroll
            for (int b = 0; b < 2; ++b)
#pragma unroll
                for (int i = 0; i < 16; ++i) acc[a][b][i] = 0.f;
        u32x4 ra[4], rb[4];
        const bf16_t* Ag = A + (size_t)(m0 + (tid >> 3)) * lda + (tid & 7) * 8;
        const bf16_t* Wg = W + (size_t)(n0 + (tid >> 3)) * K + (tid & 7) * 8;
#pragma unroll
        for (int i = 0; i < 4; ++i) { ra[i] = *(const u32x4*)(Ag + (size_t)(32 * i) * lda); rb[i] = *(const u32x4*)(Wg + (size_t)(32 * i) * K); }
        const int lofs = (tid >> 3) * 72 + (tid & 7) * 8;
#pragma unroll
        for (int i = 0; i < 4; ++i) { *(u32x4*)(sA + lofs + 32 * i * 72) = ra[i]; *(u32x4*)(sB + lofs + 32 * i * 72) = rb[i]; }
        __syncthreads();
        for (int kt = 0; kt < KT; ++kt) {
            const int buf = kt & 1;
            if (kt + 1 < KT) {
#pragma unroll
                for (int i = 0; i < 4; ++i) { ra[i] = *(const u32x4*)(Ag + (size_t)(32 * i) * lda + (kt + 1) * 64); rb[i] = *(const u32x4*)(Wg + (size_t)(32 * i) * K + (kt + 1) * 64); }
            }
            const bf16_t* a_ = sA + buf * 128 * 72 + (wm * 64 + l31) * 72 + half * 8;
            const bf16_t* b_ = sB + buf * 128 * 72 + (wn * 64 + l31) * 72 + half * 8;
#pragma unroll
            for (int kk = 0; kk < 4; ++kk) {
                const bf16x8 a0 = *(const bf16x8*)(a_ + kk * 16), a1 = *(const bf16x8*)(a_ + 32 * 72 + kk * 16);
                const bf16x8 b0 = *(const bf16x8*)(b_ + kk * 16), b1 = *(const bf16x8*)(b_ + 32 * 72 + kk * 16);
                acc[0][0] = __builtin_amdgcn_mfma_f32_32x32x16_bf16(a0, b0, acc[0][0], 0, 0, 0);
                acc[0][1] = __builtin_amdgcn_mfma_f32_32x32x16_bf16(a0, b1, acc[0][1], 0, 0, 0);
                acc[1][0] = __builtin_amdgcn_mfma_f32_32x32x16_bf16(a1, b0, acc[1][0], 0, 0, 0);
                acc[1][1] = __builtin_amdgcn_mfma_f32_32x32x16_bf16(a1, b1, acc[1][1], 0, 0, 0);
            }
            if (kt + 1 < KT) {
                bf16_t* da = sA + (buf ^ 1) * 128 * 72 + lofs; bf16_t* db = sB + (buf ^ 1) * 128 * 72 + lofs;
#pragma unroll
                for (int i = 0; i < 4; ++i) { *(u32x4*)(da + 32 * i * 72) = ra[i]; *(u32x4*)(db + 32 * i * 72) = rb[i]; }
            }
            __syncthreads();
        }
        switch (gj.kind) {
        case E_BF16: epilogue<E_BF16>(acc, m0, n0, wm, wn, lane, e); break;
        case E_F32: epilogue<E_F32>(acc, m0, n0, wm, wn, lane, e); break;
        case E_RESID: epilogue<E_RESID>(acc, m0, n0, wm, wn, lane, e); break;
        case E_SWIGLU: epilogue<E_SWIGLU>(acc, m0, n0, wm, wn, lane, e); break;
        case E_DECAY: epilogue<E_DECAY>(acc, m0, n0, wm, wn, lane, e); break;
        case E_SIGB: epilogue<E_SIGB>(acc, m0, n0, wm, wn, lane, e); break;
        case E_KV: epilogue<E_KV>(acc, m0, n0, wm, wn, lane, e); break;
        case E_MEMKV: epilogue<E_MEMKV>(acc, m0, n0, wm, wn, lane, e); break;
        default: epilogue<E_MULG>(acc, m0, n0, wm, wn, lane, e); break;
        }
    }
    rot = (rot + ntiles) % G;
}

template <int DQK, bool CAUSAL>
__device__ void attn_phase(const bf16_t* Q, int ldq, int qcol0, const bf16_t* Kb, size_t k_bh_stride, const bf16_t* VT, size_t vt_bh_stride, int vt_ld,
                           int nheads, int nkeys, const float* rope, float scl, bf16_t* O, int ldo, int ocol0, int& rot, char* smem) {
#ifdef NO_ATTN
    return;
#endif

    constexpr int KS = DQK + 8, NKK = DQK / 16, KCH = DQK / 8, NKL = (64 * KCH) / 256;
    const int tid = opaque_tid(), lane = tid & 63, wave = tid >> 6, half = lane >> 5, l31 = lane & 31, G = gridDim.x;
    bf16_t* sK = (bf16_t*)smem;
    bf16_t* sV = sK + 2 * 64 * KS;
    const int nbh = 4 * nheads, units = nbh * 64;
    for (int u = (blockIdx.x + G - rot) % G; u < units; u += G) {
        const int qb = 63 - u / nbh, bh = u % nbh, b = bh / nheads, h = bh - b * nheads;
        const int q0 = qb * 128 + wave * 32, q = q0 + l31;
        const size_t tokq = (size_t)b * S + q;
        bf16x8 qf[NKK];
        { const bf16_t* qp = Q + tokq * ldq + qcol0 + h * DQK + half * 8;
#pragma unroll
          for (int kk = 0; kk < NKK; ++kk) qf[kk] = *(const bf16x8*)(qp + kk * 16); }
        if (rope) {
            const float* rp = rope + tokq * 32 + half * 8;
            const float4 c0 = *(const float4*)rp, c1 = *(const float4*)(rp + 4), s0 = *(const float4*)(rp + 16), s1 = *(const float4*)(rp + 20);
            u32x4 qa = __builtin_bit_cast(u32x4, qf[NKK - 2]), qb_ = __builtin_bit_cast(u32x4, qf[NKK - 1]);
#define ROT2(D, CA, SA, CB, SB) { const float x1l = bflo(qa[D]), x1h = bfhi(qa[D]), x2l = bflo(qb_[D]), x2h = bfhi(qb_[D]); \
              qa[D] = pk2(x1l * CA - x2l * SA, x1h * CB - x2h * SB); qb_[D] = pk2(x2l * CA + x1l * SA, x2h * CB + x1h * SB); }
            ROT2(0, c0.x, s0.x, c0.y, s0.y) ROT2(1, c0.z, s0.z, c0.w, s0.w) ROT2(2, c1.x, s1.x, c1.y, s1.y) ROT2(3, c1.z, s1.z, c1.w, s1.w)
#undef ROT2
            qf[NKK - 2] = __builtin_bit_cast(bf16x8, qa); qf[NKK - 1] = __builtin_bit_cast(bf16x8, qb_);
        }
        const int ntiles = CAUSAL ? (qb * 2 + 2) : (nkeys >> 6);
        f32x16 o[2];
#pragma unroll
        for (int a = 0; a < 2; ++a)
#pragma unroll
            for (int i = 0; i < 16; ++i) o[a][i] = 0.f;
        float m = -1e30f, l = 0.f;
        const bf16_t* Kg = Kb + (size_t)bh * k_bh_stride;
        const bf16_t* Vg = VT + (size_t)bh * vt_bh_stride + (size_t)(tid >> 3) * vt_ld + (tid & 7) * 8;
        u32x4 rk[NKL], rv[2];
#pragma unroll
        for (int i = 0; i < NKL; ++i) rk[i] = *(const u32x4*)(Kg + (size_t)(tid + 256 * i) * 8);
#pragma unroll
        for (int i = 0; i < 2; ++i) rv[i] = *(const u32x4*)(Vg + (size_t)(32 * i) * vt_ld);
#pragma unroll
        for (int i = 0; i < NKL; ++i) { const int c = tid + 256 * i; *(u32x4*)(sK + (c / KCH) * KS + (c % KCH) * 8) = rk[i]; }
#pragma unroll
        for (int i = 0; i < 2; ++i) *(u32x4*)(sV + ((tid >> 3) + 32 * i) * 72 + (tid & 7) * 8) = rv[i];
        __syncthreads();
        for (int kt = 0; kt < ntiles; ++kt) {
            const int buf = kt & 1;
            if (kt + 1 < ntiles) {
#pragma unroll
                for (int i = 0; i < NKL; ++i) rk[i] = *(const u32x4*)(Kg + (size_t)(kt + 1) * 64 * DQK + (size_t)(tid + 256 * i) * 8);
#pragma unroll
                for (int i = 0; i < 2; ++i) rv[i] = *(const u32x4*)(Vg + (size_t)(32 * i) * vt_ld + (kt + 1) * 64);
            }
            if (!CAUSAL || kt * 64 <= q0 + 31) {
                const bf16_t* kb_ = sK + buf * 64 * KS + l31 * KS + half * 8;
                f32x16 s[2];
#pragma unroll
                for (int kb = 0; kb < 2; ++kb) {
#pragma unroll
                    for (int i = 0; i < 16; ++i) s[kb][i] = 0.f;
#pragma unroll
                    for (int kk = 0; kk < NKK; ++kk) {
                        const bf16x8 kf = *(const bf16x8*)(kb_ + kb * 32 * KS + kk * 16);
                        s[kb] = __builtin_amdgcn_mfma_f32_32x32x16_bf16(kf, qf[kk], s[kb], 0, 0, 0);
                    }
                }
                if (CAUSAL && kt * 64 + 63 > q0) {
#pragma unroll
                    for (int kb = 0; kb < 2; ++kb)
#pragma unroll
                        for (int i = 0; i < 16; ++i) { const int key = kt * 64 + kb * 32 + 8 * (i >> 2) + 4 * half + (i & 3); if (key > q) s[kb][i] = -1e30f; }
                }
                float mx = s[0][0];
#pragma unroll
                for (int kb = 0; kb < 2; ++kb)
#pragma unroll
                    for (int i = 0; i < 16; ++i) mx = fmaxf(mx, s[kb][i]);
                mx = fmaxf(mx, __shfl_xor(mx, 32));
                const float mn = fmaxf(m, mx), alpha = exp2f((m - mn) * scl), mc = mn * scl;
                m = mn;
                float ls = 0.f;
#pragma unroll
                for (int kb = 0; kb < 2; ++kb)
#pragma unroll
                    for (int i = 0; i < 16; ++i) { const float pv = exp2f(s[kb][i] * scl - mc); s[kb][i] = pv; ls += pv; }
                l = l * alpha + ls;
#pragma unroll
                for (int a = 0; a < 2; ++a)
#pragma unroll
                    for (int i = 0; i < 16; ++i) o[a][i] *= alpha;
                const bf16_t* vb_ = sV + buf * 64 * 72 + l31 * 72 + 4 * half;
#pragma unroll
                for (int kb = 0; kb < 2; ++kb)
#pragma unroll
                    for (int g = 0; g < 2; ++g) {
                        u32x4 pu;
#pragma unroll
                        for (int j = 0; j < 4; ++j) pu[j] = pk2(s[kb][8 * g + 2 * j], s[kb][8 * g + 2 * j + 1]);
                        const bf16x8 pf = __builtin_bit_cast(bf16x8, pu);
#pragma unroll
                        for (int db = 0; db < 2; ++db) {
                            const bf16_t* vp = vb_ + db * 32 * 72 + kb * 32 + 16 * g;
                            const uint2 d0 = *(const uint2*)vp, d1 = *(const uint2*)(vp + 8);
                            u32x4 vu; vu[0] = d0.x; vu[1] = d0.y; vu[2] = d1.x; vu[3] = d1.y;
                            o[db] = __builtin_amdgcn_mfma_f32_32x32x16_bf16(__builtin_bit_cast(bf16x8, vu), pf, o[db], 0, 0, 0);
                        }
                    }
            }
            if (kt + 1 < ntiles) {
                bf16_t* dk = sK + (buf ^ 1) * 64 * KS; bf16_t* dv = sV + (buf ^ 1) * 64 * 72;
#pragma unroll
                for (int i = 0; i < NKL; ++i) { const int c = tid + 256 * i; *(u32x4*)(dk + (c / KCH) * KS + (c % KCH) * 8) = rk[i]; }
#pragma unroll
                for (int i = 0; i < 2; ++i) *(u32x4*)(dv + ((tid >> 3) + 32 * i) * 72 + (tid & 7) * 8) = rv[i];
            }
            __syncthreads();
        }
        l += __shfl_xor(l, 32);
        const float inv = 1.f / l;
        bf16_t* op = O + tokq * ldo + ocol0 + h * 64 + 4 * half;
#pragma unroll
        for (int db = 0; db < 2; ++db)
#pragma unroll
            for (int g = 0; g < 4; ++g) {
                uint2 w; w.x = pk2(o[db][4 * g] * inv, o[db][4 * g + 1] * inv); w.y = pk2(o[db][4 * g + 2] * inv, o[db][4 * g + 3] * inv);
                *(uint2*)(op + db * 32 + 8 * g) = w;
            }
    }
    rot = (rot + units) % G;
}

__device__ void lora_in_phase(const Params& p, int layer) {
#ifdef NO_LIN
    return;
#endif

    const bf16_t* P = (const bf16_t*)(p.ws + WS_P); bf16_t* LIN = (bf16_t*)(p.ws + WS_LIN);
    const float* mu = p.in[6] + (size_t)layer * 2560 + 2304;
    const int tid_ = opaque_tid(), lane = tid_ & 63, gw = blockIdx.x * 4 + (tid_ >> 6), nw = gridDim.x * 4;
    const float4 m4 = *(const float4*)(mu + lane * 4);
    for (int tok = gw; tok < T; tok += nw) {
        const int s = tok & (S - 1);
        const uint2 c = *(const uint2*)(P + (size_t)tok * LDP + 2304 + lane * 4);
        uint2 pv; pv.x = 0; pv.y = 0;
        if (s) pv = *(const uint2*)(P + (size_t)(tok - 1) * LDP + 2304 + lane * 4);
        float v0 = bflo(c.x), v1 = bfhi(c.x), v2 = bflo(c.y), v3 = bfhi(c.y);
        v0 += (bflo(pv.x) - v0) * m4.x; v1 += (bfhi(pv.x) - v1) * m4.y; v2 += (bflo(pv.y) - v2) * m4.z; v3 += (bfhi(pv.y) - v3) * m4.w;
        if (lane < 16) { v0 = tanhf(v0); v1 = tanhf(v1); v2 = tanhf(v2); v3 = tanhf(v3); }
        else if (lane >= 32) { v0 = sigmoidf_(v0); v1 = sigmoidf_(v1); v2 = sigmoidf_(v2); v3 = sigmoidf_(v3); }
        uint2 w; w.x = pk2(v0, v1); w.y = pk2(v2, v3);
        *(uint2*)(LIN + (size_t)tok * 320 + lane * 4) = w;
        if (layer == 1) {
            float vd = 0.f;
            if (lane < 32) { vd = bf2f(P[(size_t)tok * LDP + 2816 + lane]); if (s) vd += bf2f(P[(size_t)(tok - 1) * LDP + 2848 + lane]); }
            LIN[(size_t)tok * 320 + 256 + lane] = f2bf(vd);
        }
    }
}

__device__ void prep_phase(const Params& p, int layer) {
#ifdef NO_PREP
    return;
#endif

    bf16_t* P = (bf16_t*)(p.ws + WS_P);
    bf16_t* Z2 = (bf16_t*)(p.ws + WS_Z + ZSZ);
    bf16_t* Z3 = (bf16_t*)(p.ws + WS_Z + 2 * ZSZ);
    bf16_t* Z4 = (bf16_t*)(p.ws + WS_Z + 3 * ZSZ);
    const bf16_t* HALO = (const bf16_t*)(p.ws + WS_HALO);
    float* RK = (float*)(p.ws + WS_RK);
    const float* mu = p.in[6] + (size_t)layer * 2560;
    const float* kkw = p.in[12] + (size_t)layer * 768; const float* kaw = p.in[13] + (size_t)layer * 768; const float* rkw = p.in[14] + (size_t)layer * 768;
    const int tid = opaque_tid(), tokl = tid >> 4, cg4 = (tid & 15) * 4;
    for (int u = blockIdx.x; u < 256 * 12; u += gridDim.x) {
        const int mt = u / 12, h = u - mt * 12, m0 = mt * 128, hc = h * 64 + cg4;
        const float4 mur = *(const float4*)(mu + hc), muk = *(const float4*)(mu + 768 + hc), muv = *(const float4*)(mu + 1536 + hc);
        const float4 kkw4 = *(const float4*)(kkw + hc), kaw4 = *(const float4*)(kaw + hc), rkw4 = *(const float4*)(rkw + hc);
        for (int it = 7; it >= 0; --it) {
            const int tok = m0 + it * 16 + tokl, s = tok & (S - 1);
            bf16_t* pr = P + (size_t)tok * LDP + hc;
            const uint2 cr = *(const uint2*)pr, ck = *(const uint2*)(pr + 768), cv = *(const uint2*)(pr + 1536);
            uint2 qr, qk, qv; qr.x = qr.y = qk.x = qk.y = qv.x = qv.y = 0;
            if (s) {
                const bf16_t* pp = (it == 0 && tokl == 0) ? (HALO + (size_t)(mt - 1) * LDP + hc) : (P + (size_t)(tok - 1) * LDP + hc);
                qr = *(const uint2*)pp; qk = *(const uint2*)(pp + 768); qv = *(const uint2*)(pp + 1536);
            }
            const size_t zi = (size_t)tok * 768 + hc;
            const uint2 lr2 = *(const uint2*)(Z2 + zi);
            uint2 vs2, vf2; vs2.x = vs2.y = vf2.x = vf2.y = 0;
            if (layer == 1) { vs2 = *(const uint2*)(Z3 + zi); vf2 = *(const uint2*)(Z4 + zi); }
            __syncthreads();
            float r[4] = {bflo(cr.x), bfhi(cr.x), bflo(cr.y), bfhi(cr.y)}, k[4] = {bflo(ck.x), bfhi(ck.x), bflo(ck.y), bfhi(ck.y)}, v[4] = {bflo(cv.x), bfhi(cv.x), bflo(cv.y), bfhi(cv.y)};
            const float rp[4] = {bflo(qr.x), bfhi(qr.x), bflo(qr.y), bfhi(qr.y)}, kp[4] = {bflo(qk.x), bfhi(qk.x), bflo(qk.y), bfhi(qk.y)}, vp[4] = {bflo(qv.x), bfhi(qv.x), bflo(qv.y), bfhi(qv.y)};
            const float mr[4] = {mur.x, mur.y, mur.z, mur.w}, mk[4] = {muk.x, muk.y, muk.z, muk.w}, mv[4] = {muv.x, muv.y, muv.z, muv.w};
            const float lr[4] = {bflo(lr2.x), bfhi(lr2.x), bflo(lr2.y), bfhi(lr2.y)};
            const float vs[4] = {bflo(vs2.x), bfhi(vs2.x), bflo(vs2.y), bfhi(vs2.y)}, vf[4] = {bflo(vf2.x), bfhi(vf2.x), bflo(vf2.y), bfhi(vf2.y)};
            const float kkw_[4] = {kkw4.x, kkw4.y, kkw4.z, kkw4.w}, kaw_[4] = {kaw4.x, kaw4.y, kaw4.z, kaw4.w}, rkw_[4] = {rkw4.x, rkw4.y, rkw4.z, rkw4.w};
            float kk[4], n2 = 0.f, rks = 0.f, bb[4];
#pragma unroll
            for (int j = 0; j < 4; ++j) {
                r[j] += (rp[j] - r[j]) * mr[j]; k[j] += (kp[j] - k[j]) * mk[j]; v[j] += (vp[j] - v[j]) * mv[j];
                if (layer == 1) v[j] += (vf[j] - v[j]) * vs[j];
                kk[j] = k[j] * kkw_[j]; n2 += kk[j] * kk[j];
                k[j] = k[j] * (1.f + (lr[j] - 1.f) * kaw_[j]);
                rks += r[j] * k[j] * rkw_[j];
            }
            n2 = reduce16(n2); rks = reduce16(rks);
            const float inv = 1.f / fmaxf(sqrtf(n2), 1e-12f);
#pragma unroll
            for (int j = 0; j < 4; ++j) { kk[j] *= inv; bb[j] = kk[j] * lr[j]; }
            uint2 w;
            w.x = pk2(r[0], r[1]); w.y = pk2(r[2], r[3]); *(uint2*)pr = w;
            w.x = pk2(k[0], k[1]); w.y = pk2(k[2], k[3]); *(uint2*)(pr + 768) = w;
            w.x = pk2(v[0], v[1]); w.y = pk2(v[2], v[3]); *(uint2*)(pr + 1536) = w;
            if (layer == 0) *(uint2*)(Z4 + zi) = w;
            w.x = pk2(bb[0], bb[1]); w.y = pk2(bb[2], bb[3]); *(uint2*)(Z2 + zi) = w;
            w.x = pk2(kk[0], kk[1]); w.y = pk2(kk[2], kk[3]); *(uint2*)(Z3 + zi) = w;
            if ((tid & 15) == 0) RK[(size_t)tok * 12 + h] = rks;
        }
        __syncthreads();
    }
}

__device__ void scan_phase(const Params& p, char* smem) {
#ifdef NO_SCAN
    return;
#endif

    const bf16_t* P = (const bf16_t*)(p.ws + WS_P);
    const _Float16* E = (const _Float16*)(p.ws + WS_Z);
    const bf16_t* Bv = (const bf16_t*)(p.ws + WS_Z + ZSZ);
    const bf16_t* KK = (const bf16_t*)(p.ws + WS_Z + 2 * ZSZ);
    bf16_t* Y = (bf16_t*)(p.ws + WS_H);
    float* sW = (float*)smem; float* sK = sW + 2048; float* sA = sK + 2048; float* sB = sA + 2048; float* sR = sB + 2048; float* sV = sR + 2048; float* sY = sV + 512;
    const int tid = opaque_tid(), lane = tid & 63, wave = tid >> 6, row = wave * 4 + (lane >> 4), kg = lane & 15;
    const int st_l = tid >> 3, c8 = (tid & 7) * 8;
    for (int u = blockIdx.x; u < 192; u += gridDim.x) {
        const int b = u / 48, h = (u % 48) >> 2, qt = u & 3;
        const size_t tok0 = (size_t)b * S;
        float S0 = 0.f, S1 = 0.f, S2 = 0.f, S3 = 0.f;
        uint4 gr, gk, ga, gb, gv; h8 ge;
        gv.x = gv.y = gv.z = gv.w = 0;
        auto gload = [&](int ch) {
            const size_t tok = tok0 + ch * 32 + st_l;
            gr = *(const uint4*)(P + tok * LDP + h * 64 + c8);
            gk = *(const uint4*)(P + tok * LDP + 768 + h * 64 + c8);
            ga = *(const uint4*)(KK + tok * 768 + h * 64 + c8);
            gb = *(const uint4*)(Bv + tok * 768 + h * 64 + c8);
            ge = *(const h8*)(E + tok * 768 + h * 64 + c8);
            if (tid < 64) { const size_t tk = tok0 + ch * 32 + (tid >> 1); gv = *(const uint4*)(P + tk * LDP + 1536 + h * 64 + qt * 16 + (tid & 1) * 8); }
        };
        auto st4 = [&](float* dst, const uint4& g) {
            float4 a, c; a.x = bflo(g.x); a.y = bfhi(g.x); a.z = bflo(g.y); a.w = bfhi(g.y); c.x = bflo(g.z); c.y = bfhi(g.z); c.z = bflo(g.w); c.w = bfhi(g.w);
            *(float4*)dst = a; *(float4*)(dst + 4) = c;
        };
        gload(0);
        for (int ch = 0; ch < 256; ++ch) {
            {
                const int o = st_l * 64 + c8;
                st4(sR + o, gr); st4(sK + o, gk); st4(sA + o, ga); st4(sB + o, gb);
                float4 a, c; a.x = __expf(-(float)ge[0]); a.y = __expf(-(float)ge[1]); a.z = __expf(-(float)ge[2]); a.w = __expf(-(float)ge[3]);
                c.x = __expf(-(float)ge[4]); c.y = __expf(-(float)ge[5]); c.z = __expf(-(float)ge[6]); c.w = __expf(-(float)ge[7]);
                *(float4*)(sW + o) = a; *(float4*)(sW + o + 4) = c;
                if (tid < 64) st4(sV + (tid >> 1) * 16 + (tid & 1) * 8, gv);
            }
            __syncthreads();
            if (ch + 1 < 256) gload(ch + 1);
#pragma unroll 4
            for (int st = 0; st < 32; ++st) {
                const float4 w4 = *(const float4*)(sW + st * 64 + kg * 4), k4 = *(const float4*)(sK + st * 64 + kg * 4), a4 = *(const float4*)(sA + st * 64 + kg * 4);
                const float4 b4 = *(const float4*)(sB + st * 64 + kg * 4), r4 = *(const float4*)(sR + st * 64 + kg * 4);
                const float v = sV[st * 16 + row];
                float d = (S0 * a4.x + S1 * a4.y) + (S2 * a4.z + S3 * a4.w);
                d = reduce16(d);
                const float sa = -d;
                S0 = S0 * w4.x + (sa * b4.x + v * k4.x); S1 = S1 * w4.y + (sa * b4.y + v * k4.y);
                S2 = S2 * w4.z + (sa * b4.z + v * k4.z); S3 = S3 * w4.w + (sa * b4.w + v * k4.w);
                float yv = (S0 * r4.x + S1 * r4.y) + (S2 * r4.z + S3 * r4.w);
                yv = reduce16(yv);
                if (kg == 0) sY[st * 16 + row] = yv;
            }
            __syncthreads();
            if (tid < 64) {
                const float* yp = sY + (tid >> 1) * 16 + (tid & 1) * 8;
                const float4 a = *(const float4*)yp, c = *(const float4*)(yp + 4);
                uint4 w; w.x = pk2(a.x, a.y); w.y = pk2(a.z, a.w); w.z = pk2(c.x, c.y); w.w = pk2(c.z, c.w);
                *(uint4*)(Y + (tok0 + ch * 32 + (tid >> 1)) * 1024 + h * 64 + qt * 16 + (tid & 1) * 8) = w;
            }
        }
        __syncthreads();
    }
}

__device__ void post_phase(const Params& p, int layer) {
#ifdef NO_POST
    return;
#endif

    bf16_t* H = (bf16_t*)(p.ws + WS_H); const bf16_t* P = (const bf16_t*)(p.ws + WS_P); const float* RK = (const float*)(p.ws + WS_RK);
    const float* lg = p.in[15] + (size_t)layer * 768; const float* lb = p.in[16] + (size_t)layer * 768;
    const int tid = opaque_tid(), cg4 = (tid & 15) * 4;
    const int npairs = T * 12;
    for (int pr = blockIdx.x * 16 + (tid >> 4); pr < npairs; pr += gridDim.x * 16) {
        const int tok = pr / 12, h = pr - tok * 12, hc = h * 64 + cg4;
        bf16_t* yp = H + (size_t)tok * 1024 + hc;
        const uint2 y2 = *(const uint2*)yp, v2 = *(const uint2*)(P + (size_t)tok * LDP + 1536 + hc);
        const float y[4] = {bflo(y2.x), bfhi(y2.x), bflo(y2.y), bfhi(y2.y)}, v[4] = {bflo(v2.x), bfhi(v2.x), bflo(v2.y), bfhi(v2.y)};
        const float mean = reduce16((y[0] + y[1]) + (y[2] + y[3])) * (1.f / 64.f);
        float q = 0.f;
#pragma unroll
        for (int j = 0; j < 4; ++j) { const float d = y[j] - mean; q += d * d; }
        const float rstd = rsqrtf(reduce16(q) * (1.f / 64.f) + 64e-5f);
        const float rk = RK[(size_t)tok * 12 + h];
        const float4 g4 = *(const float4*)(lg + hc), b4 = *(const float4*)(lb + hc);
        const float g[4] = {g4.x, g4.y, g4.z, g4.w}, bb[4] = {b4.x, b4.y, b4.z, b4.w};
        float o[4];
#pragma unroll
        for (int j = 0; j < 4; ++j) o[j] = (y[j] - mean) * rstd * g[j] + bb[j] + rk * v[j];
        uint2 w; w.x = pk2(o[0], o[1]); w.y = pk2(o[2], o[3]);
        *(uint2*)yp = w;
    }
}

__device__ void subnorm_phase(const Params& p, int j) {
#ifdef NO_SUB
    return;
#endif

    const bf16_t* PB = (const bf16_t*)(p.ws + WS_PROJB); bf16_t* CQ = (bf16_t*)(p.ws + WS_CQ);
    const float* CKR = (const float*)(p.ws + WS_CKR); bf16_t* CKV = (bf16_t*)(p.ws + WS_CKV); bf16_t* KF = (bf16_t*)(p.ws + WS_KFULL);
    const float* rope = (const float*)(p.ws + WS_ROPE);
    const float* gq = p.in[32] + (size_t)j * 512; const float* gl = p.in[28];
    const int tid_ = opaque_tid(), lane = tid_ & 63, gw = blockIdx.x * 4 + (tid_ >> 6), nw = gridDim.x * 4;
    for (int tok = gw; tok < T; tok += nw) {
        {
            const uint4 c = *(const uint4*)(PB + (size_t)tok * 768 + lane * 8);
            float v[8] = {bflo(c.x), bfhi(c.x), bflo(c.y), bfhi(c.y), bflo(c.z), bfhi(c.z), bflo(c.w), bfhi(c.w)};
            float ss = 0.f;
#pragma unroll
            for (int i = 0; i < 8; ++i) ss += v[i] * v[i];
            ss = wave_sum(ss);
            const float rs = rsqrtf(ss * (1.f / 512.f) + 1e-6f);
            const float4 g0 = *(const float4*)(gq + lane * 8), g1 = *(const float4*)(gq + lane * 8 + 4);
            uint4 w; w.x = pk2(v[0] * rs * g0.x, v[1] * rs * g0.y); w.y = pk2(v[2] * rs * g0.z, v[3] * rs * g0.w);
            w.z = pk2(v[4] * rs * g1.x, v[5] * rs * g1.y); w.w = pk2(v[6] * rs * g1.z, v[7] * rs * g1.w);
            *(uint4*)(CQ + (size_t)tok * 512 + lane * 8) = w;
        }
        if (j == 0) {
            const float4 c = *(const float4*)(CKR + (size_t)tok * 384 + lane * 4);
            float ss = c.x * c.x + c.y * c.y + c.z * c.z + c.w * c.w;
            ss = wave_sum(ss);
            const float rs = rsqrtf(ss * (1.f / 256.f) + 1e-6f);
            const float4 g = *(const float4*)(gl + lane * 4);
            uint2 w; w.x = pk2(c.x * rs * g.x, c.y * rs * g.y); w.y = pk2(c.z * rs * g.z, c.w * rs * g.w);
            *(uint2*)(CKV + (size_t)tok * 256 + lane * 4) = w;
            const int i = lane & 15, hg = lane >> 4;
            const float x1 = CKR[(size_t)tok * 384 + 256 + i], x2 = CKR[(size_t)tok * 384 + 272 + i];
            const float cs = rope[(size_t)tok * 32 + i], sn = rope[(size_t)tok * 32 + 16 + i];
            const bf16_t o1 = f2bf(x1 * cs - x2 * sn), o2 = f2bf(x2 * cs + x1 * sn);
            const int b = tok >> 13, s = tok & (S - 1);
#pragma unroll
            for (int hh = 0; hh < 3; ++hh) {
                bf16_t* kp = KF + ((size_t)(b * 12 + hg * 3 + hh) * S + s) * 96 + 64 + i;
                kp[0] = o1; kp[16] = o2;
            }
        }
    }
}

__device__ void rope_phase(const Params& p) {
    const int* pos = (const int*)p.in[2]; float* rope = (float*)(p.ws + WS_ROPE);
    for (int idx = blockIdx.x * 256 + threadIdx.x; idx < T * 16; idx += gridDim.x * 256) {
        const int tok = idx >> 4, i = idx & 15;
        const float invf = powf(10000.f, -(float)i / 16.f);
        const float ang = (float)pos[tok] * invf;
        rope[(size_t)tok * 32 + i] = cosf(ang); rope[(size_t)tok * 32 + 16 + i] = sinf(ang);
    }
}

__device__ bool get_gemm_job(const Params& p, int ph, int jn, GemmJob& g) {
    char* ws = p.ws;
    bf16_t* WA = (bf16_t*)(ws + WS_WA); bf16_t* WF = (bf16_t*)(ws + WS_WF); bf16_t* H = (bf16_t*)(ws + WS_H); bf16_t* P = (bf16_t*)(ws + WS_P);
    bf16_t* LIN = (bf16_t*)(ws + WS_LIN); bf16_t* KMEM = (bf16_t*)(ws + WS_KMEM); bf16_t* VTMEM = (bf16_t*)(ws + WS_VTMEM); bf16_t* MEMN = (bf16_t*)(ws + WS_MEMN);
    g.M = T; g.e.o1 = nullptr; g.e.bias = nullptr; g.e.resid = nullptr; g.e.halo = nullptr; g.e.ldc = 0;
    const bool rw = ph < 25;
    const int L = rw ? (ph - 1) / 12 : 2 + (ph - 25) / 9, r = rw ? (ph - 1) % 12 : (ph - 25) % 9;
    const int r_wout = rw ? 8 : 5, r_gu = rw ? 10 : 7, r_down = rw ? 11 : 8;
    if (r == r_wout) { if (jn) return false; g.A = H; g.lda = 1024; g.W = WA + (rw ? A_WOUT : B_WOUT); g.K = 1024; g.N = 1024; g.kind = E_RESID; g.e.o0 = p.out; g.e.resid = (L == 0) ? p.in[0] : p.out; g.e.ldc = 1024; return true; }
    if (r == r_gu) { if (jn) return false; g.A = H; g.lda = 1024; g.W = WF + F_GU; g.K = 1024; g.N = 5632; g.kind = E_SWIGLU; g.e.o0 = P; g.e.ldc = 2816; return true; }
    if (r == r_down) { if (jn) return false; g.A = P; g.lda = 2816; g.W = WF + F_DOWN; g.K = 2816; g.N = 1024; g.kind = E_RESID; g.e.o0 = p.out; g.e.resid = p.out; g.e.ldc = 1024; return true; }
    if (r == 1 && jn == 1) { g.A = MEMN; g.lda = 1024; g.W = WA + (rw ? A_MKV : B_MKV); g.K = 1024; g.M = 1024; g.N = 512; g.kind = E_MEMKV; g.e.o0 = KMEM; g.e.o1 = VTMEM; return true; }
    if (rw) {
        const int i = L;
        if (r == 1 && jn == 0) { g.A = H; g.lda = 1024; g.W = WA + A_WIN; g.K = 1024; g.N = (i == 1) ? 2944 : 2816; g.kind = E_BF16; g.e.o0 = P; g.e.ldc = LDP; g.e.halo = (bf16_t*)(ws + WS_HALO); return true; }
        if (r == 3) {
            if (jn == 0) { g.A = LIN; g.lda = 320; g.W = WA + A_DEC; g.K = 64; g.N = 768; g.kind = E_DECAY; g.e.o0 = ws + WS_Z; g.e.bias = p.in[8] + (size_t)i * 768; g.e.ldc = 768; return true; }
            if (jn == 1) { g.A = LIN + 64; g.lda = 320; g.W = WA + A_AAA; g.K = 64; g.N = 768; g.kind = E_SIGB; g.e.o0 = ws + WS_Z + ZSZ; g.e.bias = p.in[10] + (size_t)i * 768; g.e.ldc = 768; return true; }
            if (jn == 2 && i == 1) { g.A = LIN + 256; g.lda = 320; g.W = WA + A_VUP; g.K = 64; g.N = 768; g.kind = E_SIGB; g.e.o0 = ws + WS_Z + 2 * ZSZ; g.e.bias = p.in[25]; g.e.ldc = 768; return true; }
            return false;
        }
        if (r == 7 && jn == 0) { g.A = LIN + 128; g.lda = 320; g.W = WA + A_GATE; g.K = 128; g.N = 768; g.kind = E_MULG; g.e.o0 = H; g.e.ldc = 1024; return true; }
        return false;
    }
    const int j = L - 2;
    if (r == 1) {
        if (jn == 0) { g.A = H; g.lda = 1024; g.W = WA + B_WIN; g.K = 1024; g.N = 768; g.kind = E_BF16; g.e.o0 = ws + WS_PROJB; g.e.ldc = 768; return true; }
        if (jn == 2 && j == 0) { g.A = (bf16_t*)(ws + WS_QFULL); g.lda = 1024; g.W = WA + B_KVD; g.K = 1024; g.N = 384; g.kind = E_F32; g.e.o0 = ws + WS_CKR; g.e.ldc = 384; return true; }
        return false;
    }
    if (r == 3) {
        if (jn == 0) { g.A = (bf16_t*)(ws + WS_CQ); g.lda = 512; g.W = WA + B_QUP; g.K = 512; g.N = 1152; g.kind = E_BF16; g.e.o0 = ws + WS_QFULL; g.e.ldc = 1152; return true; }
        if (jn == 1 && j == 0) { g.A = (bf16_t*)(ws + WS_CKV); g.lda = 256; g.W = WA + B_KVU; g.K = 256; g.N = 1536; g.kind = E_KV; g.e.o0 = ws + WS_KFULL; g.e.o1 = ws + WS_VT; return true; }
        return false;
    }
    return false;
}

__device__ void run_phase(const Params& p, int ph, char* smem) {
    char* ws = p.ws;
    bf16_t* H = (bf16_t*)(ws + WS_H);
    const float MEMSCL = 0.125f * 1.4426950408889634f, MLASCL = 0.10206207261596575f * 1.4426950408889634f;
    int rot = 0;
    const bool rw = ph >= 1 && ph < 25, mla = ph >= 25 && ph < 43;
    const int L = rw ? (ph - 1) / 12 : (mla ? 2 + (ph - 25) / 9 : 0), r = rw ? (ph - 1) % 12 : (mla ? (ph - 25) % 9 : -1);
    {
        const float* x = nullptr; int nrows = T; const float* g1 = nullptr; bf16_t* o1 = H; const float* g2 = nullptr; bf16_t* o2 = nullptr; float* of = nullptr;
        if (ph == 0) { x = p.in[1]; nrows = 1024; g1 = p.in[3]; o1 = (bf16_t*)(ws + WS_MEMN); }
        else if (ph == 43) { x = p.out; g1 = p.in[39]; of = p.out; }
        else if (rw && r == 0) { x = (L == 0) ? p.in[0] : p.out; g1 = p.in[4] + (size_t)L * 1024; }
        else if (rw && r == 9) { x = p.out; g1 = p.in[19] + (size_t)L * 1024; }
        else if (mla && r == 0) { x = p.out; g1 = p.in[30] + (size_t)(L - 2) * 1024; if (L == 2) { g2 = p.in[26]; o2 = (bf16_t*)(ws + WS_QFULL); } }
        else if (mla && r == 6) { x = p.out; g1 = p.in[36] + (size_t)(L - 2) * 1024; }
        if (x) rmsnorm_phase(x, nrows, g1, o1, g2, o2, of);
    }
    if (ph == 0) rope_phase(p);
    {
        int kind = -1, CL = 0;
        if (ph == 0) { kind = 0; CL = 0; }
        else if ((rw || mla) && r == 0) { kind = 1; CL = L; }
        else if (rw && r == 9) { kind = 0; CL = L + 1; }
        else if (mla && r == 6 && L == 2) { kind = 0; CL = 3; }
        if (kind >= 0) { ConvJob c; for (int idx = 0; get_conv_job(p, kind, CL, idx, c); ++idx) run_conv(c, rot, smem); }
    }
    { GemmJob g; for (int jn = 0; jn < 3; ++jn) if (get_gemm_job(p, ph, jn, g)) gemm_job(g, rot, smem); }
    if ((rw || mla) && r == 3) {
        const bf16_t* Q = rw ? (const bf16_t*)(ws + WS_P) : (const bf16_t*)(ws + WS_PROJB);
        attn_phase<64, false>(Q, rw ? LDP : 768, rw ? 2560 : 512, (const bf16_t*)(ws + WS_KMEM), 256 * 64, (const bf16_t*)(ws + WS_VTMEM), 64 * 256, 256, 4, 256, nullptr, MEMSCL, H, 1024, 768, rot, smem);
    }
    if (mla && r == 4)
        attn_phase<96, true>((const bf16_t*)(ws + WS_QFULL), 1152, 0, (const bf16_t*)(ws + WS_KFULL), (size_t)S * 96, (const bf16_t*)(ws + WS_VT), (size_t)64 * S, S, 12, S, (const float*)(ws + WS_ROPE), MLASCL, H, 1024, 0, rot, smem);
    if (rw && r == 2) lora_in_phase(p, L);
    if (rw && r == 4) prep_phase(p, L);
    if (rw && r == 5) scan_phase(p, smem);
    if (rw && r == 6) post_phase(p, L);
    if (mla && r == 2) subnorm_phase(p, L - 2);
}

__global__ void __launch_bounds__(256, 2) yoco_mega(Params p) {
    extern __shared__ __attribute__((aligned(16))) char smem[];
    cg::grid_group grid = cg::this_grid();
    for (int ph = p.ph_lo; ph < p.ph_hi; ++ph) {
        run_phase(p, ph, smem);
        if (ph + 1 < p.ph_hi) grid.sync();
    }
}

#ifndef MULTI_LAUNCH
#define MULTI_LAUNCH 0
#endif

extern "C" void kernel_launch(void* const* d_in, const int* in_sizes, int n_in, void* d_out, int out_size, void* d_ws, size_t ws_size, hipStream_t stream) {
    static int grid_blocks = 0;
    if (!grid_blocks) {
        int dev = 0, cus = 0, per_cu = 0;
        hipGetDevice(&dev);
        hipDeviceGetAttribute(&cus, hipDeviceAttributeMultiprocessorCount, dev);
        hipFuncSetAttribute((const void*)yoco_mega, hipFuncAttributeMaxDynamicSharedMemorySize, LDS_BYTES);
        hipOccupancyMaxActiveBlocksPerMultiprocessor(&per_cu, (const void*)yoco_mega, 256, LDS_BYTES);
        if (per_cu < 1) per_cu = 1;
        if (per_cu > 2) per_cu = 2;
        grid_blocks = cus * per_cu;
        if (ws_size < WS_END) fprintf(stderr, "kernel_launch: workspace too small: %zu < %zu\n", ws_size, (size_t)WS_END);
        if (n_in != 40) fprintf(stderr, "kernel_launch: expected 40 inputs, got %d\n", n_in);
    }
    Params p{};
    for (int i = 0; i < 40; ++i) p.in[i] = (const float*)d_in[i];
    p.out = (float*)d_out; p.ws = (char*)d_ws;
#if MULTI_LAUNCH
    for (int ph = 0; ph < 44; ++ph) {
        p.ph_lo = ph; p.ph_hi = ph + 1;
        hipLaunchKernelGGL(yoco_mega, dim3(grid_blocks), dim3(256), LDS_BYTES, stream, p);
    }
#else
    p.ph_lo = 0; p.ph_hi = 44;
    void* args[] = {&p};
    hipError_t e = hipLaunchCooperativeKernel((const void*)yoco_mega, dim3(grid_blocks), dim3(256), args, LDS_BYTES, stream);
    if (e != hipSuccess) fprintf(stderr, "cooperative launch failed: %s (grid %d)\n", hipGetErrorString(e), grid_blocks);
#endif
}
```

```cpp
#include <hip/hip_runtime.h>
#include <hip/hip_cooperative_groups.h>
#include <cstdio>
#include <cstdint>
namespace cg = cooperative_groups;
#define PROBE_DUP 0

typedef unsigned short bf16_t;
typedef short bf16x8 __attribute__((ext_vector_type(8)));
typedef float f32x16 __attribute__((ext_vector_type(16)));
typedef _Float16 h8 __attribute__((ext_vector_type(8)));
typedef unsigned u32x4 __attribute__((ext_vector_type(4)));
typedef float f32x2 __attribute__((ext_vector_type(2)));
#define LAS __attribute__((address_space(3)))
typedef float f32x4 __attribute__((ext_vector_type(4)));

constexpr int T = 32768, S = 8192;
constexpr int LDP = 2944;
constexpr int LDS_BYTES = 73728 + 16;

constexpr size_t WS_WA = 0;
constexpr size_t WS_WF = WS_WA + 10485760;
constexpr size_t WS_H = WS_WF + 17825792;
constexpr size_t WS_P = WS_H + 67108864;
constexpr size_t WS_Z = WS_P + 192937984;
constexpr size_t ZSZ = 50331648;
constexpr size_t WS_LIN = WS_Z + 4 * ZSZ;
constexpr size_t WS_RK = WS_LIN + 20971520;
constexpr size_t WS_ROPE = WS_RK + 1572864;
constexpr size_t WS_KMEM = WS_ROPE + 4194304;
constexpr size_t WS_VTMEM = WS_KMEM + 524288;
constexpr size_t WS_MEMN = WS_VTMEM + 524288;
constexpr size_t WS_HALO = WS_MEMN + 2097152;
constexpr size_t WS_BAR = WS_HALO + 1507328;
constexpr size_t WS_END = WS_BAR + 16384;
constexpr size_t WS_KFULL = WS_Z;
constexpr size_t WS_VT = WS_KFULL + 75497472;
constexpr size_t WS_PROJB = WS_VT + 50331648;
constexpr size_t WS_QFULL = WS_P;
constexpr size_t WS_CQ = WS_QFULL + 75497472;
constexpr size_t WS_CKR = WS_CQ + 33554432;
constexpr size_t WS_CKV = WS_CKR + 50331648;
constexpr size_t A_WIN = 0, A_DEC = 3014656, A_AAA = 3063808, A_GATE = 3112960, A_VUP = 3211264, A_MKV = 3260416, A_WOUT = 3784704;
constexpr size_t B_WIN = 0, B_QUP = 786432, B_MKV = 1376256, B_WOUT = 1900544, B_KVD = 2949120, B_KVU = 3342336;
constexpr size_t F_GU = 0, F_DOWN = 5767168;

struct Params { const float* in[40]; float* out; char* ws; int ph_lo, ph_hi; };

__device__ __forceinline__ bf16_t f2bf(float f) { unsigned u = __float_as_uint(f); u += 0x7fffu + ((u >> 16) & 1u); return (bf16_t)(u >> 16); }
__device__ __forceinline__ unsigned pk2(float lo, float hi) { return (unsigned)f2bf(lo) | ((unsigned)f2bf(hi) << 16); }
__device__ __forceinline__ float bflo(unsigned u) { return __uint_as_float(u << 16); }
__device__ __forceinline__ float bfhi(unsigned u) { return __uint_as_float(u & 0xffff0000u); }
__device__ __forceinline__ float bf2f(bf16_t v) { return __uint_as_float((unsigned)v << 16); }
__device__ __forceinline__ float wave_sum(float v) {
#pragma unroll
    for (int o = 32; o; o >>= 1) v += __shfl_xor(v, o);
    return v;
}
template <int CTRL> __device__ __forceinline__ float dppmov(float x) { return __int_as_float(__builtin_amdgcn_update_dpp(0, __float_as_int(x), CTRL, 0xF, 0xF, true)); }
__device__ __forceinline__ float reduce16(float x) {
    x += dppmov<0xB1>(x); x += dppmov<0x4E>(x); x += dppmov<0x141>(x); x += dppmov<0x140>(x); return x;
}
__device__ __forceinline__ int opaque_tid() { int t = threadIdx.x; asm volatile("" : "+v"(t)); return t; }
__device__ __forceinline__ float sigmoidf_(float x) { return 1.f / (1.f + __expf(-x)); }

__device__ void rmsnorm_phase(const float* x, int nrows, const float* g1, bf16_t* o1, const float* g2, bf16_t* o2, float* of) {
    const int tid_ = opaque_tid(), lane = tid_ & 63, gw = blockIdx.x * 4 + (tid_ >> 6), nw = gridDim.x * 4;
    for (int row = gw; row < nrows; row += nw) {
        const float4* xr = (const float4*)(x + (size_t)row * 1024);
        float4 v[4]; float ss = 0.f;
#pragma unroll
        for (int i = 0; i < 4; ++i) { v[i] = xr[lane + 64 * i]; ss += v[i].x * v[i].x + v[i].y * v[i].y + v[i].z * v[i].z + v[i].w * v[i].w; }
        ss = wave_sum(ss);
        const float rs = rsqrtf(ss * (1.f / 1024.f) + 1e-6f);
#pragma unroll
        for (int i = 0; i < 4; ++i) {
            const float4 g = ((const float4*)g1)[lane + 64 * i];
            const float a = v[i].x * rs, b = v[i].y * rs, c = v[i].z * rs, d = v[i].w * rs;
            if (of) { float4 o; o.x = a * g.x; o.y = b * g.y; o.z = c * g.z; o.w = d * g.w; ((float4*)(of + (size_t)row * 1024))[lane + 64 * i] = o; }
            else {
                uint2 w; w.x = pk2(a * g.x, b * g.y); w.y = pk2(c * g.z, d * g.w);
                *(uint2*)(o1 + (size_t)row * 1024 + (lane + 64 * i) * 4) = w;
                if (o2) { const float4 h = ((const float4*)g2)[lane + 64 * i]; uint2 w2; w2.x = pk2(a * h.x, b * h.y); w2.y = pk2(c * h.z, d * h.w);
                    *(uint2*)(o2 + (size_t)row * 1024 + (lane + 64 * i) * 4) = w2; }
            }
        }
    }
}

struct ConvJob { const float* src; int ld; int ncols; int kvalid; bf16_t* dst; int dstK; int ngran; int swiglu; const float* rscale; int rsmode; };
__device__ void run_conv(const ConvJob& j, int& rot, char* smem) {
#ifdef NO_CONV
    return;
#endif

    bf16_t* lds = (bf16_t*)smem;
    const int G = gridDim.x, tid = opaque_tid(), nkt = j.dstK >> 6, units = j.ngran * nkt;
    for (int u = (blockIdx.x + G - rot) % G; u < units; u += G) {
        const int g = u / nkt, kt = u - g * nkt, k0 = kt * 64;
        int col0 = j.swiglu ? ((g & 1) * 2816 + 32 * (g >> 1)) : 32 * g;
        const bool colok = (col0 + 32 <= j.ncols);
#pragma unroll
        for (int i = 0; i < 8; ++i) {
            const int kr = (tid >> 5) + 8 * i, c = tid & 31, k = k0 + kr;
            float v = 0.f;
            if (colok && k < j.kvalid) {
                v = j.src[(size_t)k * j.ld + col0 + c];
                if (j.rsmode == 1) v *= (1.f - j.rscale[k]); else if (j.rsmode == 2) v *= j.rscale[k];
            }
            lds[c * 72 + kr] = f2bf(v);
        }
        __syncthreads();
        { const int c = tid >> 3, kc = (tid & 7) * 8;
          const uint4 w = *(const uint4*)(lds + c * 72 + kc);
          *(uint4*)(j.dst + (size_t)(g * 32 + c) * j.dstK + k0 + kc) = w; }
        __syncthreads();
    }
    rot = (rot + units) % G;
}
__device__ bool get_conv_job(const Params& p, int kind, int L, int idx, ConvJob& c) {
    bf16_t* WA = (bf16_t*)(p.ws + WS_WA); bf16_t* WF = (bf16_t*)(p.ws + WS_WF);
    c.swiglu = 0; c.rscale = nullptr; c.rsmode = 0;
    if (kind == 1) {
        if (idx == 0) { c.src = (L < 2) ? p.in[20] + (size_t)L * 1024 * 5632 : p.in[37] + (size_t)(L - 2) * 1024 * 5632; c.ld = 5632; c.ncols = 5632; c.kvalid = 1024; c.dst = WF + F_GU; c.dstK = 1024; c.ngran = 176; c.swiglu = 1; return true; }
        if (idx == 1) { c.src = (L < 2) ? p.in[21] + (size_t)L * 2816 * 1024 : p.in[38] + (size_t)(L - 2) * 2816 * 1024; c.ld = 1024; c.ncols = 1024; c.kvalid = 2816; c.dst = WF + F_DOWN; c.dstK = 2816; c.ngran = 32; return true; }
        return false;
    }
    if (L < 2) {
        const int i = L;
        switch (idx) {
        case 0: c.src = p.in[5] + (size_t)i * 1024 * 2816; c.ld = 2816; c.ncols = 2816; c.kvalid = 1024; c.dst = WA + A_WIN; c.dstK = 1024; c.ngran = 88; return true;
        case 1: c.src = p.in[7] + (size_t)i * 64 * 768; c.ld = 768; c.ncols = 768; c.kvalid = 64; c.dst = WA + A_DEC; c.dstK = 64; c.ngran = 24; return true;
        case 2: c.src = p.in[9] + (size_t)i * 64 * 768; c.ld = 768; c.ncols = 768; c.kvalid = 64; c.dst = WA + A_AAA; c.dstK = 64; c.ngran = 24; return true;
        case 3: c.src = p.in[11] + (size_t)i * 128 * 768; c.ld = 768; c.ncols = 768; c.kvalid = 128; c.dst = WA + A_GATE; c.dstK = 128; c.ngran = 24; return true;
        case 4: c.src = p.in[17] + (size_t)i * 1024 * 512; c.ld = 512; c.ncols = 512; c.kvalid = 1024; c.dst = WA + A_MKV; c.dstK = 1024; c.ngran = 16; return true;
        case 5: c.src = p.in[18] + (size_t)i * 1024 * 1024; c.ld = 1024; c.ncols = 1024; c.kvalid = 1024; c.dst = WA + A_WOUT; c.dstK = 1024; c.ngran = 32; return true;
        }
        if (i == 0) return false;
        switch (idx) {
        case 6: c.src = p.in[23]; c.ld = 32; c.ncols = 32; c.kvalid = 1024; c.dst = WA + A_WIN + (size_t)2816 * 1024; c.dstK = 1024; c.ngran = 1; c.rscale = p.in[22]; c.rsmode = 1; return true;
        case 7: c.src = p.in[23]; c.ld = 32; c.ncols = 32; c.kvalid = 1024; c.dst = WA + A_WIN + (size_t)2848 * 1024; c.dstK = 1024; c.ngran = 1; c.rscale = p.in[22]; c.rsmode = 2; return true;
        case 8: c.src = p.in[23]; c.ld = 32; c.ncols = 0; c.kvalid = 1024; c.dst = WA + A_WIN + (size_t)2880 * 1024; c.dstK = 1024; c.ngran = 2; return true;
        case 9: c.src = p.in[24]; c.ld = 768; c.ncols = 768; c.kvalid = 32; c.dst = WA + A_VUP; c.dstK = 64; c.ngran = 24; return true;
        }
        return false;
    }
    const int j = L - 2;
    switch (idx) {
    case 0: c.src = p.in[31] + (size_t)j * 1024 * 768; c.ld = 768; c.ncols = 768; c.kvalid = 1024; c.dst = WA + B_WIN; c.dstK = 1024; c.ngran = 24; return true;
    case 1: c.src = p.in[33] + (size_t)j * 512 * 1152; c.ld = 1152; c.ncols = 1152; c.kvalid = 512; c.dst = WA + B_QUP; c.dstK = 512; c.ngran = 36; return true;
    case 2: c.src = p.in[34] + (size_t)j * 1024 * 512; c.ld = 512; c.ncols = 512; c.kvalid = 1024; c.dst = WA + B_MKV; c.dstK = 1024; c.ngran = 16; return true;
    case 3: c.src = p.in[35] + (size_t)j * 1024 * 1024; c.ld = 1024; c.ncols = 1024; c.kvalid = 1024; c.dst = WA + B_WOUT; c.dstK = 1024; c.ngran = 32; return true;
    }
    if (j != 0) return false;
    if (idx == 4) { c.src = p.in[27]; c.ld = 288; c.ncols = 288; c.kvalid = 1024; c.dst = WA + B_KVD; c.dstK = 1024; c.ngran = 12; return true; }
    if (idx == 5) { c.src = p.in[29]; c.ld = 1536; c.ncols = 1536; c.kvalid = 256; c.dst = WA + B_KVU; c.dstK = 256; c.ngran = 48; return true; }
    return false;
}

enum { E_BF16 = 0, E_F32, E_RESID, E_SWIGLU, E_DECAY, E_SIGB, E_KV, E_MEMKV, E_MULG };
struct Epi { void* o0; void* o1; const float* bias; const float* resid; int ldc; bf16_t* halo; };
struct GemmJob { const bf16_t* A; int lda; const bf16_t* W; int K, M, N, kind; Epi e; };

template <int E> __device__ __forceinline__ void epilogue(const f32x16 (&acc)[2][2], int m0, int n0, int wm, int wn, int lane, const Epi& e) {
    const int half = lane >> 5, l31 = lane & 31;
    if (E == E_SWIGLU) {
        bf16_t* o = (bf16_t*)e.o0; const int col = (n0 >> 1) + wn * 32 + l31;
#pragma unroll
        for (int mi = 0; mi < 2; ++mi)
#pragma unroll
            for (int i = 0; i < 16; ++i) {
                const int row = m0 + wm * 64 + mi * 32 + 8 * (i >> 2) + 4 * half + (i & 3);
                const float g = acc[mi][0][i], u = acc[mi][1][i];
                o[(size_t)row * 2816 + col] = f2bf(g * sigmoidf_(g) * u);
            }
        return;
    }
#pragma unroll
    for (int mi = 0; mi < 2; ++mi)
#pragma unroll
        for (int ni = 0; ni < 2; ++ni) {
            const int col = n0 + wn * 64 + ni * 32 + l31;
            const int rbase = m0 + wm * 64 + mi * 32 + 4 * half;
            if (E == E_KV || E == E_MEMKV) {
                const bool isv = (E == E_KV) ? ((col & 127) >= 64) : (col >= 256);
                if (isv) {
#pragma unroll
                    for (int g = 0; g < 4; ++g) {
                        const int row = rbase + 8 * g;
                        uint2 w; w.x = pk2(acc[mi][ni][4 * g], acc[mi][ni][4 * g + 1]); w.y = pk2(acc[mi][ni][4 * g + 2], acc[mi][ni][4 * g + 3]);
                        size_t idx;
                        if (E == E_KV) { const int b = row >> 13, s = row & 8191, head = col >> 7, d = (col & 127) - 64; idx = ((size_t)(b * 12 + head) * 64 + d) * 8192 + s; }
                        else { const int b = row >> 8, mi_ = row & 255, head = (col - 256) >> 6, d = col & 63; idx = ((size_t)(b * 4 + head) * 64 + d) * 256 + mi_; }
                        *(uint2*)((bf16_t*)e.o1 + idx) = w;
                    }
                } else {
#pragma unroll
                    for (int i = 0; i < 16; ++i) {
                        const int row = rbase + 8 * (i >> 2) + (i & 3);
                        size_t idx;
                        if (E == E_KV) { const int b = row >> 13, s = row & 8191, head = col >> 7, c = col & 127; idx = ((size_t)(b * 12 + head) * 8192 + s) * 96 + c; }
                        else { const int b = row >> 8, mi_ = row & 255, head = col >> 6, d = col & 63; idx = ((size_t)(b * 4 + head) * 256 + mi_) * 64 + d; }
                        ((bf16_t*)e.o0)[idx] = f2bf(acc[mi][ni][i]);
                    }
                }
                continue;
            }
            float bias = 0.f;
            if (E == E_DECAY || E == E_SIGB) bias = e.bias[col];
#pragma unroll
            for (int i = 0; i < 16; ++i) {
                const int row = rbase + 8 * (i >> 2) + (i & 3);
                const float v = acc[mi][ni][i];
                const size_t idx = (size_t)row * e.ldc + col;
                if (E == E_BF16) {
                    const bf16_t b = f2bf(v);
                    ((bf16_t*)e.o0)[idx] = b;
                    if (e.halo && (row & 127) == 127) e.halo[(size_t)(row >> 7) * e.ldc + col] = b;
                } else if (E == E_F32) ((float*)e.o0)[idx] = v;
                else if (E == E_RESID) ((float*)e.o0)[idx] = e.resid[idx] + v;
                else if (E == E_DECAY) ((_Float16*)e.o0)[idx] = (_Float16)(0.60653066f * sigmoidf_(bias + v));
                else if (E == E_SIGB) ((bf16_t*)e.o0)[idx] = f2bf(sigmoidf_(bias + v));
                else if (E == E_MULG) { bf16_t* o = (bf16_t*)e.o0; o[idx] = f2bf(bf2f(o[idx]) * v); }
            }
        }
}

__device__ void gemm_job(const GemmJob& gj, int& rot, char* smem) {
    const bf16_t* A = gj.A; const bf16_t* W = gj.W; const int lda = gj.lda, K = gj.K, M = gj.M, N = gj.N; const Epi& e = gj.e;
#ifdef NO_GEMM
    return;
#endif

    const int tid = opaque_tid(), lane = tid & 63, wave = tid >> 6, wm = wave >> 1, wn = wave & 1;
    const int ntn = N >> 7, ntiles = (M >> 7) * ntn, KT = K >> 6, G = gridDim.x;
    bf16_t* sA = (bf16_t*)smem;
    bf16_t* sB = sA + 2 * 128 * 72;
    const int half = lane >> 5, l31 = lane & 31;
    for (int t = (blockIdx.x + G - rot) % G; t < ntiles; t += G) {
        const int tm = t / ntn, tn = t - tm * ntn, m0 = tm << 7, n0 = tn << 7;
        f32x16 acc[2][2];
#pragma unroll
        for (int a = 0; a < 2; ++a)
#pragma unroll
            for (int b = 0; b < 2; ++b)
#pragma unroll
                for (int i = 0; i < 16; ++i) acc[a][b][i] = 0.f;
        u32x4 ra[4], rb[4];
        const bf16_t* Ag = A + (size_t)(m0 + (tid >> 3)) * lda + (tid & 7) * 8;
        const bf16_t* Wg = W + (size_t)(n0 + (tid >> 3)) * K + (tid & 7) * 8;
#pragma unroll
        for (int i = 0; i < 4; ++i) { ra[i] = *(const u32x4*)(Ag + (size_t)(32 * i) * lda); rb[i] = *(const u32x4*)(Wg + (size_t)(32 * i) * K); }
        const int lofs = (tid >> 3) * 72 + (tid & 7) * 8;
#pragma unroll
        for (int i = 0; i < 4; ++i) { *(u32x4*)(sA + lofs + 32 * i * 72) = ra[i]; *(u32x4*)(sB + lofs + 32 * i * 72) = rb[i]; }
        __syncthreads();
        for (int kt = 0; kt < KT; ++kt) {
            const int buf = kt & 1;
            if (kt + 1 < KT) {
#pragma unroll
                for (int i = 0; i < 4; ++i) { ra[i] = *(const u32x4*)(Ag + (size_t)(32 * i) * lda + (kt + 1) * 64); rb[i] = *(const u32x4*)(Wg + (size_t)(32 * i) * K + (kt + 1) * 64); }
            }
            const bf16_t* a_ = sA + buf * 128 * 72 + (wm * 64 + l31) * 72 + half * 8;
            const bf16_t* b_ = sB + buf * 128 * 72 + (wn * 64 + l31) * 72 + half * 8;
#pragma unroll
            for (int kk = 0; kk < 4; ++kk) {
                const bf16x8 a0 = *(const bf16x8*)(a_ + kk * 16), a1 = *(const bf16x8*)(a_ + 32 * 72 + kk * 16);
                const bf16x8 b0 = *(const bf16x8*)(b_ + kk * 16), b1 = *(const bf16x8*)(b_ + 32 * 72 + kk * 16);
                acc[0][0] = __builtin_amdgcn_mfma_f32_32x32x16_bf16(a0, b0, acc[0][0], 0, 0, 0);
                acc[0][1] = __builtin_amdgcn_mfma_f32_32x32x16_bf16(a0, b1, acc[0][1], 0, 0, 0);
                acc[1][0] = __builtin_amdgcn_mfma_f32_32x32x16_bf16(a1, b0, acc[1][0], 0, 0, 0);
                acc[1][1] = __builtin_amdgcn_mfma_f32_32x32x16_bf16(a1, b1, acc[1][1], 0, 0, 0);
            }
            if (kt + 1 < KT) {
                bf16_t* da = sA + (buf ^ 1) * 128 * 72 + lofs; bf16_t* db = sB + (buf ^ 1) * 128 * 72 + lofs;
#pragma unroll
                for (int i = 0; i < 4; ++i) { *(u32x4*)(da + 32 * i * 72) = ra[i]; *(u32x4*)(db + 32 * i * 72) = rb[i]; }
            }
            __syncthreads();
        }
        switch (gj.kind) {
        case E_BF16: epilogue<E_BF16>(acc, m0, n0, wm, wn, lane, e); break;
        case E_F32: epilogue<E_F32>(acc, m0, n0, wm, wn, lane, e); break;
        case E_RESID: epilogue<E_RESID>(acc, m0, n0, wm, wn, lane, e); break;
        case E_SWIGLU: epilogue<E_SWIGLU>(acc, m0, n0, wm, wn, lane, e); break;
        case E_DECAY: epilogue<E_DECAY>(acc, m0, n0, wm, wn, lane, e); break;
        case E_SIGB: epilogue<E_SIGB>(acc, m0, n0, wm, wn, lane, e); break;
        case E_KV: epilogue<E_KV>(acc, m0, n0, wm, wn, lane, e); break;
        case E_MEMKV: epilogue<E_MEMKV>(acc, m0, n0, wm, wn, lane, e); break;
        default: epilogue<E_MULG>(acc, m0, n0, wm, wn, lane, e); break;
        }
    }
    rot = (rot + ntiles) % G;
}

template <int DQK, bool CAUSAL>
__device__ void attn_phase(const bf16_t* Q, int ldq, int qcol0, const bf16_t* Kb, size_t k_bh_stride, const bf16_t* VT, size_t vt_bh_stride, int vt_ld,
                           int nheads, int nkeys, const float* rope, float scl, bf16_t* O, int ldo, int ocol0, int& rot, char* smem) {
#ifdef NO_ATTN
    return;
#endif

    constexpr int KS = DQK + 8, NKK = DQK / 16, KCH = DQK / 8, NKL = (64 * KCH) / 256;
    const int tid = opaque_tid(), lane = tid & 63, wave = tid >> 6, half = lane >> 5, l31 = lane & 31, G = gridDim.x;
    bf16_t* sK = (bf16_t*)smem;
    bf16_t* sV = sK + 2 * 64 * KS;
    const int nbh = 4 * nheads, units = nbh * 64;
    for (int u = (blockIdx.x + G - rot) % G; u < units; u += G) {
        const int qb = 63 - u / nbh, bh = u % nbh, b = bh / nheads, h = bh - b * nheads;
        const int q0 = qb * 128 + wave * 32, q = q0 + l31;
        const size_t tokq = (size_t)b * S + q;
        bf16x8 qf[NKK];
        { const bf16_t* qp = Q + tokq * ldq + qcol0 + h * DQK + half * 8;
#pragma unroll
          for (int kk = 0; kk < NKK; ++kk) qf[kk] = *(const bf16x8*)(qp + kk * 16); }
        if (rope) {
            const float* rp = rope + tokq * 32 + half * 8;
            const float4 c0 = *(const float4*)rp, c1 = *(const float4*)(rp + 4), s0 = *(const float4*)(rp + 16), s1 = *(const float4*)(rp + 20);
            u32x4 qa = __builtin_bit_cast(u32x4, qf[NKK - 2]), qb_ = __builtin_bit_cast(u32x4, qf[NKK - 1]);
#define ROT2(D, CA, SA, CB, SB) { const float x1l = bflo(qa[D]), x1h = bfhi(qa[D]), x2l = bflo(qb_[D]), x2h = bfhi(qb_[D]); \
              qa[D] = pk2(x1l * CA - x2l * SA, x1h * CB - x2h * SB); qb_[D] = pk2(x2l * CA + x1l * SA, x2h * CB + x1h * SB); }
            ROT2(0, c0.x, s0.x, c0.y, s0.y) ROT2(1, c0.z, s0.z, c0.w, s0.w) ROT2(2, c1.x, s1.x, c1.y, s1.y) ROT2(3, c1.z, s1.z, c1.w, s1.w)
#undef ROT2
            qf[NKK - 2] = __builtin_bit_cast(bf16x8, qa); qf[NKK - 1] = __builtin_bit_cast(bf16x8, qb_);
        }
        const int ntiles = CAUSAL ? (qb * 2 + 2) : (nkeys >> 6);
        f32x16 o[2];
#pragma unroll
        for (int a = 0; a < 2; ++a)
#pragma unroll
            for (int i = 0; i < 16; ++i) o[a][i] = 0.f;
        float m = -1e30f, l = 0.f;
        const bf16_t* Kg = Kb + (size_t)bh * k_bh_stride;
        const bf16_t* Vg = VT + (size_t)bh * vt_bh_stride + (size_t)(tid >> 3) * vt_ld + (tid & 7) * 8;
        u32x4 rk[NKL], rv[2];
#pragma unroll
        for (int i = 0; i < NKL; ++i) rk[i] = *(const u32x4*)(Kg + (size_t)(tid + 256 * i) * 8);
#pragma unroll
        for (int i = 0; i < 2; ++i) rv[i] = *(const u32x4*)(Vg + (size_t)(32 * i) * vt_ld);
#pragma unroll
        for (int i = 0; i < NKL; ++i) { const int c = tid + 256 * i; *(u32x4*)(sK + (c / KCH) * KS + (c % KCH) * 8) = rk[i]; }
#pragma unroll
        for (int i = 0; i < 2; ++i) *(u32x4*)(sV + ((tid >> 3) + 32 * i) * 72 + (tid & 7) * 8) = rv[i];
        __syncthreads();
        for (int kt = 0; kt < ntiles; ++kt) {
            const int buf = kt & 1;
            if (kt + 1 < ntiles) {
#pragma unroll
                for (int i = 0; i < NKL; ++i) rk[i] = *(const u32x4*)(Kg + (size_t)(kt + 1) * 64 * DQK + (size_t)(tid + 256 * i) * 8);
#pragma unroll
                for (int i = 0; i < 2; ++i) rv[i] = *(const u32x4*)(Vg + (size_t)(32 * i) * vt_ld + (kt + 1) * 64);
            }
            if (!CAUSAL || kt * 64 <= q0 + 31) {
                const bf16_t* kb_ = sK + buf * 64 * KS + l31 * KS + half * 8;
                f32x16 s[2];
#pragma unroll
                for (int kb = 0; kb < 2; ++kb) {
#pragma unroll
                    for (int i = 0; i < 16; ++i) s[kb][i] = 0.f;
#pragma unroll
                    for (int kk = 0; kk < NKK; ++kk) {
                        const bf16x8 kf = *(const bf16x8*)(kb_ + kb * 32 * KS + kk * 16);
                        s[kb] = __builtin_amdgcn_mfma_f32_32x32x16_bf16(kf, qf[kk], s[kb], 0, 0, 0);
                    }
                }
                if (CAUSAL && kt * 64 + 63 > q0) {
#pragma unroll
                    for (int kb = 0; kb < 2; ++kb)
#pragma unroll
                        for (int i = 0; i < 16; ++i) { const int key = kt * 64 + kb * 32 + 8 * (i >> 2) + 4 * half + (i & 3); if (key > q) s[kb][i] = -1e30f; }
                }
                float mx = s[0][0];
#pragma unroll
                for (int kb = 0; kb < 2; ++kb)
#pragma unroll
                    for (int i = 0; i < 16; ++i) mx = fmaxf(mx, s[kb][i]);
                mx = fmaxf(mx, __shfl_xor(mx, 32));
                const float mn = fmaxf(m, mx), alpha = exp2f((m - mn) * scl), mc = mn * scl;
                m = mn;
                float ls = 0.f;
#pragma unroll
                for (int kb = 0; kb < 2; ++kb)
#pragma unroll
                    for (int i = 0; i < 16; ++i) { const float pv = exp2f(s[kb][i] * scl - mc); s[kb][i] = pv; ls += pv; }
                l = l * alpha + ls;
#pragma unroll
                for (int a = 0; a < 2; ++a)
#pragma unroll
                    for (int i = 0; i < 16; ++i) o[a][i] *= alpha;
                const bf16_t* vb_ = sV + buf * 64 * 72 + l31 * 72 + 4 * half;
#pragma unroll
                for (int kb = 0; kb < 2; ++kb)
#pragma unroll
                    for (int g = 0; g < 2; ++g) {
                        u32x4 pu;
#pragma unroll
                        for (int j = 0; j < 4; ++j) pu[j] = pk2(s[kb][8 * g + 2 * j], s[kb][8 * g + 2 * j + 1]);
                        const bf16x8 pf = __builtin_bit_cast(bf16x8, pu);
#pragma unroll
                        for (int db = 0; db < 2; ++db) {
                            const bf16_t* vp = vb_ + db * 32 * 72 + kb * 32 + 16 * g;
                            const uint2 d0 = *(const uint2*)vp, d1 = *(const uint2*)(vp + 8);
                            u32x4 vu; vu[0] = d0.x; vu[1] = d0.y; vu[2] = d1.x; vu[3] = d1.y;
                            o[db] = __builtin_amdgcn_mfma_f32_32x32x16_bf16(__builtin_bit_cast(bf16x8, vu), pf, o[db], 0, 0, 0);
                        }
                    }
            }
            if (kt + 1 < ntiles) {
                bf16_t* dk = sK + (buf ^ 1) * 64 * KS; bf16_t* dv = sV + (buf ^ 1) * 64 * 72;
#pragma unroll
                for (int i = 0; i < NKL; ++i) { const int c = tid + 256 * i; *(u32x4*)(dk + (c / KCH) * KS + (c % KCH) * 8) = rk[i]; }
#pragma unroll
                for (int i = 0; i < 2; ++i) *(u32x4*)(dv + ((tid >> 3) + 32 * i) * 72 + (tid & 7) * 8) = rv[i];
            }
            __syncthreads();
        }
        l += __shfl_xor(l, 32);
        const float inv = 1.f / l;
        bf16_t* op = O + tokq * ldo + ocol0 + h * 64 + 4 * half;
#pragma unroll
        for (int db = 0; db < 2; ++db)
#pragma unroll
            for (int g = 0; g < 4; ++g) {
                uint2 w; w.x = pk2(o[db][4 * g] * inv, o[db][4 * g + 1] * inv); w.y = pk2(o[db][4 * g + 2] * inv, o[db][4 * g + 3] * inv);
                *(uint2*)(op + db * 32 + 8 * g) = w;
            }
    }
    rot = (rot + units) % G;
}

__device__ void lora_in_phase(const Params& p, int layer) {
#ifdef NO_LIN
    return;
#endif

    const bf16_t* P = (const bf16_t*)(p.ws + WS_P); bf16_t* LIN = (bf16_t*)(p.ws + WS_LIN);
    const float* mu = p.in[6] + (size_t)layer * 2560 + 2304;
    const int tid_ = opaque_tid(), lane = tid_ & 63, gw = blockIdx.x * 4 + (tid_ >> 6), nw = gridDim.x * 4;
    const float4 m4 = *(const float4*)(mu + lane * 4);
    for (int tok = gw; tok < T; tok += nw) {
        const int s = tok & (S - 1);
        const uint2 c = *(const uint2*)(P + (size_t)tok * LDP + 2304 + lane * 4);
        uint2 pv; pv.x = 0; pv.y = 0;
        if (s) pv = *(const uint2*)(P + (size_t)(tok - 1) * LDP + 2304 + lane * 4);
        float v0 = bflo(c.x), v1 = bfhi(c.x), v2 = bflo(c.y), v3 = bfhi(c.y);
        v0 += (bflo(pv.x) - v0) * m4.x; v1 += (bfhi(pv.x) - v1) * m4.y; v2 += (bflo(pv.y) - v2) * m4.z; v3 += (bfhi(pv.y) - v3) * m4.w;
        if (lane < 16) { v0 = tanhf(v0); v1 = tanhf(v1); v2 = tanhf(v2); v3 = tanhf(v3); }
        else if (lane >= 32) { v0 = sigmoidf_(v0); v1 = sigmoidf_(v1); v2 = sigmoidf_(v2); v3 = sigmoidf_(v3); }
        uint2 w; w.x = pk2(v0, v1); w.y = pk2(v2, v3);
        *(uint2*)(LIN + (size_t)tok * 320 + lane * 4) = w;
        if (layer == 1) {
            float vd = 0.f;
            if (lane < 32) { vd = bf2f(P[(size_t)tok * LDP + 2816 + lane]); if (s) vd += bf2f(P[(size_t)(tok - 1) * LDP + 2848 + lane]); }
            LIN[(size_t)tok * 320 + 256 + lane] = f2bf(vd);
        }
    }
}

__device__ void prep_phase(const Params& p, int layer) {
#ifdef NO_PREP
    return;
#endif

    bf16_t* P = (bf16_t*)(p.ws + WS_P);
    bf16_t* Z2 = (bf16_t*)(p.ws + WS_Z + ZSZ);
    bf16_t* Z3 = (bf16_t*)(p.ws + WS_Z + 2 * ZSZ);
    bf16_t* Z4 = (bf16_t*)(p.ws + WS_Z + 3 * ZSZ);
    const bf16_t* HALO = (const bf16_t*)(p.ws + WS_HALO);
    float* RK = (float*)(p.ws + WS_RK);
    const float* mu = p.in[6] + (size_t)layer * 2560;
    const float* kkw = p.in[12] + (size_t)layer * 768; const float* kaw = p.in[13] + (size_t)layer * 768; const float* rkw = p.in[14] + (size_t)layer * 768;
    const int tid = opaque_tid(), tokl = tid >> 4, cg4 = (tid & 15) * 4;
    for (int u = blockIdx.x; u < 256 * 12; u += gridDim.x) {
        const int mt = u / 12, h = u - mt * 12, m0 = mt * 128, hc = h * 64 + cg4;
        const float4 mur = *(const float4*)(mu + hc), muk = *(const float4*)(mu + 768 + hc), muv = *(const float4*)(mu + 1536 + hc);
        const float4 kkw4 = *(const float4*)(kkw + hc), kaw4 = *(const float4*)(kaw + hc), rkw4 = *(const float4*)(rkw + hc);
        for (int it = 7; it >= 0; --it) {
            const int tok = m0 + it * 16 + tokl, s = tok & (S - 1);
            bf16_t* pr = P + (size_t)tok * LDP + hc;
            const uint2 cr = *(const uint2*)pr, ck = *(const uint2*)(pr + 768), cv = *(const uint2*)(pr + 1536);
            uint2 qr, qk, qv; qr.x = qr.y = qk.x = qk.y = qv.x = qv.y = 0;
            if (s) {
                const bf16_t* pp = (it == 0 && tokl == 0) ? (HALO + (size_t)(mt - 1) * LDP + hc) : (P + (size_t)(tok - 1) * LDP + hc);
                qr = *(const uint2*)pp; qk = *(const uint2*)(pp + 768); qv = *(const uint2*)(pp + 1536);
            }
            const size_t zi = (size_t)tok * 768 + hc;
            const uint2 lr2 = *(const uint2*)(Z2 + zi);
            uint2 vs2, vf2; vs2.x = vs2.y = vf2.x = vf2.y = 0;
            if (layer == 1) { vs2 = *(const uint2*)(Z3 + zi); vf2 = *(const uint2*)(Z4 + zi); }
            __syncthreads();
            float r[4] = {bflo(cr.x), bfhi(cr.x), bflo(cr.y), bfhi(cr.y)}, k[4] = {bflo(ck.x), bfhi(ck.x), bflo(ck.y), bfhi(ck.y)}, v[4] = {bflo(cv.x), bfhi(cv.x), bflo(cv.y), bfhi(cv.y)};
            const float rp[4] = {bflo(qr.x), bfhi(qr.x), bflo(qr.y), bfhi(qr.y)}, kp[4] = {bflo(qk.x), bfhi(qk.x), bflo(qk.y), bfhi(qk.y)}, vp[4] = {bflo(qv.x), bfhi(qv.x), bflo(qv.y), bfhi(qv.y)};
            const float mr[4] = {mur.x, mur.y, mur.z, mur.w}, mk[4] = {muk.x, muk.y, muk.z, muk.w}, mv[4] = {muv.x, muv.y, muv.z, muv.w};
            const float lr[4] = {bflo(lr2.x), bfhi(lr2.x), bflo(lr2.y), bfhi(lr2.y)};
            const float vs[4] = {bflo(vs2.x), bfhi(vs2.x), bflo(vs2.y), bfhi(vs2.y)}, vf[4] = {bflo(vf2.x), bfhi(vf2.x), bflo(vf2.y), bfhi(vf2.y)};
            const float kkw_[4] = {kkw4.x, kkw4.y, kkw4.z, kkw4.w}, kaw_[4] = {kaw4.x, kaw4.y, kaw4.z, kaw4.w}, rkw_[4] = {rkw4.x, rkw4.y, rkw4.z, rkw4.w};
            float kk[4], n2 = 0.f, rks = 0.f, bb[4];
#pragma unroll
            for (int j = 0; j < 4; ++j) {
                r[j] += (rp[j] - r[j]) * mr[j]; k[j] += (kp[j] - k[j]) * mk[j]; v[j] += (vp[j] - v[j]) * mv[j];
                if (layer == 1) v[j] += (vf[j] - v[j]) * vs[j];
                kk[j] = k[j] * kkw_[j]; n2 += kk[j] * kk[j];
                k[j] = k[j] * (1.f + (lr[j] - 1.f) * kaw_[j]);
                rks += r[j] * k[j] * rkw_[j];
            }
            n2 = reduce16(n2); rks = reduce16(rks);
            const float inv = 1.f / fmaxf(sqrtf(n2), 1e-12f);
#pragma unroll
            for (int j = 0; j < 4; ++j) { kk[j] *= inv; bb[j] = kk[j] * lr[j]; }
            uint2 w;
            w.x = pk2(r[0], r[1]); w.y = pk2(r[2], r[3]); *(uint2*)pr = w;
            w.x = pk2(k[0], k[1]); w.y = pk2(k[2], k[3]); *(uint2*)(pr + 768) = w;
            w.x = pk2(v[0], v[1]); w.y = pk2(v[2], v[3]); *(uint2*)(pr + 1536) = w;
            if (layer == 0) *(uint2*)(Z4 + zi) = w;
            w.x = pk2(bb[0], bb[1]); w.y = pk2(bb[2], bb[3]); *(uint2*)(Z2 + zi) = w;
            w.x = pk2(kk[0], kk[1]); w.y = pk2(kk[2], kk[3]); *(uint2*)(Z3 + zi) = w;
            if ((tid & 15) == 0) RK[(size_t)tok * 12 + h] = rks;
        }
        __syncthreads();
    }
}

__device__ void scan_phase(const Params& p, char* smem) {
#ifdef NO_SCAN
    return;
#endif

    const bf16_t* P = (const bf16_t*)(p.ws + WS_P);
    const _Float16* E = (const _Float16*)(p.ws + WS_Z);
    const bf16_t* Bv = (const bf16_t*)(p.ws + WS_Z + ZSZ);
    const bf16_t* KK = (const bf16_t*)(p.ws + WS_Z + 2 * ZSZ);
    bf16_t* Y = (bf16_t*)(p.ws + WS_H);
    float* sW = (float*)smem; float* sK = sW + 2048; float* sA = sK + 2048; float* sB = sA + 2048; float* sR = sB + 2048; float* sV = sR + 2048; float* sY = sV + 512;
    const int tid = opaque_tid(), lane = tid & 63, wave = tid >> 6, row = wave * 4 + (lane >> 4), kg = lane & 15;
    const int st_l = tid >> 3, c8 = (tid & 7) * 8;
    for (int u = blockIdx.x; u < 192; u += gridDim.x) {
        const int b = u / 48, h = (u % 48) >> 2, qt = u & 3;
        const size_t tok0 = (size_t)b * S;
        f32x2 S01 = {0.f, 0.f}, S23 = {0.f, 0.f};
        u32x4 gr, gk, ga, gb, gv = {0u, 0u, 0u, 0u}; h8 ge;
        auto gload = [&](int ch) {
            const size_t tok = tok0 + ch * 32 + st_l;
            gr = *(const u32x4*)(P + tok * LDP + h * 64 + c8);
            gk = *(const u32x4*)(P + tok * LDP + 768 + h * 64 + c8);
            ga = *(const u32x4*)(KK + tok * 768 + h * 64 + c8);
            gb = *(const u32x4*)(Bv + tok * 768 + h * 64 + c8);
            ge = *(const h8*)(E + tok * 768 + h * 64 + c8);
            if (tid < 64) { const size_t tk = tok0 + ch * 32 + (tid >> 1); gv = *(const u32x4*)(P + tk * LDP + 1536 + h * 64 + qt * 16 + (tid & 1) * 8); }
        };
        auto st4 = [&](float* dst, const u32x4& g) {
            f32x4 a, c; a[0] = bflo(g[0]); a[1] = bfhi(g[0]); a[2] = bflo(g[1]); a[3] = bfhi(g[1]); c[0] = bflo(g[2]); c[1] = bfhi(g[2]); c[2] = bflo(g[3]); c[3] = bfhi(g[3]);
            *(f32x4*)dst = a; *(f32x4*)(dst + 4) = c;
        };
        gload(0);
        for (int ch = 0; ch < 256; ++ch) {
            {
                const int o = st_l * 64 + c8;
                st4(sR + o, gr); st4(sK + o, gk); st4(sA + o, ga); st4(sB + o, gb);
                float4 a, c; a.x = __expf(-(float)ge[0]); a.y = __expf(-(float)ge[1]); a.z = __expf(-(float)ge[2]); a.w = __expf(-(float)ge[3]);
                c.x = __expf(-(float)ge[4]); c.y = __expf(-(float)ge[5]); c.z = __expf(-(float)ge[6]); c.w = __expf(-(float)ge[7]);
                *(float4*)(sW + o) = a; *(float4*)(sW + o + 4) = c;
                if (tid < 64) st4(sV + (tid >> 1) * 16 + (tid & 1) * 8, gv);
            }
            __syncthreads();
            if (ch + 1 < 256) gload(ch + 1);
            float yk0 = 0.f, yk1 = 0.f;
            {
                unsigned a_cur = (unsigned)(size_t)(LAS char*)(sW + kg * 4), v_cur = (unsigned)(size_t)(LAS char*)(sV + row);
                f32x4 w0, k0, a0, b0, r0, w1, k1, a1, b1, r1; float v0, v1;
#define SCAN_LOAD(W, K, A, B, R, V, AD, VD) asm volatile("ds_read_b128 %0, %6\n\tds_read_b128 %1, %6 offset:8192\n\tds_read_b128 %2, %6 offset:16384\n\tds_read_b128 %3, %6 offset:24576\n\tds_read_b128 %4, %6 offset:32768\n\tds_read_b32 %5, %7" \
                    : "=&v"(W), "=&v"(K), "=&v"(A), "=&v"(B), "=&v"(R), "=&v"(V) : "v"(AD), "v"(VD) : "memory")
#define SCAN_WAIT(W, K, A, B, R, V, DEP) asm volatile("s_waitcnt lgkmcnt(0)" : "+v"(W), "+v"(K), "+v"(A), "+v"(B), "+v"(R), "+v"(V), "+v"(DEP) :: "memory")
#define SCAN_STEP(W, K, A, B, R, V, YV) { \
                    f32x2 t = S01 * (f32x2){A[0], A[1]}; t = __builtin_elementwise_fma(S23, (f32x2){A[2], A[3]}, t); \
                    const float d = reduce16(t[0] + t[1]); const f32x2 sa2 = {-d, -d}, v2 = {V, V}; \
                    const f32x2 u01 = __builtin_elementwise_fma(sa2, (f32x2){B[0], B[1]}, v2 * (f32x2){K[0], K[1]}); \
                    const f32x2 u23 = __builtin_elementwise_fma(sa2, (f32x2){B[2], B[3]}, v2 * (f32x2){K[2], K[3]}); \
                    S01 = __builtin_elementwise_fma(S01, (f32x2){W[0], W[1]}, u01); S23 = __builtin_elementwise_fma(S23, (f32x2){W[2], W[3]}, u23); \
                    f32x2 y2 = S01 * (f32x2){R[0], R[1]}; y2 = __builtin_elementwise_fma(S23, (f32x2){R[2], R[3]}, y2); \
                    YV = reduce16(y2[0] + y2[1]); }
                SCAN_LOAD(w0, k0, a0, b0, r0, v0, a_cur, v_cur);
                float yv = 0.f;
#pragma unroll 1
                for (int hh = 0; hh < 2; ++hh) {
                    float yk = 0.f;
#pragma unroll 1
                    for (int s2 = 0; s2 < 16; s2 += 2) {
                        SCAN_WAIT(w0, k0, a0, b0, r0, v0, yv);
                        { const unsigned an = a_cur + 256, vn = v_cur + 64; SCAN_LOAD(w1, k1, a1, b1, r1, v1, an, vn); }
                        SCAN_STEP(w0, k0, a0, b0, r0, v0, yv)
                        yk = (kg == s2) ? yv : yk;
                        SCAN_WAIT(w1, k1, a1, b1, r1, v1, yv);
                        a_cur += 512; v_cur += 128;
                        SCAN_LOAD(w0, k0, a0, b0, r0, v0, a_cur, v_cur);
                        SCAN_STEP(w1, k1, a1, b1, r1, v1, yv)
                        yk = (kg == s2 + 1) ? yv : yk;
                    }
                    if (hh == 0) yk0 = yk; else yk1 = yk;
                }
                SCAN_WAIT(w0, k0, a0, b0, r0, v0, yv);
#undef SCAN_LOAD
#undef SCAN_WAIT
#undef SCAN_STEP
            }
            sY[kg * 16 + row] = yk0; sY[(16 + kg) * 16 + row] = yk1;
            __syncthreads();
            if (tid < 64) {
                const float* yp = sY + (tid >> 1) * 16 + (tid & 1) * 8;
                const float4 a = *(const float4*)yp, c = *(const float4*)(yp + 4);
                uint4 w; w.x = pk2(a.x, a.y); w.y = pk2(a.z, a.w); w.z = pk2(c.x, c.y); w.w = pk2(c.z, c.w);
                *(uint4*)(Y + (tok0 + ch * 32 + (tid >> 1)) * 1024 + h * 64 + qt * 16 + (tid & 1) * 8) = w;
            }
        }
        __syncthreads();
    }
}

__device__ void post_phase(const Params& p, int layer) {
#ifdef NO_POST
    return;
#endif

    bf16_t* H = (bf16_t*)(p.ws + WS_H); const bf16_t* P = (const bf16_t*)(p.ws + WS_P); const float* RK = (const float*)(p.ws + WS_RK);
    const float* lg = p.in[15] + (size_t)layer * 768; const float* lb = p.in[16] + (size_t)layer * 768;
    const int tid = opaque_tid(), cg4 = (tid & 15) * 4;
    const int npairs = T * 12;
    for (int pr = blockIdx.x * 16 + (tid >> 4); pr < npairs; pr += gridDim.x * 16) {
        const int tok = pr / 12, h = pr - tok * 12, hc = h * 64 + cg4;
        bf16_t* yp = H + (size_t)tok * 1024 + hc;
        const uint2 y2 = *(const uint2*)yp, v2 = *(const uint2*)(P + (size_t)tok * LDP + 1536 + hc);
        const float y[4] = {bflo(y2.x), bfhi(y2.x), bflo(y2.y), bfhi(y2.y)}, v[4] = {bflo(v2.x), bfhi(v2.x), bflo(v2.y), bfhi(v2.y)};
        const float mean = reduce16((y[0] + y[1]) + (y[2] + y[3])) * (1.f / 64.f);
        float q = 0.f;
#pragma unroll
        for (int j = 0; j < 4; ++j) { const float d = y[j] - mean; q += d * d; }
        const float rstd = rsqrtf(reduce16(q) * (1.f / 64.f) + 64e-5f);
        const float rk = RK[(size_t)tok * 12 + h];
        const float4 g4 = *(const float4*)(lg + hc), b4 = *(const float4*)(lb + hc);
        const float g[4] = {g4.x, g4.y, g4.z, g4.w}, bb[4] = {b4.x, b4.y, b4.z, b4.w};
        float o[4];
#pragma unroll
        for (int j = 0; j < 4; ++j) o[j] = (y[j] - mean) * rstd * g[j] + bb[j] + rk * v[j];
        uint2 w; w.x = pk2(o[0], o[1]); w.y = pk2(o[2], o[3]);
        *(uint2*)yp = w;
    }
}

__device__ void subnorm_phase(const Params& p, int j) {
#ifdef NO_SUB
    return;
#endif

    const bf16_t* PB = (const bf16_t*)(p.ws + WS_PROJB); bf16_t* CQ = (bf16_t*)(p.ws + WS_CQ);
    const float* CKR = (const float*)(p.ws + WS_CKR); bf16_t* CKV = (bf16_t*)(p.ws + WS_CKV); bf16_t* KF = (bf16_t*)(p.ws + WS_KFULL);
    const float* rope = (const float*)(p.ws + WS_ROPE);
    const float* gq = p.in[32] + (size_t)j * 512; const float* gl = p.in[28];
    const int tid_ = opaque_tid(), lane = tid_ & 63, gw = blockIdx.x * 4 + (tid_ >> 6), nw = gridDim.x * 4;
    for (int tok = gw; tok < T; tok += nw) {
        {
            const uint4 c = *(const uint4*)(PB + (size_t)tok * 768 + lane * 8);
            float v[8] = {bflo(c.x), bfhi(c.x), bflo(c.y), bfhi(c.y), bflo(c.z), bfhi(c.z), bflo(c.w), bfhi(c.w)};
            float ss = 0.f;
#pragma unroll
            for (int i = 0; i < 8; ++i) ss += v[i] * v[i];
            ss = wave_sum(ss);
            const float rs = rsqrtf(ss * (1.f / 512.f) + 1e-6f);
            const float4 g0 = *(const float4*)(gq + lane * 8), g1 = *(const float4*)(gq + lane * 8 + 4);
            uint4 w; w.x = pk2(v[0] * rs * g0.x, v[1] * rs * g0.y); w.y = pk2(v[2] * rs * g0.z, v[3] * rs * g0.w);
            w.z = pk2(v[4] * rs * g1.x, v[5] * rs * g1.y); w.w = pk2(v[6] * rs * g1.z, v[7] * rs * g1.w);
            *(uint4*)(CQ + (size_t)tok * 512 + lane * 8) = w;
        }
        if (j == 0) {
            const float4 c = *(const float4*)(CKR + (size_t)tok * 384 + lane * 4);
            float ss = c.x * c.x + c.y * c.y + c.z * c.z + c.w * c.w;
            ss = wave_sum(ss);
            const float rs = rsqrtf(ss * (1.f / 256.f) + 1e-6f);
            const float4 g = *(const float4*)(gl + lane * 4);
            uint2 w; w.x = pk2(c.x * rs * g.x, c.y * rs * g.y); w.y = pk2(c.z * rs * g.z, c.w * rs * g.w);
            *(uint2*)(CKV + (size_t)tok * 256 + lane * 4) = w;
            const int i = lane & 15, hg = lane >> 4;
            const float x1 = CKR[(size_t)tok * 384 + 256 + i], x2 = CKR[(size_t)tok * 384 + 272 + i];
            const float cs = rope[(size_t)tok * 32 + i], sn = rope[(size_t)tok * 32 + 16 + i];
            const bf16_t o1 = f2bf(x1 * cs - x2 * sn), o2 = f2bf(x2 * cs + x1 * sn);
            const int b = tok >> 13, s = tok & (S - 1);
#pragma unroll
            for (int hh = 0; hh < 3; ++hh) {
                bf16_t* kp = KF + ((size_t)(b * 12 + hg * 3 + hh) * S + s) * 96 + 64 + i;
                kp[0] = o1; kp[16] = o2;
            }
        }
    }
}

__device__ void rope_phase(const Params& p) {
    const int* pos = (const int*)p.in[2]; float* rope = (float*)(p.ws + WS_ROPE);
    for (int idx = blockIdx.x * 256 + threadIdx.x; idx < T * 16; idx += gridDim.x * 256) {
        const int tok = idx >> 4, i = idx & 15;
        const float invf = powf(10000.f, -(float)i / 16.f);
        const float ang = (float)pos[tok] * invf;
        rope[(size_t)tok * 32 + i] = cosf(ang); rope[(size_t)tok * 32 + 16 + i] = sinf(ang);
    }
}

__device__ bool get_gemm_job(const Params& p, int ph, int jn, GemmJob& g) {
    char* ws = p.ws;
    bf16_t* WA = (bf16_t*)(ws + WS_WA); bf16_t* WF = (bf16_t*)(ws + WS_WF); bf16_t* H = (bf16_t*)(ws + WS_H); bf16_t* P = (bf16_t*)(ws + WS_P);
    bf16_t* LIN = (bf16_t*)(ws + WS_LIN); bf16_t* KMEM = (bf16_t*)(ws + WS_KMEM); bf16_t* VTMEM = (bf16_t*)(ws + WS_VTMEM); bf16_t* MEMN = (bf16_t*)(ws + WS_MEMN);
    g.M = T; g.e.o1 = nullptr; g.e.bias = nullptr; g.e.resid = nullptr; g.e.halo = nullptr; g.e.ldc = 0;
    const bool rw = ph < 25;
    const int L = rw ? (ph - 1) / 12 : 2 + (ph - 25) / 9, r = rw ? (ph - 1) % 12 : (ph - 25) % 9;
    const int r_wout = rw ? 8 : 5, r_gu = rw ? 10 : 7, r_down = rw ? 11 : 8;
    if (r == r_wout) { if (jn) return false; g.A = H; g.lda = 1024; g.W = WA + (rw ? A_WOUT : B_WOUT); g.K = 1024; g.N = 1024; g.kind = E_RESID; g.e.o0 = p.out; g.e.resid = (L == 0) ? p.in[0] : p.out; g.e.ldc = 1024; return true; }
    if (r == r_gu) { if (jn) return false; g.A = H; g.lda = 1024; g.W = WF + F_GU; g.K = 1024; g.N = 5632; g.kind = E_SWIGLU; g.e.o0 = P; g.e.ldc = 2816; return true; }
    if (r == r_down) { if (jn) return false; g.A = P; g.lda = 2816; g.W = WF + F_DOWN; g.K = 2816; g.N = 1024; g.kind = E_RESID; g.e.o0 = p.out; g.e.resid = p.out; g.e.ldc = 1024; return true; }
    if (r == 1 && jn == 1) { g.A = MEMN; g.lda = 1024; g.W = WA + (rw ? A_MKV : B_MKV); g.K = 1024; g.M = 1024; g.N = 512; g.kind = E_MEMKV; g.e.o0 = KMEM; g.e.o1 = VTMEM; return true; }
    if (rw) {
        const int i = L;
        if (r == 1 && jn == 0) { g.A = H; g.lda = 1024; g.W = WA + A_WIN; g.K = 1024; g.N = (i == 1) ? 2944 : 2816; g.kind = E_BF16; g.e.o0 = P; g.e.ldc = LDP; g.e.halo = (bf16_t*)(ws + WS_HALO); return true; }
        if (r == 3) {
            if (jn == 0) { g.A = LIN; g.lda = 320; g.W = WA + A_DEC; g.K = 64; g.N = 768; g.kind = E_DECAY; g.e.o0 = ws + WS_Z; g.e.bias = p.in[8] + (size_t)i * 768; g.e.ldc = 768; return true; }
            if (jn == 1) { g.A = LIN + 64; g.lda = 320; g.W = WA + A_AAA; g.K = 64; g.N = 768; g.kind = E_SIGB; g.e.o0 = ws + WS_Z + ZSZ; g.e.bias = p.in[10] + (size_t)i * 768; g.e.ldc = 768; return true; }
            if (jn == 2 && i == 1) { g.A = LIN + 256; g.lda = 320; g.W = WA + A_VUP; g.K = 64; g.N = 768; g.kind = E_SIGB; g.e.o0 = ws + WS_Z + 2 * ZSZ; g.e.bias = p.in[25]; g.e.ldc = 768; return true; }
            return false;
        }
        if (r == 7 && jn == 0) { g.A = LIN + 128; g.lda = 320; g.W = WA + A_GATE; g.K = 128; g.N = 768; g.kind = E_MULG; g.e.o0 = H; g.e.ldc = 1024; return true; }
        return false;
    }
    const int j = L - 2;
    if (r == 1) {
        if (jn == 0) { g.A = H; g.lda = 1024; g.W = WA + B_WIN; g.K = 1024; g.N = 768; g.kind = E_BF16; g.e.o0 = ws + WS_PROJB; g.e.ldc = 768; return true; }
        if (jn == 2 && j == 0) { g.A = (bf16_t*)(ws + WS_QFULL); g.lda = 1024; g.W = WA + B_KVD; g.K = 1024; g.N = 384; g.kind = E_F32; g.e.o0 = ws + WS_CKR; g.e.ldc = 384; return true; }
        return false;
    }
    if (r == 3) {
        if (jn == 0) { g.A = (bf16_t*)(ws + WS_CQ); g.lda = 512; g.W = WA + B_QUP; g.K = 512; g.N = 1152; g.kind = E_BF16; g.e.o0 = ws + WS_QFULL; g.e.ldc = 1152; return true; }
        if (jn == 1 && j == 0) { g.A = (bf16_t*)(ws + WS_CKV); g.lda = 256; g.W = WA + B_KVU; g.K = 256; g.N = 1536; g.kind = E_KV; g.e.o0 = ws + WS_KFULL; g.e.o1 = ws + WS_VT; return true; }
        return false;
    }
    return false;
}

__device__ void run_phase(const Params& p, int ph, char* smem) {
    char* ws = p.ws;
    bf16_t* H = (bf16_t*)(ws + WS_H);
    const float MEMSCL = 0.125f * 1.4426950408889634f, MLASCL = 0.10206207261596575f * 1.4426950408889634f;
    int rot = 0;
    const bool rw = ph >= 1 && ph < 25, mla = ph >= 25 && ph < 43;
    const int L = rw ? (ph - 1) / 12 : (mla ? 2 + (ph - 25) / 9 : 0), r = rw ? (ph - 1) % 12 : (mla ? (ph - 25) % 9 : -1);
    {
        const float* x = nullptr; int nrows = T; const float* g1 = nullptr; bf16_t* o1 = H; const float* g2 = nullptr; bf16_t* o2 = nullptr; float* of = nullptr;
        if (ph == 0) { x = p.in[1]; nrows = 1024; g1 = p.in[3]; o1 = (bf16_t*)(ws + WS_MEMN); }
        else if (ph == 43) { x = p.out; g1 = p.in[39]; of = p.out; }
        else if (rw && r == 0) { x = (L == 0) ? p.in[0] : p.out; g1 = p.in[4] + (size_t)L * 1024; }
        else if (rw && r == 9) { x = p.out; g1 = p.in[19] + (size_t)L * 1024; }
        else if (mla && r == 0) { x = p.out; g1 = p.in[30] + (size_t)(L - 2) * 1024; if (L == 2) { g2 = p.in[26]; o2 = (bf16_t*)(ws + WS_QFULL); } }
        else if (mla && r == 6) { x = p.out; g1 = p.in[36] + (size_t)(L - 2) * 1024; }
        if (x) rmsnorm_phase(x, nrows, g1, o1, g2, o2, of);
    }
    if (ph == 0) rope_phase(p);
    {
        int kind = -1, CL = 0;
        if (ph == 0) { kind = 0; CL = 0; }
        else if ((rw || mla) && r == 0) { kind = 1; CL = L; }
        else if (rw && r == 9) { kind = 0; CL = L + 1; }
        else if (mla && r == 6 && L == 2) { kind = 0; CL = 3; }
        if (kind >= 0) { ConvJob c; for (int idx = 0; get_conv_job(p, kind, CL, idx, c); ++idx) run_conv(c, rot, smem); }
    }
    { GemmJob g; for (int jn = 0; jn < 3; ++jn) if (get_gemm_job(p, ph, jn, g)) gemm_job(g, rot, smem); }
    if ((rw || mla) && r == 3) {
        const bf16_t* Q = rw ? (const bf16_t*)(ws + WS_P) : (const bf16_t*)(ws + WS_PROJB);
        attn_phase<64, false>(Q, rw ? LDP : 768, rw ? 2560 : 512, (const bf16_t*)(ws + WS_KMEM), 256 * 64, (const bf16_t*)(ws + WS_VTMEM), 64 * 256, 256, 4, 256, nullptr, MEMSCL, H, 1024, 768, rot, smem);
    }
    if (mla && r == 4)
        attn_phase<96, true>((const bf16_t*)(ws + WS_QFULL), 1152, 0, (const bf16_t*)(ws + WS_KFULL), (size_t)S * 96, (const bf16_t*)(ws + WS_VT), (size_t)64 * S, S, 12, S, (const float*)(ws + WS_ROPE), MLASCL, H, 1024, 0, rot, smem);
    if (rw && r == 2) lora_in_phase(p, L);
    if (rw && r == 4) prep_phase(p, L);
    if (rw && r == 5) scan_phase(p, smem);
    if (rw && r == 6) post_phase(p, L);
    if (mla && r == 2) subnorm_phase(p, L - 2);
}

#define XB_TMO      128
#define XB_XCNT(j)  (256  + 64 * (j))
#define XB_XSUB(j)  (1280 + 64 * (j))
#define XB_XGEN(j)  (2304 + 64 * (j))
#define XB_TOP      3328
#define XB_TOPGEN   3392
#define XCD_BAR_WORDS 3456
#define XB_SPIN_CAP (1u << 18)
__device__ __forceinline__ unsigned xb_ld(unsigned* p)              { return __hip_atomic_load(p, __ATOMIC_RELAXED, __HIP_MEMORY_SCOPE_AGENT); }
__device__ __forceinline__ unsigned xb_add(unsigned* p, unsigned v) { return __hip_atomic_fetch_add(p, v, __ATOMIC_RELAXED, __HIP_MEMORY_SCOPE_AGENT); }
__device__ __forceinline__ unsigned xb_xcc_id() { return (unsigned)__builtin_amdgcn_s_getreg((3 << 11) | 20) & 0xFu; }
#define XB_SPIN(cond, bar) do { unsigned _sp = 0; while (cond) { __builtin_amdgcn_s_sleep(1); \
    if ((++_sp & 255u) == 0u) { if (xb_ld(&(bar)[XB_TMO])) break; if (_sp > XB_SPIN_CAP) { atomicAdd(&(bar)[XB_TMO], 1u); break; } } } } while (0)
struct XcdBarrier { unsigned* bar; unsigned x; volatile LAS unsigned* st; };
__device__ __forceinline__ XcdBarrier xcd_barrier_post(unsigned* bar, volatile LAS unsigned* st) {
    XcdBarrier b; b.bar = bar; b.x = xb_xcc_id(); b.st = st;
    if (threadIdx.x == 0) (void)xb_add(&bar[XB_XCNT(b.x)], 1u);
    return b;
}
__device__ __forceinline__ void xcd_barrier_complete(unsigned* bar, unsigned x, unsigned& nloc, unsigned& nx) {
    const unsigned G = gridDim.x * gridDim.y * gridDim.z;
    unsigned sum, cnt, mine, sp = 0u;
    for (;;) {
        sum = 0u; cnt = 0u; mine = 0u;
#pragma unroll
        for (unsigned j = 0; j < 16; ++j) { const unsigned c = xb_ld(&bar[XB_XCNT(j)]); sum += c; cnt += (c > 0u) ? 1u : 0u; mine = (j == x) ? c : mine; }
        if (sum == G) break;
        __builtin_amdgcn_s_sleep(1);
        if ((++sp & 255u) == 0u) { if (xb_ld(&bar[XB_TMO])) break; if (sp > XB_SPIN_CAP) { atomicAdd(&bar[XB_TMO], 1u); break; } }
    }
    nloc = mine > 0u ? mine : 1u; nx = cnt > 0u ? cnt : 1u;
}
__device__ __forceinline__ void xcd_barrier(const XcdBarrier& b) {
    asm volatile("s_waitcnt vmcnt(0)" ::: "memory");
    __syncthreads();
    if (threadIdx.x == 0) {
        unsigned* bar = b.bar;
        __builtin_amdgcn_s_waitcnt(0);
        unsigned nloc = b.st[0], nx = b.st[1];
        if (nloc == 0u) { xcd_barrier_complete(bar, b.x, nloc, nx); b.st[0] = nloc; b.st[1] = nx; }
        const unsigned old = xb_add(&bar[XB_XSUB(b.x)], 1u);
        const unsigned gen = old / nloc;
        if (old + 1u == (gen + 1u) * nloc) {
            __builtin_amdgcn_fence(__ATOMIC_RELEASE, "agent");
            asm volatile("s_waitcnt vmcnt(0)" ::: "memory");
            const unsigned og = xb_add(&bar[XB_TOP], 1u);
            const unsigned tg = og / nx;
            if (og + 1u == (tg + 1u) * nx) xb_add(&bar[XB_TOPGEN], 1u);
            else XB_SPIN(xb_ld(&bar[XB_TOPGEN]) == tg, bar);
            __builtin_amdgcn_fence(__ATOMIC_ACQUIRE, "agent");
            xb_add(&bar[XB_XGEN(b.x)], 1u);
            asm volatile("s_waitcnt vmcnt(0)" ::: "memory");
        } else {
            XB_SPIN(xb_ld(&bar[XB_XGEN(b.x)]) == gen, bar);
            __builtin_amdgcn_fence(__ATOMIC_ACQUIRE, "agent");
            asm volatile("s_waitcnt vmcnt(0)" ::: "memory");
        }
    }
    __syncthreads();
}

__global__ void __launch_bounds__(256, 2) yoco_mega(Params p) {
    extern __shared__ __attribute__((aligned(16))) char smem[];
    cg::grid_group grid = cg::this_grid();
    volatile LAS unsigned* st = (volatile LAS unsigned*)((LAS char*)smem + 73728);
    if (threadIdx.x == 0) { st[0] = 0u; st[1] = 0u; }
    __syncthreads();
    const XcdBarrier xb = xcd_barrier_post((unsigned*)(p.ws + WS_BAR), st);
    if (p.ph_lo < 0) grid.sync();
    for (int ph = p.ph_lo; ph < p.ph_hi; ++ph) {
        int nrep = 1;
#if PROBE_DUP
        {
            const bool rw = ph >= 1 && ph < 25, mla = ph >= 25 && ph < 43;
            const int r = rw ? (ph - 1) % 12 : (mla ? (ph - 25) % 9 : -1);
            if ((PROBE_DUP & 1) && rw && r == 5) nrep = 2;
            if ((PROBE_DUP & 2) && ((rw && r == 10) || (mla && r == 7))) nrep = 2;
            if ((PROBE_DUP & 4) && mla && r == 4) nrep = 2;
            if ((PROBE_DUP & 8) && rw && r == 3) nrep = 2;
            if ((PROBE_DUP & 16) && ((rw && (r == 0 || r == 9)) || (mla && (r == 0 || r == 6)))) nrep = 2;
            if ((PROBE_DUP & 32) && ((rw && r == 2) || (mla && (r == 2 || r == 3)))) nrep = 2;
        }
#endif
        for (int rep = 0; rep < nrep; ++rep) {
            run_phase(p, ph, smem);
            if (rep + 1 < nrep || ph + 1 < p.ph_hi) xcd_barrier(xb);
        }
    }
}

#ifndef PROBE_DUP
#define PROBE_DUP 0
#endif
#ifndef MULTI_LAUNCH
#define MULTI_LAUNCH 0
#endif

extern "C" void kernel_launch(void* const* d_in, const int* in_sizes, int n_in, void* d_out, int out_size, void* d_ws, size_t ws_size, hipStream_t stream) {
    static int grid_blocks = 0;
    if (!grid_blocks) {
        int dev = 0, cus = 0, per_cu = 0;
        hipGetDevice(&dev);
        hipDeviceGetAttribute(&cus, hipDeviceAttributeMultiprocessorCount, dev);
        hipFuncSetAttribute((const void*)yoco_mega, hipFuncAttributeMaxDynamicSharedMemorySize, LDS_BYTES);
        hipOccupancyMaxActiveBlocksPerMultiprocessor(&per_cu, (const void*)yoco_mega, 256, LDS_BYTES);
        if (per_cu < 1) per_cu = 1;
        if (per_cu > 2) per_cu = 2;
        grid_blocks = cus * per_cu;
        if (ws_size < WS_END) fprintf(stderr, "kernel_launch: workspace too small: %zu < %zu\n", ws_size, (size_t)WS_END);
        if (n_in != 40) fprintf(stderr, "kernel_launch: expected 40 inputs, got %d\n", n_in);
    }
    Params p{};
    for (int i = 0; i < 40; ++i) p.in[i] = (const float*)d_in[i];
    p.out = (float*)d_out; p.ws = (char*)d_ws;
#if MULTI_LAUNCH
    for (int ph = 0; ph < 44; ++ph) {
        p.ph_lo = ph; p.ph_hi = ph + 1;
        hipLaunchKernelGGL(yoco_mega, dim3(grid_blocks), dim3(256), LDS_BYTES, stream, p);
    }
#else
    p.ph_lo = 0; p.ph_hi = 44;
    (void)hipMemsetAsync((char*)d_ws + WS_BAR, 0, 16384, stream);
    void* args[] = {&p};
    hipError_t e = hipLaunchCooperativeKernel((const void*)yoco_mega, dim3(grid_blocks), dim3(256), args, LDS_BYTES, stream);
    if (e != hipSuccess) fprintf(stderr, "cooperative launch failed: %s (grid %d)\n", hipGetErrorString(e), grid_blocks);
#endif
}
```

```cpp
#include <hip/hip_runtime.h>
#include <hip/hip_cooperative_groups.h>
#include <cstdio>
#include <cstdint>
namespace cg = cooperative_groups;
#define PROBE_DUP 0

typedef unsigned short bf16_t;
typedef short bf16x8 __attribute__((ext_vector_type(8)));
typedef float f32x16 __attribute__((ext_vector_type(16)));
typedef _Float16 h8 __attribute__((ext_vector_type(8)));
typedef unsigned u32x4 __attribute__((ext_vector_type(4)));
typedef float f32x2 __attribute__((ext_vector_type(2)));
#define LAS __attribute__((address_space(3)))
typedef float f32x4 __attribute__((ext_vector_type(4)));

constexpr int T = 32768, S = 8192;
constexpr int LDP = 2944;
constexpr int LDS_BYTES = 73728 + 16;

constexpr size_t WS_WA = 0;
constexpr size_t WS_WF = WS_WA + 10485760;
constexpr size_t WS_H = WS_WF + 17825792;
constexpr size_t WS_P = WS_H + 67108864;
constexpr size_t WS_Z = WS_P + 192937984;
constexpr size_t ZSZ = 50331648;
constexpr size_t WS_LIN = WS_Z + 4 * ZSZ;
constexpr size_t WS_RK = WS_LIN + 20971520;
constexpr size_t WS_ROPE = WS_RK + 1572864;
constexpr size_t WS_KMEM = WS_ROPE + 4194304;
constexpr size_t WS_VTMEM = WS_KMEM + 524288;
constexpr size_t WS_MEMN = WS_VTMEM + 524288;
constexpr size_t WS_HALO = WS_MEMN + 2097152;
constexpr size_t WS_BAR = WS_HALO + 1507328;
constexpr size_t WS_END = WS_BAR + 16384;
constexpr size_t WS_KFULL = WS_Z;
constexpr size_t WS_VT = WS_KFULL + 75497472;
constexpr size_t WS_PROJB = WS_VT + 50331648;
constexpr size_t WS_QFULL = WS_P;
constexpr size_t WS_CQ = WS_QFULL + 75497472;
constexpr size_t WS_CKR = WS_CQ + 33554432;
constexpr size_t WS_CKV = WS_CKR + 50331648;
constexpr size_t A_WIN = 0, A_DEC = 3014656, A_AAA = 3063808, A_GATE = 3112960, A_VUP = 3211264, A_MKV = 3260416, A_WOUT = 3784704;
constexpr size_t B_WIN = 0, B_QUP = 786432, B_MKV = 1376256, B_WOUT = 1900544, B_KVD = 2949120, B_KVU = 3342336;
constexpr size_t F_GU = 0, F_DOWN = 5767168;

struct Params { const float* in[40]; float* out; char* ws; int ph_lo, ph_hi; };

__device__ __forceinline__ bf16_t f2bf(float f) { unsigned u = __float_as_uint(f); u += 0x7fffu + ((u >> 16) & 1u); return (bf16_t)(u >> 16); }
__device__ __forceinline__ unsigned pk2(float lo, float hi) { return (unsigned)f2bf(lo) | ((unsigned)f2bf(hi) << 16); }
__device__ __forceinline__ float bflo(unsigned u) { return __uint_as_float(u << 16); }
__device__ __forceinline__ float bfhi(unsigned u) { return __uint_as_float(u & 0xffff0000u); }
__device__ __forceinline__ float bf2f(bf16_t v) { return __uint_as_float((unsigned)v << 16); }
__device__ __forceinline__ float wave_sum(float v) {
#pragma unroll
    for (int o = 32; o; o >>= 1) v += __shfl_xor(v, o);
    return v;
}
template <int CTRL> __device__ __forceinline__ float dppmov(float x) { return __int_as_float(__builtin_amdgcn_update_dpp(0, __float_as_int(x), CTRL, 0xF, 0xF, true)); }
__device__ __forceinline__ float reduce16(float x) {
    x += dppmov<0xB1>(x); x += dppmov<0x4E>(x); x += dppmov<0x141>(x); x += dppmov<0x140>(x); return x;
}
__device__ __forceinline__ int opaque_tid() { int t = threadIdx.x; asm volatile("" : "+v"(t)); return t; }
__device__ __forceinline__ float sigmoidf_(float x) { return 1.f / (1.f + __expf(-x)); }

__device__ void rmsnorm_phase(const float* x, int nrows, const float* g1, bf16_t* o1, const float* g2, bf16_t* o2, float* of) {
    const int tid_ = opaque_tid(), lane = tid_ & 63, gw = blockIdx.x * 4 + (tid_ >> 6), nw = gridDim.x * 4;
    for (int row = gw; row < nrows; row += nw) {
        const float4* xr = (const float4*)(x + (size_t)row * 1024);
        float4 v[4]; float ss = 0.f;
#pragma unroll
        for (int i = 0; i < 4; ++i) { v[i] = xr[lane + 64 * i]; ss += v[i].x * v[i].x + v[i].y * v[i].y + v[i].z * v[i].z + v[i].w * v[i].w; }
        ss = wave_sum(ss);
        const float rs = rsqrtf(ss * (1.f / 1024.f) + 1e-6f);
#pragma unroll
        for (int i = 0; i < 4; ++i) {
            const float4 g = ((const float4*)g1)[lane + 64 * i];
            const float a = v[i].x * rs, b = v[i].y * rs, c = v[i].z * rs, d = v[i].w * rs;
            if (of) { float4 o; o.x = a * g.x; o.y = b * g.y; o.z = c * g.z; o.w = d * g.w; ((float4*)(of + (size_t)row * 1024))[lane + 64 * i] = o; }
            else {
                uint2 w; w.x = pk2(a * g.x, b * g.y); w.y = pk2(c * g.z, d * g.w);
                *(uint2*)(o1 + (size_t)row * 1024 + (lane + 64 * i) * 4) = w;
                if (o2) { const float4 h = ((const float4*)g2)[lane + 64 * i]; uint2 w2; w2.x = pk2(a * h.x, b * h.y); w2.y = pk2(c * h.z, d * h.w);
                    *(uint2*)(o2 + (size_t)row * 1024 + (lane + 64 * i) * 4) = w2; }
            }
        }
    }
}

struct ConvJob { const float* src; int ld; int ncols; int kvalid; bf16_t* dst; int dstK; int ngran; int swiglu; const float* rscale; int rsmode; };
__device__ void run_conv(const ConvJob& j, int& rot, char* smem, int vb, int G) {
#ifdef NO_CONV
    return;
#endif

    bf16_t* lds = (bf16_t*)smem;
    const int tid = opaque_tid(), nkt = j.dstK >> 6, units = j.ngran * nkt;
    for (int u = (vb + G - rot) % G; u < units; u += G) {
        const int g = u / nkt, kt = u - g * nkt, k0 = kt * 64;
        int col0 = j.swiglu ? ((g & 1) * 2816 + 32 * (g >> 1)) : 32 * g;
        const bool colok = (col0 + 32 <= j.ncols);
#pragma unroll
        for (int i = 0; i < 8; ++i) {
            const int kr = (tid >> 5) + 8 * i, c = tid & 31, k = k0 + kr;
            float v = 0.f;
            if (colok && k < j.kvalid) {
                v = j.src[(size_t)k * j.ld + col0 + c];
                if (j.rsmode == 1) v *= (1.f - j.rscale[k]); else if (j.rsmode == 2) v *= j.rscale[k];
            }
            lds[c * 72 + kr] = f2bf(v);
        }
        __syncthreads();
        { const int c = tid >> 3, kc = (tid & 7) * 8;
          const uint4 w = *(const uint4*)(lds + c * 72 + kc);
          *(uint4*)(j.dst + (size_t)(g * 32 + c) * j.dstK + k0 + kc) = w; }
        __syncthreads();
    }
    rot = (rot + units) % G;
}
__device__ bool get_conv_job(const Params& p, int kind, int L, int idx, ConvJob& c) {
    bf16_t* WA = (bf16_t*)(p.ws + WS_WA); bf16_t* WF = (bf16_t*)(p.ws + WS_WF);
    c.swiglu = 0; c.rscale = nullptr; c.rsmode = 0;
    if (kind == 1) {
        if (idx == 0) { c.src = (L < 2) ? p.in[20] + (size_t)L * 1024 * 5632 : p.in[37] + (size_t)(L - 2) * 1024 * 5632; c.ld = 5632; c.ncols = 5632; c.kvalid = 1024; c.dst = WF + F_GU; c.dstK = 1024; c.ngran = 176; c.swiglu = 1; return true; }
        if (idx == 1) { c.src = (L < 2) ? p.in[21] + (size_t)L * 2816 * 1024 : p.in[38] + (size_t)(L - 2) * 2816 * 1024; c.ld = 1024; c.ncols = 1024; c.kvalid = 2816; c.dst = WF + F_DOWN; c.dstK = 2816; c.ngran = 32; return true; }
        return false;
    }
    if (L < 2) {
        const int i = L;
        switch (idx) {
        case 0: c.src = p.in[5] + (size_t)i * 1024 * 2816; c.ld = 2816; c.ncols = 2816; c.kvalid = 1024; c.dst = WA + A_WIN; c.dstK = 1024; c.ngran = 88; return true;
        case 1: c.src = p.in[7] + (size_t)i * 64 * 768; c.ld = 768; c.ncols = 768; c.kvalid = 64; c.dst = WA + A_DEC; c.dstK = 64; c.ngran = 24; return true;
        case 2: c.src = p.in[9] + (size_t)i * 64 * 768; c.ld = 768; c.ncols = 768; c.kvalid = 64; c.dst = WA + A_AAA; c.dstK = 64; c.ngran = 24; return true;
        case 3: c.src = p.in[11] + (size_t)i * 128 * 768; c.ld = 768; c.ncols = 768; c.kvalid = 128; c.dst = WA + A_GATE; c.dstK = 128; c.ngran = 24; return true;
        case 4: c.src = p.in[17] + (size_t)i * 1024 * 512; c.ld = 512; c.ncols = 512; c.kvalid = 1024; c.dst = WA + A_MKV; c.dstK = 1024; c.ngran = 16; return true;
        case 5: c.src = p.in[18] + (size_t)i * 1024 * 1024; c.ld = 1024; c.ncols = 1024; c.kvalid = 1024; c.dst = WA + A_WOUT; c.dstK = 1024; c.ngran = 32; return true;
        }
        if (i == 0) return false;
        switch (idx) {
        case 6: c.src = p.in[23]; c.ld = 32; c.ncols = 32; c.kvalid = 1024; c.dst = WA + A_WIN + (size_t)2816 * 1024; c.dstK = 1024; c.ngran = 1; c.rscale = p.in[22]; c.rsmode = 1; return true;
        case 7: c.src = p.in[23]; c.ld = 32; c.ncols = 32; c.kvalid = 1024; c.dst = WA + A_WIN + (size_t)2848 * 1024; c.dstK = 1024; c.ngran = 1; c.rscale = p.in[22]; c.rsmode = 2; return true;
        case 8: c.src = p.in[23]; c.ld = 32; c.ncols = 0; c.kvalid = 1024; c.dst = WA + A_WIN + (size_t)2880 * 1024; c.dstK = 1024; c.ngran = 2; return true;
        case 9: c.src = p.in[24]; c.ld = 768; c.ncols = 768; c.kvalid = 32; c.dst = WA + A_VUP; c.dstK = 64; c.ngran = 24; return true;
        }
        return false;
    }
    const int j = L - 2;
    switch (idx) {
    case 0: c.src = p.in[31] + (size_t)j * 1024 * 768; c.ld = 768; c.ncols = 768; c.kvalid = 1024; c.dst = WA + B_WIN; c.dstK = 1024; c.ngran = 24; return true;
    case 1: c.src = p.in[33] + (size_t)j * 512 * 1152; c.ld = 1152; c.ncols = 1152; c.kvalid = 512; c.dst = WA + B_QUP; c.dstK = 512; c.ngran = 36; return true;
    case 2: c.src = p.in[34] + (size_t)j * 1024 * 512; c.ld = 512; c.ncols = 512; c.kvalid = 1024; c.dst = WA + B_MKV; c.dstK = 1024; c.ngran = 16; return true;
    case 3: c.src = p.in[35] + (size_t)j * 1024 * 1024; c.ld = 1024; c.ncols = 1024; c.kvalid = 1024; c.dst = WA + B_WOUT; c.dstK = 1024; c.ngran = 32; return true;
    }
    if (j != 0) return false;
    if (idx == 4) { c.src = p.in[27]; c.ld = 288; c.ncols = 288; c.kvalid = 1024; c.dst = WA + B_KVD; c.dstK = 1024; c.ngran = 12; return true; }
    if (idx == 5) { c.src = p.in[29]; c.ld = 1536; c.ncols = 1536; c.kvalid = 256; c.dst = WA + B_KVU; c.dstK = 256; c.ngran = 48; return true; }
    return false;
}

enum { E_BF16 = 0, E_F32, E_RESID, E_SWIGLU, E_DECAY, E_SIGB, E_KV, E_MEMKV, E_MULG };
struct Epi { void* o0; void* o1; const float* bias; const float* resid; int ldc; bf16_t* halo; };
struct GemmJob { const bf16_t* A; int lda; const bf16_t* W; int K, M, N, kind; Epi e; };

template <int E, int MI> __device__ __forceinline__ void epilogue(const f32x16 (&acc)[MI][2], int m0, int n0, int wm, int wn, int lane, const Epi& e) {
    const int half = lane >> 5, l31 = lane & 31;
    if (E == E_SWIGLU) {
        bf16_t* o = (bf16_t*)e.o0; const int col = (n0 >> 1) + wn * 32 + l31;
#pragma unroll
        for (int mi = 0; mi < MI; ++mi)
#pragma unroll
            for (int i = 0; i < 16; ++i) {
                const int row = m0 + wm * (MI * 32) + mi * 32 + 8 * (i >> 2) + 4 * half + (i & 3);
                const float g = acc[mi][0][i], u = acc[mi][1][i];
                o[(size_t)row * 2816 + col] = f2bf(g * sigmoidf_(g) * u);
            }
        return;
    }
#pragma unroll
    for (int mi = 0; mi < MI; ++mi)
#pragma unroll
        for (int ni = 0; ni < 2; ++ni) {
            const int col = n0 + wn * 64 + ni * 32 + l31;
            const int rbase = m0 + wm * (MI * 32) + mi * 32 + 4 * half;
            if (E == E_KV || E == E_MEMKV) {
                const bool isv = (E == E_KV) ? ((col & 127) >= 64) : (col >= 256);
                if (isv) {
#pragma unroll
                    for (int g = 0; g < 4; ++g) {
                        const int row = rbase + 8 * g;
                        uint2 w; w.x = pk2(acc[mi][ni][4 * g], acc[mi][ni][4 * g + 1]); w.y = pk2(acc[mi][ni][4 * g + 2], acc[mi][ni][4 * g + 3]);
                        size_t idx;
                        if (E == E_KV) { const int b = row >> 13, s = row & 8191, head = col >> 7, d = (col & 127) - 64; idx = ((size_t)(b * 12 + head) * 64 + d) * 8192 + s; }
                        else { const int b = row >> 8, mi_ = row & 255, head = (col - 256) >> 6, d = col & 63; idx = ((size_t)(b * 4 + head) * 64 + d) * 256 + mi_; }
                        *(uint2*)((bf16_t*)e.o1 + idx) = w;
                    }
                } else {
#pragma unroll
                    for (int i = 0; i < 16; ++i) {
                        const int row = rbase + 8 * (i >> 2) + (i & 3);
                        size_t idx;
                        if (E == E_KV) { const int b = row >> 13, s = row & 8191, head = col >> 7, c = col & 127; idx = ((size_t)(b * 12 + head) * 8192 + s) * 96 + c; }
                        else { const int b = row >> 8, mi_ = row & 255, head = col >> 6, d = col & 63; idx = ((size_t)(b * 4 + head) * 256 + mi_) * 64 + d; }
                        ((bf16_t*)e.o0)[idx] = f2bf(acc[mi][ni][i]);
                    }
                }
                continue;
            }
            float bias = 0.f;
            if (E == E_DECAY || E == E_SIGB) bias = e.bias[col];
#pragma unroll
            for (int i = 0; i < 16; ++i) {
                const int row = rbase + 8 * (i >> 2) + (i & 3);
                const float v = acc[mi][ni][i];
                const size_t idx = (size_t)row * e.ldc + col;
                if (E == E_BF16) {
                    const bf16_t b = f2bf(v);
                    ((bf16_t*)e.o0)[idx] = b;
                    if (e.halo && (row & 127) == 127) e.halo[(size_t)(row >> 7) * e.ldc + col] = b;
                } else if (E == E_F32) ((float*)e.o0)[idx] = v;
                else if (E == E_RESID) ((float*)e.o0)[idx] = e.resid[idx] + v;
                else if (E == E_DECAY) ((_Float16*)e.o0)[idx] = (_Float16)(0.60653066f * sigmoidf_(bias + v));
                else if (E == E_SIGB) ((bf16_t*)e.o0)[idx] = f2bf(sigmoidf_(bias + v));
                else if (E == E_MULG) { bf16_t* o = (bf16_t*)e.o0; o[idx] = f2bf(bf2f(o[idx]) * v); }
            }
        }
}

#define EPI_DISPATCH(MI_) switch (gj.kind) { \
        case E_BF16: epilogue<E_BF16, MI_>(acc, m0, n0, wm, wn, lane, e); break; \
        case E_F32: epilogue<E_F32, MI_>(acc, m0, n0, wm, wn, lane, e); break; \
        case E_RESID: epilogue<E_RESID, MI_>(acc, m0, n0, wm, wn, lane, e); break; \
        case E_SWIGLU: epilogue<E_SWIGLU, MI_>(acc, m0, n0, wm, wn, lane, e); break; \
        case E_DECAY: epilogue<E_DECAY, MI_>(acc, m0, n0, wm, wn, lane, e); break; \
        case E_SIGB: epilogue<E_SIGB, MI_>(acc, m0, n0, wm, wn, lane, e); break; \
        case E_KV: epilogue<E_KV, MI_>(acc, m0, n0, wm, wn, lane, e); break; \
        case E_MEMKV: epilogue<E_MEMKV, MI_>(acc, m0, n0, wm, wn, lane, e); break; \
        default: epilogue<E_MULG, MI_>(acc, m0, n0, wm, wn, lane, e); break; }

__device__ void gemm_job(const GemmJob& gj, int& rot, char* smem) {
    const bf16_t* A = gj.A; const bf16_t* W = gj.W; const int lda = gj.lda, K = gj.K, M = gj.M, N = gj.N; const Epi& e = gj.e;
#ifdef NO_GEMM
    return;
#endif

    const int tid = opaque_tid(), lane = tid & 63, wave = tid >> 6, wm = wave >> 1, wn = wave & 1;
    const int ntn = N >> 7, ntiles = (M >> 7) * ntn, KT = K >> 6, G = gridDim.x;
    bf16_t* sA = (bf16_t*)smem;
    bf16_t* sB = sA + 2 * 128 * 72;
    const int half = lane >> 5, l31 = lane & 31;
    const int bp = (blockIdx.x + G - rot) % G, xcd = bp & 7, li = bp >> 3, GL = G >> 3;
    const int mpx = (M >> 7) >> 3, mgsz = mpx < 8 ? mpx : 8, tpx = mpx * ntn, gsz = mgsz * ntn;
    for (int idx = li; idx < tpx; idx += GL) {
        const int grp = idx / gsz, rem = idx - grp * gsz, tn = rem / mgsz, tm = xcd * mpx + grp * mgsz + (rem - tn * mgsz), m0 = tm << 7, n0 = tn << 7;
        f32x16 acc[2][2];
#pragma unroll
        for (int a = 0; a < 2; ++a)
#pragma unroll
            for (int b = 0; b < 2; ++b)
#pragma unroll
                for (int i = 0; i < 16; ++i) acc[a][b][i] = 0.f;
        u32x4 ra[4], rb[4];
        const bf16_t* Ag = A + (size_t)(m0 + (tid >> 3)) * lda + (tid & 7) * 8;
        const bf16_t* Wg = W + (size_t)(n0 + (tid >> 3)) * K + (tid & 7) * 8;
#pragma unroll
        for (int i = 0; i < 4; ++i) { ra[i] = *(const u32x4*)(Ag + (size_t)(32 * i) * lda); rb[i] = *(const u32x4*)(Wg + (size_t)(32 * i) * K); }
        const int lofs = (tid >> 3) * 72 + (tid & 7) * 8;
#pragma unroll
        for (int i = 0; i < 4; ++i) { *(u32x4*)(sA + lofs + 32 * i * 72) = ra[i]; *(u32x4*)(sB + lofs + 32 * i * 72) = rb[i]; }
        if (KT > 1) {
#pragma unroll
            for (int i = 0; i < 4; ++i) { ra[i] = *(const u32x4*)(Ag + (size_t)(32 * i) * lda + 64); rb[i] = *(const u32x4*)(Wg + (size_t)(32 * i) * K + 64); }
        }
        __syncthreads();
        for (int kt = 0; kt < KT; ++kt) {
            const int buf = kt & 1;
            if (kt + 1 < KT) {
                bf16_t* da = sA + (buf ^ 1) * 128 * 72 + lofs; bf16_t* db = sB + (buf ^ 1) * 128 * 72 + lofs;
#pragma unroll
                for (int i = 0; i < 4; ++i) { *(u32x4*)(da + 32 * i * 72) = ra[i]; *(u32x4*)(db + 32 * i * 72) = rb[i]; }
            }
            if (kt + 2 < KT) {
#pragma unroll
                for (int i = 0; i < 4; ++i) { ra[i] = *(const u32x4*)(Ag + (size_t)(32 * i) * lda + (kt + 2) * 64); rb[i] = *(const u32x4*)(Wg + (size_t)(32 * i) * K + (kt + 2) * 64); }
            }
            const bf16_t* a_ = sA + buf * 128 * 72 + (wm * 64 + l31) * 72 + half * 8;
            const bf16_t* b_ = sB + buf * 128 * 72 + (wn * 64 + l31) * 72 + half * 8;
#define LDF(P_, O_) (*(const bf16x8*)((P_) + (O_)))
#define MFMA4(A0, A1, B0, B1) acc[0][0] = __builtin_amdgcn_mfma_f32_32x32x16_bf16(A0, B0, acc[0][0], 0, 0, 0); acc[0][1] = __builtin_amdgcn_mfma_f32_32x32x16_bf16(A0, B1, acc[0][1], 0, 0, 0); \
            acc[1][0] = __builtin_amdgcn_mfma_f32_32x32x16_bf16(A1, B0, acc[1][0], 0, 0, 0); acc[1][1] = __builtin_amdgcn_mfma_f32_32x32x16_bf16(A1, B1, acc[1][1], 0, 0, 0);
            __builtin_amdgcn_sched_barrier(0);
            bf16x8 fa0 = LDF(a_, 0), fb0 = LDF(b_, 0), fb1 = LDF(b_, 32 * 72), fa1 = LDF(a_, 32 * 72);
            bf16x8 ga0 = LDF(a_, 16), gb0 = LDF(b_, 16), gb1 = LDF(b_, 32 * 72 + 16), ga1 = LDF(a_, 32 * 72 + 16);
            __builtin_amdgcn_sched_barrier(0);
            MFMA4(fa0, fa1, fb0, fb1)
            fa0 = LDF(a_, 32); fb0 = LDF(b_, 32); fb1 = LDF(b_, 32 * 72 + 32); fa1 = LDF(a_, 32 * 72 + 32);
            __builtin_amdgcn_sched_barrier(0);
            MFMA4(ga0, ga1, gb0, gb1)
            ga0 = LDF(a_, 48); gb0 = LDF(b_, 48); gb1 = LDF(b_, 32 * 72 + 48); ga1 = LDF(a_, 32 * 72 + 48);
            __builtin_amdgcn_sched_barrier(0);
            MFMA4(fa0, fa1, fb0, fb1)
            MFMA4(ga0, ga1, gb0, gb1)
#undef LDF
#undef MFMA4
            __syncthreads();
        }
        EPI_DISPATCH(2)
    }
    rot = (rot + 8 * (tpx % GL)) % G;
}

__device__ void gemm_job256(const GemmJob& gj, int& rot, char* smem) {
#ifdef NO_GEMM
    return;
#endif
    const bf16_t* A = gj.A; const bf16_t* W = gj.W; const int lda = gj.lda, K = gj.K, M = gj.M, N = gj.N; const Epi& e = gj.e;
    const int tid = opaque_tid(), lane = tid & 63, wave = tid >> 6, wm = wave >> 1, wn = wave & 1;
    const int ntn = N >> 7, ntiles = (M >> 8) * ntn, KT = K >> 5, G = gridDim.x;
    bf16_t* sA = (bf16_t*)smem;
    bf16_t* sB = sA + 2 * 256 * 40;
    const int half = lane >> 5, l31 = lane & 31;
    for (int t = (blockIdx.x + G - rot) % G; t < ntiles; t += G) {
        const int tm = t / ntn, tn = t - tm * ntn, m0 = tm << 8, n0 = tn << 7;
        f32x16 acc[4][2];
#pragma unroll
        for (int a = 0; a < 4; ++a)
#pragma unroll
            for (int b = 0; b < 2; ++b)
#pragma unroll
                for (int i = 0; i < 16; ++i) acc[a][b][i] = 0.f;
        u32x4 ra[4], rb[2];
        const bf16_t* Ag = A + (size_t)(m0 + (tid >> 2)) * lda + (tid & 3) * 8;
        const bf16_t* Wg = W + (size_t)(n0 + (tid >> 2)) * K + (tid & 3) * 8;
#pragma unroll
        for (int i = 0; i < 4; ++i) ra[i] = *(const u32x4*)(Ag + (size_t)(64 * i) * lda);
#pragma unroll
        for (int i = 0; i < 2; ++i) rb[i] = *(const u32x4*)(Wg + (size_t)(64 * i) * K);
        const int lofs = (tid >> 2) * 40 + (tid & 3) * 8;
#pragma unroll
        for (int i = 0; i < 4; ++i) *(u32x4*)(sA + lofs + 64 * i * 40) = ra[i];
#pragma unroll
        for (int i = 0; i < 2; ++i) *(u32x4*)(sB + lofs + 64 * i * 40) = rb[i];
        __syncthreads();
        for (int kt = 0; kt < KT; ++kt) {
            const int buf = kt & 1;
            if (kt + 1 < KT) {
#pragma unroll
                for (int i = 0; i < 4; ++i) ra[i] = *(const u32x4*)(Ag + (size_t)(64 * i) * lda + (kt + 1) * 32);
#pragma unroll
                for (int i = 0; i < 2; ++i) rb[i] = *(const u32x4*)(Wg + (size_t)(64 * i) * K + (kt + 1) * 32);
            }
            const bf16_t* a_ = sA + buf * 256 * 40 + (wm * 128 + l31) * 40 + half * 8;
            const bf16_t* b_ = sB + buf * 128 * 40 + (wn * 64 + l31) * 40 + half * 8;
#pragma unroll
            for (int kk = 0; kk < 2; ++kk) {
                bf16x8 af[4], bfr[2];
#pragma unroll
                for (int mi = 0; mi < 4; ++mi) af[mi] = *(const bf16x8*)(a_ + mi * 32 * 40 + kk * 16);
#pragma unroll
                for (int ni = 0; ni < 2; ++ni) bfr[ni] = *(const bf16x8*)(b_ + ni * 32 * 40 + kk * 16);
#pragma unroll
                for (int mi = 0; mi < 4; ++mi)
#pragma unroll
                    for (int ni = 0; ni < 2; ++ni) acc[mi][ni] = __builtin_amdgcn_mfma_f32_32x32x16_bf16(af[mi], bfr[ni], acc[mi][ni], 0, 0, 0);
            }
            if (kt + 1 < KT) {
                bf16_t* da = sA + (buf ^ 1) * 256 * 40 + lofs; bf16_t* db = sB + (buf ^ 1) * 128 * 40 + lofs;
#pragma unroll
                for (int i = 0; i < 4; ++i) *(u32x4*)(da + 64 * i * 40) = ra[i];
#pragma unroll
                for (int i = 0; i < 2; ++i) *(u32x4*)(db + 64 * i * 40) = rb[i];
            }
            __syncthreads();
        }
        switch (gj.kind) {
        case E_BF16: epilogue<E_BF16, 4>(acc, m0, n0, wm, wn, lane, e); break;
        case E_RESID: epilogue<E_RESID, 4>(acc, m0, n0, wm, wn, lane, e); break;
        case E_SWIGLU: epilogue<E_SWIGLU, 4>(acc, m0, n0, wm, wn, lane, e); break;
        default: epilogue<E_KV, 4>(acc, m0, n0, wm, wn, lane, e); break;
        }
    }
    rot = (rot + ntiles) % G;
}

template <int DQK, bool CAUSAL>
__device__ void attn_phase(const bf16_t* Q, int ldq, int qcol0, const bf16_t* Kb, size_t k_bh_stride, const bf16_t* VT, size_t vt_bh_stride, int vt_ld,
                           int nheads, int nkeys, const float* rope, float scl, bf16_t* O, int ldo, int ocol0, int& rot, char* smem, int vb, int G) {
#ifdef NO_ATTN
    return;
#endif

    constexpr int KS = DQK + 8, NKK = DQK / 16, KCH = DQK / 8, NKL = (64 * KCH) / 256;
    const int tid = opaque_tid(), lane = tid & 63, wave = tid >> 6, half = lane >> 5, l31 = lane & 31;
    bf16_t* sK = (bf16_t*)smem;
    bf16_t* sV = sK + 2 * 64 * KS;
    const int nbh = 4 * nheads, upx = (nbh >> 3) * 64;
    const int bp = (vb + G - rot) % G, xcd = bp & 7, li = bp >> 3, GL = G >> 3;
    for (int idx = li; idx < upx; idx += GL) {
        const int hr = idx >> 6, qi = idx & 63, qb = (hr & 1) ? 63 - qi : qi, bh = xcd + 8 * hr, b = bh / nheads, h = bh - b * nheads;
        const int q0 = qb * 128 + wave * 32, q = q0 + l31;
        const size_t tokq = (size_t)b * S + q;
        bf16x8 qf[NKK];
        { const bf16_t* qp = Q + tokq * ldq + qcol0 + h * DQK + half * 8;
#pragma unroll
          for (int kk = 0; kk < NKK; ++kk) qf[kk] = *(const bf16x8*)(qp + kk * 16); }
        if (rope) {
            const float* rp = rope + tokq * 32 + half * 8;
            const float4 c0 = *(const float4*)rp, c1 = *(const float4*)(rp + 4), s0 = *(const float4*)(rp + 16), s1 = *(const float4*)(rp + 20);
            u32x4 qa = __builtin_bit_cast(u32x4, qf[NKK - 2]), qb_ = __builtin_bit_cast(u32x4, qf[NKK - 1]);
#define ROT2(D, CA, SA, CB, SB) { const float x1l = bflo(qa[D]), x1h = bfhi(qa[D]), x2l = bflo(qb_[D]), x2h = bfhi(qb_[D]); \
              qa[D] = pk2(x1l * CA - x2l * SA, x1h * CB - x2h * SB); qb_[D] = pk2(x2l * CA + x1l * SA, x2h * CB + x1h * SB); }
            ROT2(0, c0.x, s0.x, c0.y, s0.y) ROT2(1, c0.z, s0.z, c0.w, s0.w) ROT2(2, c1.x, s1.x, c1.y, s1.y) ROT2(3, c1.z, s1.z, c1.w, s1.w)
#undef ROT2
            qf[NKK - 2] = __builtin_bit_cast(bf16x8, qa); qf[NKK - 1] = __builtin_bit_cast(bf16x8, qb_);
        }
        const int ntiles = CAUSAL ? (qb * 2 + 2) : (nkeys >> 6);
        f32x16 o[2];
#pragma unroll
        for (int a = 0; a < 2; ++a)
#pragma unroll
            for (int i = 0; i < 16; ++i) o[a][i] = 0.f;
        float m = -1e30f, l = 0.f;
        const bf16_t* Kg = Kb + (size_t)bh * k_bh_stride;
        const bf16_t* Vg = VT + (size_t)bh * vt_bh_stride + (size_t)(tid >> 3) * vt_ld + (tid & 7) * 8;
        u32x4 rk[NKL], rv[2];
#pragma unroll
        for (int i = 0; i < NKL; ++i) rk[i] = *(const u32x4*)(Kg + (size_t)(tid + 256 * i) * 8);
#pragma unroll
        for (int i = 0; i < 2; ++i) rv[i] = *(const u32x4*)(Vg + (size_t)(32 * i) * vt_ld);
#pragma unroll
        for (int i = 0; i < NKL; ++i) { const int c = tid + 256 * i; *(u32x4*)(sK + (c / KCH) * KS + (c % KCH) * 8) = rk[i]; }
#pragma unroll
        for (int i = 0; i < 2; ++i) *(u32x4*)(sV + ((tid >> 3) + 32 * i) * 72 + (tid & 7) * 8) = rv[i];
        __syncthreads();
        for (int kt = 0; kt < ntiles; ++kt) {
            const int buf = kt & 1;
            if (kt + 1 < ntiles) {
#pragma unroll
                for (int i = 0; i < NKL; ++i) rk[i] = *(const u32x4*)(Kg + (size_t)(kt + 1) * 64 * DQK + (size_t)(tid + 256 * i) * 8);
#pragma unroll
                for (int i = 0; i < 2; ++i) rv[i] = *(const u32x4*)(Vg + (size_t)(32 * i) * vt_ld + (kt + 1) * 64);
            }
            if (!CAUSAL || kt * 64 <= q0 + 31) {
                const bf16_t* kb_ = sK + buf * 64 * KS + l31 * KS + half * 8;
                const bf16_t* vb_ = sV + buf * 64 * 72 + l31 * 72 + 4 * half;
                f32x16 s[2];
                bf16x8 kf0[NKK], kf1[NKK];
                __builtin_amdgcn_sched_barrier(0);
#pragma unroll
                for (int kk = 0; kk < NKK; ++kk) kf0[kk] = *(const bf16x8*)(kb_ + kk * 16);
#pragma unroll
                for (int kk = 0; kk < NKK; ++kk) kf1[kk] = *(const bf16x8*)(kb_ + 32 * KS + kk * 16);
                __builtin_amdgcn_sched_barrier(0);
#pragma unroll
                for (int i = 0; i < 16; ++i) { s[0][i] = 0.f; s[1][i] = 0.f; }
#pragma unroll
                for (int kk = 0; kk < NKK; ++kk) s[0] = __builtin_amdgcn_mfma_f32_32x32x16_bf16(kf0[kk], qf[kk], s[0], 0, 0, 0);
#pragma unroll
                for (int kk = 0; kk < NKK; ++kk) s[1] = __builtin_amdgcn_mfma_f32_32x32x16_bf16(kf1[kk], qf[kk], s[1], 0, 0, 0);
                uint2 vfr[2][2][2][2];
#pragma unroll
                for (int kb = 0; kb < 2; ++kb)
#pragma unroll
                    for (int g = 0; g < 2; ++g)
#pragma unroll
                        for (int db = 0; db < 2; ++db) {
                            const bf16_t* vp = vb_ + db * 32 * 72 + kb * 32 + 16 * g;
                            vfr[kb][g][db][0] = *(const uint2*)vp; vfr[kb][g][db][1] = *(const uint2*)(vp + 8);
                        }
                __builtin_amdgcn_sched_barrier(0);
                if (CAUSAL && kt * 64 + 63 > q0) {
#pragma unroll
                    for (int kb = 0; kb < 2; ++kb)
#pragma unroll
                        for (int i = 0; i < 16; ++i) { const int key = kt * 64 + kb * 32 + 8 * (i >> 2) + 4 * half + (i & 3); if (key > q) s[kb][i] = -1e30f; }
                }
                float mx = s[0][0];
#pragma unroll
                for (int kb = 0; kb < 2; ++kb)
#pragma unroll
                    for (int i = 0; i < 16; ++i) mx = fmaxf(mx, s[kb][i]);
                mx = fmaxf(mx, __shfl_xor(mx, 32));
                const float mn = fmaxf(m, mx), alpha = exp2f((m - mn) * scl), mc = mn * scl;
                m = mn;
                float ls = 0.f;
#pragma unroll
                for (int kb = 0; kb < 2; ++kb)
#pragma unroll
                    for (int i = 0; i < 16; ++i) { const float pv = exp2f(s[kb][i] * scl - mc); s[kb][i] = pv; ls += pv; }
                l = l * alpha + ls;
#pragma unroll
                for (int a = 0; a < 2; ++a)
#pragma unroll
                    for (int i = 0; i < 16; ++i) o[a][i] *= alpha;
#pragma unroll
                for (int kb = 0; kb < 2; ++kb)
#pragma unroll
                    for (int g = 0; g < 2; ++g) {
                        u32x4 pu;
#pragma unroll
                        for (int j = 0; j < 4; ++j) pu[j] = pk2(s[kb][8 * g + 2 * j], s[kb][8 * g + 2 * j + 1]);
                        const bf16x8 pf = __builtin_bit_cast(bf16x8, pu);
#pragma unroll
                        for (int db = 0; db < 2; ++db) {
                            u32x4 vu; vu[0] = vfr[kb][g][db][0].x; vu[1] = vfr[kb][g][db][0].y; vu[2] = vfr[kb][g][db][1].x; vu[3] = vfr[kb][g][db][1].y;
                            o[db] = __builtin_amdgcn_mfma_f32_32x32x16_bf16(__builtin_bit_cast(bf16x8, vu), pf, o[db], 0, 0, 0);
                        }
                    }
            }
            if (kt + 1 < ntiles) {
                bf16_t* dk = sK + (buf ^ 1) * 64 * KS; bf16_t* dv = sV + (buf ^ 1) * 64 * 72;
#pragma unroll
                for (int i = 0; i < NKL; ++i) { const int c = tid + 256 * i; *(u32x4*)(dk + (c / KCH) * KS + (c % KCH) * 8) = rk[i]; }
#pragma unroll
                for (int i = 0; i < 2; ++i) *(u32x4*)(dv + ((tid >> 3) + 32 * i) * 72 + (tid & 7) * 8) = rv[i];
            }
            __syncthreads();
        }
        l += __shfl_xor(l, 32);
        const float inv = 1.f / l;
        bf16_t* op = O + tokq * ldo + ocol0 + h * 64 + 4 * half;
#pragma unroll
        for (int db = 0; db < 2; ++db)
#pragma unroll
            for (int g = 0; g < 4; ++g) {
                uint2 w; w.x = pk2(o[db][4 * g] * inv, o[db][4 * g + 1] * inv); w.y = pk2(o[db][4 * g + 2] * inv, o[db][4 * g + 3] * inv);
                *(uint2*)(op + db * 32 + 8 * g) = w;
            }
    }
    rot = (rot + 8 * (upx % GL)) % G;
}

__device__ void lora_in_phase(const Params& p, int layer) {
#ifdef NO_LIN
    return;
#endif

    const bf16_t* P = (const bf16_t*)(p.ws + WS_P); bf16_t* LIN = (bf16_t*)(p.ws + WS_LIN);
    const float* mu = p.in[6] + (size_t)layer * 2560 + 2304;
    const int tid_ = opaque_tid(), lane = tid_ & 63, gw = blockIdx.x * 4 + (tid_ >> 6), nw = gridDim.x * 4;
    const float4 m4 = *(const float4*)(mu + lane * 4);
    for (int tok = gw; tok < T; tok += nw) {
        const int s = tok & (S - 1);
        const uint2 c = *(const uint2*)(P + (size_t)tok * LDP + 2304 + lane * 4);
        uint2 pv; pv.x = 0; pv.y = 0;
        if (s) pv = *(const uint2*)(P + (size_t)(tok - 1) * LDP + 2304 + lane * 4);
        float v0 = bflo(c.x), v1 = bfhi(c.x), v2 = bflo(c.y), v3 = bfhi(c.y);
        v0 += (bflo(pv.x) - v0) * m4.x; v1 += (bfhi(pv.x) - v1) * m4.y; v2 += (bflo(pv.y) - v2) * m4.z; v3 += (bfhi(pv.y) - v3) * m4.w;
        if (lane < 16) { v0 = tanhf(v0); v1 = tanhf(v1); v2 = tanhf(v2); v3 = tanhf(v3); }
        else if (lane >= 32) { v0 = sigmoidf_(v0); v1 = sigmoidf_(v1); v2 = sigmoidf_(v2); v3 = sigmoidf_(v3); }
        uint2 w; w.x = pk2(v0, v1); w.y = pk2(v2, v3);
        *(uint2*)(LIN + (size_t)tok * 320 + lane * 4) = w;
        if (layer == 1) {
            float vd = 0.f;
            if (lane < 32) { vd = bf2f(P[(size_t)tok * LDP + 2816 + lane]); if (s) vd += bf2f(P[(size_t)(tok - 1) * LDP + 2848 + lane]); }
            LIN[(size_t)tok * 320 + 256 + lane] = f2bf(vd);
        }
    }
}

__device__ void prep_phase(const Params& p, int layer) {
#ifdef NO_PREP
    return;
#endif

    bf16_t* P = (bf16_t*)(p.ws + WS_P);
    bf16_t* Z2 = (bf16_t*)(p.ws + WS_Z + ZSZ);
    bf16_t* Z3 = (bf16_t*)(p.ws + WS_Z + 2 * ZSZ);
    bf16_t* Z4 = (bf16_t*)(p.ws + WS_Z + 3 * ZSZ);
    const bf16_t* HALO = (const bf16_t*)(p.ws + WS_HALO);
    float* RK = (float*)(p.ws + WS_RK);
    const float* mu = p.in[6] + (size_t)layer * 2560;
    const float* kkw = p.in[12] + (size_t)layer * 768; const float* kaw = p.in[13] + (size_t)layer * 768; const float* rkw = p.in[14] + (size_t)layer * 768;
    const int tid = opaque_tid(), tokl = tid >> 4, cg4 = (tid & 15) * 4;
    for (int u = blockIdx.x; u < 256 * 12; u += gridDim.x) {
        const int mt = u / 12, h = u - mt * 12, m0 = mt * 128, hc = h * 64 + cg4;
        const float4 mur = *(const float4*)(mu + hc), muk = *(const float4*)(mu + 768 + hc), muv = *(const float4*)(mu + 1536 + hc);
        const float4 kkw4 = *(const float4*)(kkw + hc), kaw4 = *(const float4*)(kaw + hc), rkw4 = *(const float4*)(rkw + hc);
        for (int it = 7; it >= 0; --it) {
            const int tok = m0 + it * 16 + tokl, s = tok & (S - 1);
            bf16_t* pr = P + (size_t)tok * LDP + hc;
            const uint2 cr = *(const uint2*)pr, ck = *(const uint2*)(pr + 768), cv = *(const uint2*)(pr + 1536);
            uint2 qr, qk, qv; qr.x = qr.y = qk.x = qk.y = qv.x = qv.y = 0;
            if (s) {
                const bf16_t* pp = (it == 0 && tokl == 0) ? (HALO + (size_t)(mt - 1) * LDP + hc) : (P + (size_t)(tok - 1) * LDP + hc);
                qr = *(const uint2*)pp; qk = *(const uint2*)(pp + 768); qv = *(const uint2*)(pp + 1536);
            }
            const size_t zi = (size_t)tok * 768 + hc;
            const uint2 lr2 = *(const uint2*)(Z2 + zi);
            uint2 vs2, vf2; vs2.x = vs2.y = vf2.x = vf2.y = 0;
            if (layer == 1) { vs2 = *(const uint2*)(Z3 + zi); vf2 = *(const uint2*)(Z4 + zi); }
            __syncthreads();
            float r[4] = {bflo(cr.x), bfhi(cr.x), bflo(cr.y), bfhi(cr.y)}, k[4] = {bflo(ck.x), bfhi(ck.x), bflo(ck.y), bfhi(ck.y)}, v[4] = {bflo(cv.x), bfhi(cv.x), bflo(cv.y), bfhi(cv.y)};
            const float rp[4] = {bflo(qr.x), bfhi(qr.x), bflo(qr.y), bfhi(qr.y)}, kp[4] = {bflo(qk.x), bfhi(qk.x), bflo(qk.y), bfhi(qk.y)}, vp[4] = {bflo(qv.x), bfhi(qv.x), bflo(qv.y), bfhi(qv.y)};
            const float mr[4] = {mur.x, mur.y, mur.z, mur.w}, mk[4] = {muk.x, muk.y, muk.z, muk.w}, mv[4] = {muv.x, muv.y, muv.z, muv.w};
            const float lr[4] = {bflo(lr2.x), bfhi(lr2.x), bflo(lr2.y), bfhi(lr2.y)};
            const float vs[4] = {bflo(vs2.x), bfhi(vs2.x), bflo(vs2.y), bfhi(vs2.y)}, vf[4] = {bflo(vf2.x), bfhi(vf2.x), bflo(vf2.y), bfhi(vf2.y)};
            const float kkw_[4] = {kkw4.x, kkw4.y, kkw4.z, kkw4.w}, kaw_[4] = {kaw4.x, kaw4.y, kaw4.z, kaw4.w}, rkw_[4] = {rkw4.x, rkw4.y, rkw4.z, rkw4.w};
            float kk[4], n2 = 0.f, rks = 0.f, bb[4];
#pragma unroll
            for (int j = 0; j < 4; ++j) {
                r[j] += (rp[j] - r[j]) * mr[j]; k[j] += (kp[j] - k[j]) * mk[j]; v[j] += (vp[j] - v[j]) * mv[j];
                if (layer == 1) v[j] += (vf[j] - v[j]) * vs[j];
                kk[j] = k[j] * kkw_[j]; n2 += kk[j] * kk[j];
                k[j] = k[j] * (1.f + (lr[j] - 1.f) * kaw_[j]);
                rks += r[j] * k[j] * rkw_[j];
            }
            n2 = reduce16(n2); rks = reduce16(rks);
            const float inv = 1.f / fmaxf(sqrtf(n2), 1e-12f);
#pragma unroll
            for (int j = 0; j < 4; ++j) { kk[j] *= inv; bb[j] = kk[j] * lr[j]; }
            uint2 w;
            w.x = pk2(r[0], r[1]); w.y = pk2(r[2], r[3]); *(uint2*)pr = w;
            w.x = pk2(k[0], k[1]); w.y = pk2(k[2], k[3]); *(uint2*)(pr + 768) = w;
            w.x = pk2(v[0], v[1]); w.y = pk2(v[2], v[3]); *(uint2*)(pr + 1536) = w;
            if (layer == 0) *(uint2*)(Z4 + zi) = w;
            w.x = pk2(bb[0], bb[1]); w.y = pk2(bb[2], bb[3]); *(uint2*)(Z2 + zi) = w;
            w.x = pk2(kk[0], kk[1]); w.y = pk2(kk[2], kk[3]); *(uint2*)(Z3 + zi) = w;
            if ((tid & 15) == 0) RK[(size_t)tok * 12 + h] = rks;
        }
        __syncthreads();
    }
}

__device__ void scan_phase(const Params& p, char* smem) {
#ifdef NO_SCAN
    return;
#endif

    const bf16_t* P = (const bf16_t*)(p.ws + WS_P);
    const _Float16* E = (const _Float16*)(p.ws + WS_Z);
    const bf16_t* Bv = (const bf16_t*)(p.ws + WS_Z + ZSZ);
    const bf16_t* KK = (const bf16_t*)(p.ws + WS_Z + 2 * ZSZ);
    bf16_t* Y = (bf16_t*)(p.ws + WS_H);
    float* sW = (float*)smem; float* sK = sW + 2048; float* sA = sK + 2048; float* sB = sA + 2048; float* sR = sB + 2048; float* sV = sR + 2048; float* sY = sV + 512; float* sYp = sY + 512;
    const int tid = opaque_tid(), lane = tid & 63, wave = tid >> 6, row = wave * 4 + (lane >> 4), kg = lane & 15;
    const int st_l = tid >> 3, c8 = (tid & 7) * 8;
    for (int u = blockIdx.x; u < 192; u += gridDim.x) {
        const int b = u / 48, h = (u % 48) >> 2, qt = u & 3;
        const size_t tok0 = (size_t)b * S;
        f32x2 S01 = {0.f, 0.f}, S23 = {0.f, 0.f};
        struct SR { u32x4 r, k, a, b, v; h8 e; };
        SR RA, RB; RA.v = (u32x4){0u, 0u, 0u, 0u}; RB.v = RA.v;
        auto gload = [&](SR& R_, int ch) {
            u32x4& gr = R_.r; u32x4& gk = R_.k; u32x4& ga = R_.a; u32x4& gb = R_.b; u32x4& gv = R_.v; h8& ge = R_.e;
            const size_t tok = tok0 + ch * 32 + st_l;
            gr = *(const u32x4*)(P + tok * LDP + h * 64 + c8);
            gk = *(const u32x4*)(P + tok * LDP + 768 + h * 64 + c8);
            ga = *(const u32x4*)(KK + tok * 768 + h * 64 + c8);
            gb = *(const u32x4*)(Bv + tok * 768 + h * 64 + c8);
            ge = *(const h8*)(E + tok * 768 + h * 64 + c8);
            if (tid < 64) { const size_t tk = tok0 + ch * 32 + (tid >> 1); gv = *(const u32x4*)(P + tk * LDP + 1536 + h * 64 + qt * 16 + (tid & 1) * 8); }
        };
        auto st4 = [&](float* dst, const u32x4& g) {
            f32x4 a, c; a[0] = bflo(g[0]); a[1] = bfhi(g[0]); a[2] = bflo(g[1]); a[3] = bfhi(g[1]); c[0] = bflo(g[2]); c[1] = bfhi(g[2]); c[2] = bflo(g[3]); c[3] = bfhi(g[3]);
            *(f32x4*)dst = a; *(f32x4*)(dst + 4) = c;
        };
        gload(RA, 0); gload(RB, 1);
        auto body = [&](SR& R_, int ch) {
            u32x4& gr = R_.r; u32x4& gk = R_.k; u32x4& ga = R_.a; u32x4& gb = R_.b; u32x4& gv = R_.v; h8& ge = R_.e;
            {
                const int o = st_l * 64 + c8;
                st4(sR + o, gr); st4(sK + o, gk); st4(sA + o, ga); st4(sB + o, gb);
                float4 a, c; a.x = __expf(-(float)ge[0]); a.y = __expf(-(float)ge[1]); a.z = __expf(-(float)ge[2]); a.w = __expf(-(float)ge[3]);
                c.x = __expf(-(float)ge[4]); c.y = __expf(-(float)ge[5]); c.z = __expf(-(float)ge[6]); c.w = __expf(-(float)ge[7]);
                *(float4*)(sW + o) = a; *(float4*)(sW + o + 4) = c;
                if (tid < 64) st4(sV + (tid >> 1) * 16 + (tid & 1) * 8, gv);
            }
            __syncthreads();
            if (ch + 2 < 256) gload(R_, ch + 2);
            {
                unsigned a_cur = (unsigned)(size_t)(LAS char*)(sW + kg * 4), v_cur = (unsigned)(size_t)(LAS char*)(sV + row);
                f32x4 w0, k0, a0, b0, r0, w1, k1, a1, b1, r1, w2, k2, a2, b2, r2, w3, k3, a3, b3, r3; float v0, v1, v2, v3;
#define SCAN_LOAD(W, K, A, B, R, V, AD, VD) asm volatile("ds_read_b128 %0, %6\n\tds_read_b128 %1, %6 offset:8192\n\tds_read_b128 %2, %6 offset:16384\n\tds_read_b128 %3, %6 offset:24576\n\tds_read_b128 %4, %6 offset:32768\n\tds_read_b32 %5, %7" \
                    : "=&v"(W), "=&v"(K), "=&v"(A), "=&v"(B), "=&v"(R), "=&v"(V) : "v"(AD), "v"(VD) : "memory")
#define SCAN_WAIT(W, K, A, B, R, V, DEP) asm volatile("s_waitcnt lgkmcnt(6)" : "+v"(W), "+v"(K), "+v"(A), "+v"(B), "+v"(R), "+v"(V), "+v"(DEP) :: "memory")
#define SCAN_WAIT0(W, K, A, B, R, V, DEP) asm volatile("s_waitcnt lgkmcnt(0)" : "+v"(W), "+v"(K), "+v"(A), "+v"(B), "+v"(R), "+v"(V), "+v"(DEP) :: "memory")
#define SCAN_STEP(W, K, A, B, R, V, YV) { \
                    f32x2 t = S01 * (f32x2){A[0], A[1]}; t = __builtin_elementwise_fma(S23, (f32x2){A[2], A[3]}, t); \
                    const float d = reduce16(t[0] + t[1]); const f32x2 sa2 = {-d, -d}, v2_ = {V, V}; \
                    const f32x2 u01 = __builtin_elementwise_fma(sa2, (f32x2){B[0], B[1]}, v2_ * (f32x2){K[0], K[1]}); \
                    const f32x2 u23 = __builtin_elementwise_fma(sa2, (f32x2){B[2], B[3]}, v2_ * (f32x2){K[2], K[3]}); \
                    S01 = __builtin_elementwise_fma(S01, (f32x2){W[0], W[1]}, u01); S23 = __builtin_elementwise_fma(S23, (f32x2){W[2], W[3]}, u23); \
                    f32x2 y2 = S01 * (f32x2){R[0], R[1]}; y2 = __builtin_elementwise_fma(S23, (f32x2){R[2], R[3]}, y2); \
                    YV = y2[0] + y2[1]; }
                SCAN_LOAD(w0, k0, a0, b0, r0, v0, a_cur, v_cur);
                { const unsigned an = a_cur + 256, vn = v_cur + 64; SCAN_LOAD(w1, k1, a1, b1, r1, v1, an, vn); }
                float yv = 0.f;
                float* ypw = sYp + row * 16 + kg;
#pragma unroll 1
                for (int q = 0; q < 8; ++q) {
                    const int sb = (q & 3) * 4;
                    SCAN_WAIT(w0, k0, a0, b0, r0, v0, yv);
                    { const unsigned an = a_cur + 512, vn = v_cur + 128; SCAN_LOAD(w2, k2, a2, b2, r2, v2, an, vn); }
                    SCAN_STEP(w0, k0, a0, b0, r0, v0, yv)
                    ypw[sb * 256] = yv;
                    SCAN_WAIT(w1, k1, a1, b1, r1, v1, yv);
                    { const unsigned an = a_cur + 768, vn = v_cur + 192; SCAN_LOAD(w3, k3, a3, b3, r3, v3, an, vn); }
                    SCAN_STEP(w1, k1, a1, b1, r1, v1, yv)
                    ypw[(sb + 1) * 256] = yv;
                    SCAN_WAIT(w2, k2, a2, b2, r2, v2, yv);
                    a_cur += 1024; v_cur += 256;
                    SCAN_LOAD(w0, k0, a0, b0, r0, v0, a_cur, v_cur);
                    SCAN_STEP(w2, k2, a2, b2, r2, v2, yv)
                    ypw[(sb + 2) * 256] = yv;
                    SCAN_WAIT(w3, k3, a3, b3, r3, v3, yv);
                    { const unsigned an = a_cur + 256, vn = v_cur + 64; SCAN_LOAD(w1, k1, a1, b1, r1, v1, an, vn); }
                    SCAN_STEP(w3, k3, a3, b3, r3, v3, yv)
                    ypw[(sb + 3) * 256] = yv;
                    if ((q & 3) == 3) {
                        const int hh = q >> 2, stp = lane >> 2, rw_ = wave * 4 + (lane & 3);
                        const f32x4* pp = (const f32x4*)(sYp + stp * 256 + rw_ * 16);
                        const f32x4 q0 = pp[0], q1 = pp[1], q2 = pp[2], q3 = pp[3];
                        const float ysum = ((q0[0] + q0[1]) + (q0[2] + q0[3])) + ((q1[0] + q1[1]) + (q1[2] + q1[3])) + ((q2[0] + q2[1]) + (q2[2] + q2[3])) + ((q3[0] + q3[1]) + (q3[2] + q3[3]));
                        sY[(hh * 16 + stp) * 16 + rw_] = ysum;
                    }
                }
                SCAN_WAIT0(w0, k0, a0, b0, r0, v0, yv);
                SCAN_WAIT0(w1, k1, a1, b1, r1, v1, yv);
#undef SCAN_WAIT0
#undef SCAN_LOAD
#undef SCAN_WAIT
#undef SCAN_STEP
            }
            __syncthreads();
            if (tid < 64) {
                const float* yp = sY + (tid >> 1) * 16 + (tid & 1) * 8;
                const float4 a = *(const float4*)yp, c = *(const float4*)(yp + 4);
                uint4 w; w.x = pk2(a.x, a.y); w.y = pk2(a.z, a.w); w.z = pk2(c.x, c.y); w.w = pk2(c.z, c.w);
                *(uint4*)(Y + (tok0 + ch * 32 + (tid >> 1)) * 1024 + h * 64 + qt * 16 + (tid & 1) * 8) = w;
            }
        };
#pragma unroll 1
        for (int ch = 0; ch < 256; ch += 2) { body(RA, ch); body(RB, ch + 1); }
        __syncthreads();
    }
}

__device__ void post_phase(const Params& p, int layer) {
#ifdef NO_POST
    return;
#endif

    bf16_t* H = (bf16_t*)(p.ws + WS_H); const bf16_t* P = (const bf16_t*)(p.ws + WS_P); const float* RK = (const float*)(p.ws + WS_RK);
    const float* lg = p.in[15] + (size_t)layer * 768; const float* lb = p.in[16] + (size_t)layer * 768;
    const int tid = opaque_tid(), cg4 = (tid & 15) * 4;
    const int npairs = T * 12;
    for (int pr = blockIdx.x * 16 + (tid >> 4); pr < npairs; pr += gridDim.x * 16) {
        const int tok = pr / 12, h = pr - tok * 12, hc = h * 64 + cg4;
        bf16_t* yp = H + (size_t)tok * 1024 + hc;
        const uint2 y2 = *(const uint2*)yp, v2 = *(const uint2*)(P + (size_t)tok * LDP + 1536 + hc);
        const float y[4] = {bflo(y2.x), bfhi(y2.x), bflo(y2.y), bfhi(y2.y)}, v[4] = {bflo(v2.x), bfhi(v2.x), bflo(v2.y), bfhi(v2.y)};
        const float mean = reduce16((y[0] + y[1]) + (y[2] + y[3])) * (1.f / 64.f);
        float q = 0.f;
#pragma unroll
        for (int j = 0; j < 4; ++j) { const float d = y[j] - mean; q += d * d; }
        const float rstd = rsqrtf(reduce16(q) * (1.f / 64.f) + 64e-5f);
        const float rk = RK[(size_t)tok * 12 + h];
        const float4 g4 = *(const float4*)(lg + hc), b4 = *(const float4*)(lb + hc);
        const float g[4] = {g4.x, g4.y, g4.z, g4.w}, bb[4] = {b4.x, b4.y, b4.z, b4.w};
        float o[4];
#pragma unroll
        for (int j = 0; j < 4; ++j) o[j] = (y[j] - mean) * rstd * g[j] + bb[j] + rk * v[j];
        uint2 w; w.x = pk2(o[0], o[1]); w.y = pk2(o[2], o[3]);
        *(uint2*)yp = w;
    }
}

__device__ void subnorm_phase(const Params& p, int j) {
#ifdef NO_SUB
    return;
#endif

    const bf16_t* PB = (const bf16_t*)(p.ws + WS_PROJB); bf16_t* CQ = (bf16_t*)(p.ws + WS_CQ);
    const float* CKR = (const float*)(p.ws + WS_CKR); bf16_t* CKV = (bf16_t*)(p.ws + WS_CKV); bf16_t* KF = (bf16_t*)(p.ws + WS_KFULL);
    const float* rope = (const float*)(p.ws + WS_ROPE);
    const float* gq = p.in[32] + (size_t)j * 512; const float* gl = p.in[28];
    const int tid_ = opaque_tid(), lane = tid_ & 63, gw = blockIdx.x * 4 + (tid_ >> 6), nw = gridDim.x * 4;
    for (int tok = gw; tok < T; tok += nw) {
        {
            const uint4 c = *(const uint4*)(PB + (size_t)tok * 768 + lane * 8);
            float v[8] = {bflo(c.x), bfhi(c.x), bflo(c.y), bfhi(c.y), bflo(c.z), bfhi(c.z), bflo(c.w), bfhi(c.w)};
            float ss = 0.f;
#pragma unroll
            for (int i = 0; i < 8; ++i) ss += v[i] * v[i];
            ss = wave_sum(ss);
            const float rs = rsqrtf(ss * (1.f / 512.f) + 1e-6f);
            const float4 g0 = *(const float4*)(gq + lane * 8), g1 = *(const float4*)(gq + lane * 8 + 4);
            uint4 w; w.x = pk2(v[0] * rs * g0.x, v[1] * rs * g0.y); w.y = pk2(v[2] * rs * g0.z, v[3] * rs * g0.w);
            w.z = pk2(v[4] * rs * g1.x, v[5] * rs * g1.y); w.w = pk2(v[6] * rs * g1.z, v[7] * rs * g1.w);
            *(uint4*)(CQ + (size_t)tok * 512 + lane * 8) = w;
        }
        if (j == 0) {
            const float4 c = *(const float4*)(CKR + (size_t)tok * 384 + lane * 4);
            float ss = c.x * c.x + c.y * c.y + c.z * c.z + c.w * c.w;
            ss = wave_sum(ss);
            const float rs = rsqrtf(ss * (1.f / 256.f) + 1e-6f);
            const float4 g = *(const float4*)(gl + lane * 4);
            uint2 w; w.x = pk2(c.x * rs * g.x, c.y * rs * g.y); w.y = pk2(c.z * rs * g.z, c.w * rs * g.w);
            *(uint2*)(CKV + (size_t)tok * 256 + lane * 4) = w;
            const int i = lane & 15, hg = lane >> 4;
            const float x1 = CKR[(size_t)tok * 384 + 256 + i], x2 = CKR[(size_t)tok * 384 + 272 + i];
            const float cs = rope[(size_t)tok * 32 + i], sn = rope[(size_t)tok * 32 + 16 + i];
            const bf16_t o1 = f2bf(x1 * cs - x2 * sn), o2 = f2bf(x2 * cs + x1 * sn);
            const int b = tok >> 13, s = tok & (S - 1);
#pragma unroll
            for (int hh = 0; hh < 3; ++hh) {
                bf16_t* kp = KF + ((size_t)(b * 12 + hg * 3 + hh) * S + s) * 96 + 64 + i;
                kp[0] = o1; kp[16] = o2;
            }
        }
    }
}

__device__ void rope_phase(const Params& p) {
    const int* pos = (const int*)p.in[2]; float* rope = (float*)(p.ws + WS_ROPE);
    for (int idx = blockIdx.x * 256 + threadIdx.x; idx < T * 16; idx += gridDim.x * 256) {
        const int tok = idx >> 4, i = idx & 15;
        const float invf = powf(10000.f, -(float)i / 16.f);
        const float ang = (float)pos[tok] * invf;
        rope[(size_t)tok * 32 + i] = cosf(ang); rope[(size_t)tok * 32 + 16 + i] = sinf(ang);
    }
}

__device__ bool get_gemm_job(const Params& p, int ph, int jn, GemmJob& g) {
    char* ws = p.ws;
    bf16_t* WA = (bf16_t*)(ws + WS_WA); bf16_t* WF = (bf16_t*)(ws + WS_WF); bf16_t* H = (bf16_t*)(ws + WS_H); bf16_t* P = (bf16_t*)(ws + WS_P);
    bf16_t* LIN = (bf16_t*)(ws + WS_LIN); bf16_t* KMEM = (bf16_t*)(ws + WS_KMEM); bf16_t* VTMEM = (bf16_t*)(ws + WS_VTMEM); bf16_t* MEMN = (bf16_t*)(ws + WS_MEMN);
    g.M = T; g.e.o1 = nullptr; g.e.bias = nullptr; g.e.resid = nullptr; g.e.halo = nullptr; g.e.ldc = 0;
    const bool rw = ph < 25;
    const int L = rw ? (ph - 1) / 12 : 2 + (ph - 25) / 9, r = rw ? (ph - 1) % 12 : (ph - 25) % 9;
    const int r_wout = rw ? 8 : 5, r_gu = rw ? 10 : 7, r_down = rw ? 11 : 8;
    if (r == r_wout) { if (jn) return false; g.A = H; g.lda = 1024; g.W = WA + (rw ? A_WOUT : B_WOUT); g.K = 1024; g.N = 1024; g.kind = E_RESID; g.e.o0 = p.out; g.e.resid = (L == 0) ? p.in[0] : p.out; g.e.ldc = 1024; return true; }
    if (r == r_gu) { if (jn) return false; g.A = H; g.lda = 1024; g.W = WF + F_GU; g.K = 1024; g.N = 5632; g.kind = E_SWIGLU; g.e.o0 = P; g.e.ldc = 2816; return true; }
    if (r == r_down) { if (jn) return false; g.A = P; g.lda = 2816; g.W = WF + F_DOWN; g.K = 2816; g.N = 1024; g.kind = E_RESID; g.e.o0 = p.out; g.e.resid = p.out; g.e.ldc = 1024; return true; }
    if (r == 1 && jn == 1) { g.A = MEMN; g.lda = 1024; g.W = WA + (rw ? A_MKV : B_MKV); g.K = 1024; g.M = 1024; g.N = 512; g.kind = E_MEMKV; g.e.o0 = KMEM; g.e.o1 = VTMEM; return true; }
    if (rw) {
        const int i = L;
        if (r == 1 && jn == 0) { g.A = H; g.lda = 1024; g.W = WA + A_WIN; g.K = 1024; g.N = (i == 1) ? 2944 : 2816; g.kind = E_BF16; g.e.o0 = P; g.e.ldc = LDP; g.e.halo = (bf16_t*)(ws + WS_HALO); return true; }
        if (r == 3) {
            if (jn == 0) { g.A = LIN; g.lda = 320; g.W = WA + A_DEC; g.K = 64; g.N = 768; g.kind = E_DECAY; g.e.o0 = ws + WS_Z; g.e.bias = p.in[8] + (size_t)i * 768; g.e.ldc = 768; return true; }
            if (jn == 1) { g.A = LIN + 64; g.lda = 320; g.W = WA + A_AAA; g.K = 64; g.N = 768; g.kind = E_SIGB; g.e.o0 = ws + WS_Z + ZSZ; g.e.bias = p.in[10] + (size_t)i * 768; g.e.ldc = 768; return true; }
            if (jn == 2 && i == 1) { g.A = LIN + 256; g.lda = 320; g.W = WA + A_VUP; g.K = 64; g.N = 768; g.kind = E_SIGB; g.e.o0 = ws + WS_Z + 2 * ZSZ; g.e.bias = p.in[25]; g.e.ldc = 768; return true; }
            return false;
        }
        if (r == 7 && jn == 0) { g.A = LIN + 128; g.lda = 320; g.W = WA + A_GATE; g.K = 128; g.N = 768; g.kind = E_MULG; g.e.o0 = H; g.e.ldc = 1024; return true; }
        return false;
    }
    const int j = L - 2;
    if (r == 1) {
        if (jn == 0) { g.A = H; g.lda = 1024; g.W = WA + B_WIN; g.K = 1024; g.N = 768; g.kind = E_BF16; g.e.o0 = ws + WS_PROJB; g.e.ldc = 768; return true; }
        if (jn == 2 && j == 0) { g.A = (bf16_t*)(ws + WS_QFULL); g.lda = 1024; g.W = WA + B_KVD; g.K = 1024; g.N = 384; g.kind = E_F32; g.e.o0 = ws + WS_CKR; g.e.ldc = 384; return true; }
        return false;
    }
    if (r == 3) {
        if (jn == 0) { g.A = (bf16_t*)(ws + WS_CQ); g.lda = 512; g.W = WA + B_QUP; g.K = 512; g.N = 1152; g.kind = E_BF16; g.e.o0 = ws + WS_QFULL; g.e.ldc = 1152; return true; }
        if (jn == 1 && j == 0) { g.A = (bf16_t*)(ws + WS_CKV); g.lda = 256; g.W = WA + B_KVU; g.K = 256; g.N = 1536; g.kind = E_KV; g.e.o0 = ws + WS_KFULL; g.e.o1 = ws + WS_VT; return true; }
        return false;
    }
    return false;
}

__device__ void run_phase(const Params& p, int ph, char* smem) {
    char* ws = p.ws;
    bf16_t* H = (bf16_t*)(ws + WS_H);
    const float MEMSCL = 0.125f * 1.4426950408889634f, MLASCL = 0.10206207261596575f * 1.4426950408889634f;
    int rot = 0;
    const bool rw = ph >= 1 && ph < 25, mla = ph >= 25 && ph < 43;
    const int L = rw ? (ph - 1) / 12 : (mla ? 2 + (ph - 25) / 9 : 0), r = rw ? (ph - 1) % 12 : (mla ? (ph - 25) % 9 : -1);
    {
        const float* x = nullptr; int nrows = T; const float* g1 = nullptr; bf16_t* o1 = H; const float* g2 = nullptr; bf16_t* o2 = nullptr; float* of = nullptr;
        if (ph == 0) { x = p.in[1]; nrows = 1024; g1 = p.in[3]; o1 = (bf16_t*)(ws + WS_MEMN); }
        else if (ph == 43) { x = p.out; g1 = p.in[39]; of = p.out; }
        else if (rw && r == 0) { x = (L == 0) ? p.in[0] : p.out; g1 = p.in[4] + (size_t)L * 1024; }
        else if (rw && r == 9) { x = p.out; g1 = p.in[19] + (size_t)L * 1024; }
        else if (mla && r == 0) { x = p.out; g1 = p.in[30] + (size_t)(L - 2) * 1024; if (L == 2) { g2 = p.in[26]; o2 = (bf16_t*)(ws + WS_QFULL); } }
        else if (mla && r == 6) { x = p.out; g1 = p.in[36] + (size_t)(L - 2) * 1024; }
        if (x) rmsnorm_phase(x, nrows, g1, o1, g2, o2, of);
    }
    if (ph == 0) rope_phase(p);
    int cvb = blockIdx.x, cVG = gridDim.x;
    {
        int kind = -1, CL = 0;
        if (ph == 0) { kind = 0; CL = 0; }
        else if ((rw || mla) && r == 0) { kind = 1; CL = L; }
        else if (rw && r == 9) { kind = 0; CL = L + 1; }
        else if (mla && r == 6 && L == 2) { kind = 0; CL = 3; }
        const int GG = gridDim.x; const bool split = rw && r == 5 && GG >= 256;
        if (rw && r == 0) kind = -1;
        if (rw && r == 5) { kind = 1; CL = L; }
        if (split && GG == 512) { const int b_ = blockIdx.x; cvb = (b_ >= 192 && b_ < 256) ? b_ - 192 : (b_ >= 448 ? b_ - 384 : -1); cVG = 128; }
        else { cvb = split ? (int)blockIdx.x - 192 : (int)blockIdx.x; cVG = split ? GG - 192 : GG; }
        if (kind >= 0 && cvb >= 0) { ConvJob c; for (int idx = 0; get_conv_job(p, kind, CL, idx, c); ++idx) run_conv(c, rot, smem, cvb, cVG); }
    }
    { GemmJob g; for (int jn = 0; jn < 3; ++jn) if (get_gemm_job(p, ph, jn, g)) { gemm_job(g, rot, smem); } }
    if (((rw && r == 5) || (mla && r == 3)) && cvb >= 0) {
        const bf16_t* Q = rw ? (const bf16_t*)(ws + WS_P) : (const bf16_t*)(ws + WS_PROJB);
        attn_phase<64, false>(Q, rw ? LDP : 768, rw ? 2560 : 512, (const bf16_t*)(ws + WS_KMEM), 256 * 64, (const bf16_t*)(ws + WS_VTMEM), 64 * 256, 256, 4, 256, nullptr, MEMSCL, H, 1024, 768, rot, smem, cvb, cVG);
    }
    if (mla && r == 4)
        attn_phase<96, true>((const bf16_t*)(ws + WS_QFULL), 1152, 0, (const bf16_t*)(ws + WS_KFULL), (size_t)S * 96, (const bf16_t*)(ws + WS_VT), (size_t)64 * S, S, 12, S, (const float*)(ws + WS_ROPE), MLASCL, H, 1024, 0, rot, smem, blockIdx.x, gridDim.x);
    if (rw && r == 2) lora_in_phase(p, L);
    if (rw && r == 4) prep_phase(p, L);
    if (rw && r == 5 && (blockIdx.x < 192 || cVG == (int)gridDim.x)) scan_phase(p, smem);
    if (rw && r == 6) post_phase(p, L);
    if (mla && r == 2) subnorm_phase(p, L - 2);
}

#define XB_TMO      128
#define XB_XCNT(j)  (256  + 64 * (j))
#define XB_XSUB(j)  (1280 + 64 * (j))
#define XB_XGEN(j)  (2304 + 64 * (j))
#define XB_TOP      3328
#define XB_TOPGEN   3392
#define XCD_BAR_WORDS 3456
#define XB_SPIN_CAP (1u << 18)
__device__ __forceinline__ unsigned xb_ld(unsigned* p)              { return __hip_atomic_load(p, __ATOMIC_RELAXED, __HIP_MEMORY_SCOPE_AGENT); }
__device__ __forceinline__ unsigned xb_add(unsigned* p, unsigned v) { return __hip_atomic_fetch_add(p, v, __ATOMIC_RELAXED, __HIP_MEMORY_SCOPE_AGENT); }
__device__ __forceinline__ unsigned xb_xcc_id() { return (unsigned)__builtin_amdgcn_s_getreg((3 << 11) | 20) & 0xFu; }
#define XB_SPIN(cond, bar) do { unsigned _sp = 0; while (cond) { __builtin_amdgcn_s_sleep(1); \
    if ((++_sp & 255u) == 0u) { if (xb_ld(&(bar)[XB_TMO])) break; if (_sp > XB_SPIN_CAP) { atomicAdd(&(bar)[XB_TMO], 1u); break; } } } } while (0)
struct XcdBarrier { unsigned* bar; unsigned x; volatile LAS unsigned* st; };
__device__ __forceinline__ XcdBarrier xcd_barrier_post(unsigned* bar, volatile LAS unsigned* st) {
    XcdBarrier b; b.bar = bar; b.x = xb_xcc_id(); b.st = st;
    if (threadIdx.x == 0) (void)xb_add(&bar[XB_XCNT(b.x)], 1u);
    return b;
}
__device__ __forceinline__ void xcd_barrier_complete(unsigned* bar, unsigned x, unsigned& nloc, unsigned& nx) {
    const unsigned G = gridDim.x * gridDim.y * gridDim.z;
    unsigned sum, cnt, mine, sp = 0u;
    for (;;) {
        sum = 0u; cnt = 0u; mine = 0u;
#pragma unroll
        for (unsigned j = 0; j < 16; ++j) { const unsigned c = xb_ld(&bar[XB_XCNT(j)]); sum += c; cnt += (c > 0u) ? 1u : 0u; mine = (j == x) ? c : mine; }
        if (sum == G) break;
        __builtin_amdgcn_s_sleep(1);
        if ((++sp & 255u) == 0u) { if (xb_ld(&bar[XB_TMO])) break; if (sp > XB_SPIN_CAP) { atomicAdd(&bar[XB_TMO], 1u); break; } }
    }
    nloc = mine > 0u ? mine : 1u; nx = cnt > 0u ? cnt : 1u;
}
__device__ __forceinline__ void xcd_barrier(const XcdBarrier& b) {
    asm volatile("s_waitcnt vmcnt(0)" ::: "memory");
    __syncthreads();
    if (threadIdx.x == 0) {
        unsigned* bar = b.bar;
        __builtin_amdgcn_s_waitcnt(0);
        unsigned nloc = b.st[0], nx = b.st[1];
        if (nloc == 0u) { xcd_barrier_complete(bar, b.x, nloc, nx); b.st[0] = nloc; b.st[1] = nx; }
        const unsigned old = xb_add(&bar[XB_XSUB(b.x)], 1u);
        const unsigned gen = old / nloc;
        if (old + 1u == (gen + 1u) * nloc) {
            __builtin_amdgcn_fence(__ATOMIC_RELEASE, "agent");
            asm volatile("s_waitcnt vmcnt(0)" ::: "memory");
            const unsigned og = xb_add(&bar[XB_TOP], 1u);
            const unsigned tg = og / nx;
            if (og + 1u == (tg + 1u) * nx) xb_add(&bar[XB_TOPGEN], 1u);
            else XB_SPIN(xb_ld(&bar[XB_TOPGEN]) == tg, bar);
            __builtin_amdgcn_fence(__ATOMIC_ACQUIRE, "agent");
            xb_add(&bar[XB_XGEN(b.x)], 1u);
            asm volatile("s_waitcnt vmcnt(0)" ::: "memory");
        } else {
            XB_SPIN(xb_ld(&bar[XB_XGEN(b.x)]) == gen, bar);
            __builtin_amdgcn_fence(__ATOMIC_ACQUIRE, "agent");
            asm volatile("s_waitcnt vmcnt(0)" ::: "memory");
        }
    }
    __syncthreads();
}

__global__ void __launch_bounds__(256, 2) yoco_mega(Params p) {
    extern __shared__ __attribute__((aligned(16))) char smem[];
    cg::grid_group grid = cg::this_grid();
    volatile LAS unsigned* st = (volatile LAS unsigned*)((LAS char*)smem + 73728);
    if (threadIdx.x == 0) { st[0] = 0u; st[1] = 0u; }
    __syncthreads();
    const XcdBarrier xb = xcd_barrier_post((unsigned*)(p.ws + WS_BAR), st);
    if (p.ph_lo < 0) grid.sync();
    for (int ph = p.ph_lo; ph < p.ph_hi; ++ph) {
        int nrep = 1;
#if PROBE_DUP
        {
            const bool rw = ph >= 1 && ph < 25, mla = ph >= 25 && ph < 43;
            const int r = rw ? (ph - 1) % 12 : (mla ? (ph - 25) % 9 : -1);
            if ((PROBE_DUP & 1) && rw && r == 5) nrep = 2;
            if ((PROBE_DUP & 2) && ((rw && r == 10) || (mla && r == 7))) nrep = 2;
            if ((PROBE_DUP & 4) && mla && r == 4) nrep = 2;
            if ((PROBE_DUP & 8) && rw && r == 3) nrep = 2;
            if ((PROBE_DUP & 16) && ((rw && (r == 0 || r == 9)) || (mla && (r == 0 || r == 6)))) nrep = 2;
            if ((PROBE_DUP & 32) && ((rw && r == 2) || (mla && (r == 2 || r == 3)))) nrep = 2;
        }
#endif
        for (int rep = 0; rep < nrep; ++rep) {
            run_phase(p, ph, smem);
            if (rep + 1 < nrep || ph + 1 < p.ph_hi) xcd_barrier(xb);
        }
    }
}

#ifndef PROBE_DUP
#define PROBE_DUP 0
#endif
#ifndef MULTI_LAUNCH
#define MULTI_LAUNCH 0
#endif

extern "C" void kernel_launch(void* const* d_in, const int* in_sizes, int n_in, void* d_out, int out_size, void* d_ws, size_t ws_size, hipStream_t stream) {
    static int grid_blocks = 0;
    if (!grid_blocks) {
        int dev = 0, cus = 0, per_cu = 0;
        hipGetDevice(&dev);
        hipDeviceGetAttribute(&cus, hipDeviceAttributeMultiprocessorCount, dev);
        hipFuncSetAttribute((const void*)yoco_mega, hipFuncAttributeMaxDynamicSharedMemorySize, LDS_BYTES);
        hipOccupancyMaxActiveBlocksPerMultiprocessor(&per_cu, (const void*)yoco_mega, 256, LDS_BYTES);
        if (per_cu < 1) per_cu = 1;
        if (per_cu > 2) per_cu = 2;
        grid_blocks = cus * per_cu;
        if (ws_size < WS_END) fprintf(stderr, "kernel_launch: workspace too small: %zu < %zu\n", ws_size, (size_t)WS_END);
        if (n_in != 40) fprintf(stderr, "kernel_launch: expected 40 inputs, got %d\n", n_in);
    }
    Params p{};
    for (int i = 0; i < 40; ++i) p.in[i] = (const float*)d_in[i];
    p.out = (float*)d_out; p.ws = (char*)d_ws;
#if MULTI_LAUNCH
    for (int ph = 0; ph < 44; ++ph) {
        p.ph_lo = ph; p.ph_hi = ph + 1;
        hipLaunchKernelGGL(yoco_mega, dim3(grid_blocks), dim3(256), LDS_BYTES, stream, p);
    }
#else
    p.ph_lo = 0; p.ph_hi = 44;
    (void)hipMemsetAsync((char*)d_ws + WS_BAR, 0, 16384, stream);
    void* args[] = {&p};
    hipError_t e = hipLaunchCooperativeKernel((const void*)yoco_mega, dim3(grid_blocks), dim3(256), args, LDS_BYTES, stream);
    if (e != hipSuccess) fprintf(stderr, "cooperative launch failed: %s (grid %d)\n", hipGetErrorString(e), grid_blocks);
#endif
}
```

```cpp
#include <hip/hip_runtime.h>
#include <hip/hip_cooperative_groups.h>
#include <cstdio>
#include <cstdint>
namespace cg = cooperative_groups;
#define PROBE_DUP 0

typedef unsigned short bf16_t;
typedef short bf16x8 __attribute__((ext_vector_type(8)));
typedef float f32x16 __attribute__((ext_vector_type(16)));
typedef _Float16 h8 __attribute__((ext_vector_type(8)));
typedef unsigned u32x4 __attribute__((ext_vector_type(4)));
typedef float f32x2 __attribute__((ext_vector_type(2)));
#define LAS __attribute__((address_space(3)))
typedef float f32x4 __attribute__((ext_vector_type(4)));

constexpr int T = 32768, S = 8192;
constexpr int LDP = 2944;
constexpr int NT = 512, NWV = 8;
constexpr int LDS_MAIN = 147456;
constexpr int LDS_BYTES = LDS_MAIN + 16;

constexpr size_t WS_WA = 0;
constexpr size_t WS_WF = WS_WA + 10485760;
constexpr size_t WS_H = WS_WF + 17825792;
constexpr size_t WS_P = WS_H + 67108864;
constexpr size_t WS_Z = WS_P + 192937984;
constexpr size_t ZSZ = 50331648;
constexpr size_t WS_LIN = WS_Z + 4 * ZSZ;
constexpr size_t WS_RK = WS_LIN + 20971520;
constexpr size_t WS_ROPE = WS_RK + 1572864;
constexpr size_t WS_KMEM = WS_ROPE + 4194304;
constexpr size_t WS_VTMEM = WS_KMEM + 524288;
constexpr size_t WS_MEMN = WS_VTMEM + 524288;
constexpr size_t WS_HALO = WS_MEMN + 2097152;
constexpr size_t WS_BAR = WS_HALO + 1507328;
constexpr size_t WS_END = WS_BAR + 16384;
constexpr size_t WS_KFULL = WS_Z;
constexpr size_t WS_VT = WS_KFULL + 75497472;
constexpr size_t WS_PROJB = WS_VT + 50331648;
constexpr size_t WS_QFULL = WS_P;
constexpr size_t WS_CQ = WS_QFULL + 75497472;
constexpr size_t WS_CKR = WS_CQ + 33554432;
constexpr size_t WS_CKV = WS_CKR + 50331648;
constexpr size_t A_WIN = 0, A_DEC = 3014656, A_AAA = 3063808, A_GATE = 3112960, A_VUP = 3211264, A_MKV = 3260416, A_WOUT = 3784704;
constexpr size_t B_WIN = 0, B_QUP = 786432, B_MKV = 1376256, B_WOUT = 1900544, B_KVD = 2949120, B_KVU = 3342336;
constexpr size_t F_GU = 0, F_DOWN = 5767168;

struct Params { const float* in[40]; float* out; char* ws; int ph_lo, ph_hi; };

__device__ __forceinline__ bf16_t f2bf(float f) { unsigned u = __float_as_uint(f); u += 0x7fffu + ((u >> 16) & 1u); return (bf16_t)(u >> 16); }
__device__ __forceinline__ unsigned pk2(float lo, float hi) { return (unsigned)f2bf(lo) | ((unsigned)f2bf(hi) << 16); }
__device__ __forceinline__ float bflo(unsigned u) { return __uint_as_float(u << 16); }
__device__ __forceinline__ float bfhi(unsigned u) { return __uint_as_float(u & 0xffff0000u); }
__device__ __forceinline__ float bf2f(bf16_t v) { return __uint_as_float((unsigned)v << 16); }
__device__ __forceinline__ float reduce16(float x);
__device__ __forceinline__ float wave_sum(float v) {
    v = reduce16(v);
    const int b = __float_as_int(v);
    return (__int_as_float(__builtin_amdgcn_readlane(b, 0)) + __int_as_float(__builtin_amdgcn_readlane(b, 16))) +
           (__int_as_float(__builtin_amdgcn_readlane(b, 32)) + __int_as_float(__builtin_amdgcn_readlane(b, 48)));
}
template <int CTRL> __device__ __forceinline__ float dppmov(float x) { return __int_as_float(__builtin_amdgcn_update_dpp(0, __float_as_int(x), CTRL, 0xF, 0xF, true)); }
__device__ __forceinline__ float reduce16(float x) {
    x += dppmov<0xB1>(x); x += dppmov<0x4E>(x); x += dppmov<0x141>(x); x += dppmov<0x140>(x); return x;
}
__device__ __forceinline__ int opaque_tid() { int t = threadIdx.x; asm volatile("" : "+v"(t)); return t; }
__device__ __forceinline__ float sigmoidf_(float x) { return 1.f / (1.f + __expf(-x)); }

__device__ void rmsnorm_phase(const float* x, int nrows, const float* g1, bf16_t* o1, const float* g2, bf16_t* o2, float* of) {
    const int tid_ = opaque_tid(), lane = tid_ & 63, gw = blockIdx.x * NWV + (tid_ >> 6), nw = gridDim.x * NWV;
    for (int row = gw; row < nrows; row += nw) {
        const float4* xr = (const float4*)(x + (size_t)row * 1024);
        float4 v[4]; float ss = 0.f;
#pragma unroll
        for (int i = 0; i < 4; ++i) { v[i] = xr[lane + 64 * i]; ss += v[i].x * v[i].x + v[i].y * v[i].y + v[i].z * v[i].z + v[i].w * v[i].w; }
        ss = wave_sum(ss);
        const float rs = rsqrtf(ss * (1.f / 1024.f) + 1e-6f);
#pragma unroll
        for (int i = 0; i < 4; ++i) {
            const float4 g = ((const float4*)g1)[lane + 64 * i];
            const float a = v[i].x * rs, b = v[i].y * rs, c = v[i].z * rs, d = v[i].w * rs;
            if (of) { float4 o; o.x = a * g.x; o.y = b * g.y; o.z = c * g.z; o.w = d * g.w; ((float4*)(of + (size_t)row * 1024))[lane + 64 * i] = o; }
            else {
                uint2 w; w.x = pk2(a * g.x, b * g.y); w.y = pk2(c * g.z, d * g.w);
                *(uint2*)(o1 + (size_t)row * 1024 + (lane + 64 * i) * 4) = w;
                if (o2) { const float4 h = ((const float4*)g2)[lane + 64 * i]; uint2 w2; w2.x = pk2(a * h.x, b * h.y); w2.y = pk2(c * h.z, d * h.w);
                    *(uint2*)(o2 + (size_t)row * 1024 + (lane + 64 * i) * 4) = w2; }
            }
        }
    }
}

struct ConvJob { const float* src; int ld; int ncols; int kvalid; bf16_t* dst; int dstK; int ngran; int swiglu; const float* rscale; int rsmode; };
__device__ void run_conv(const ConvJob& j, int& rot, char* smem, int vb, int G) {
#ifdef NO_CONV
    return;
#endif

    bf16_t* lds = (bf16_t*)smem;
    const int tid = opaque_tid(), nkt = j.dstK >> 6, units = j.ngran * nkt;
    for (int u = (vb + G - rot) % G; u < units; u += G) {
        const int g = u / nkt, kt = u - g * nkt, k0 = kt * 64;
        int col0 = j.swiglu ? ((g & 1) * 2816 + 32 * (g >> 1)) : 32 * g;
        const bool colok = (col0 + 32 <= j.ncols);
#pragma unroll
        for (int i = 0; i < 4; ++i) {
            const int kr = (tid >> 5) + 16 * i, c = tid & 31, k = k0 + kr;
            float v = 0.f;
            if (colok && k < j.kvalid) {
                v = j.src[(size_t)k * j.ld + col0 + c];
                if (j.rsmode == 1) v *= (1.f - j.rscale[k]); else if (j.rsmode == 2) v *= j.rscale[k];
            }
            lds[c * 72 + kr] = f2bf(v);
        }
        __syncthreads();
        if (tid < 256) { const int c = tid >> 3, kc = (tid & 7) * 8;
          const uint4 w = *(const uint4*)(lds + c * 72 + kc);
          *(uint4*)(j.dst + (size_t)(g * 32 + c) * j.dstK + k0 + kc) = w; }
        __syncthreads();
    }
    rot = (rot + units) % G;
}
__device__ bool get_conv_job(const Params& p, int kind, int L, int idx, ConvJob& c) {
    bf16_t* WA = (bf16_t*)(p.ws + WS_WA); bf16_t* WF = (bf16_t*)(p.ws + WS_WF);
    c.swiglu = 0; c.rscale = nullptr; c.rsmode = 0;
    if (kind == 1) {
        if (idx == 0) { c.src = (L < 2) ? p.in[20] + (size_t)L * 1024 * 5632 : p.in[37] + (size_t)(L - 2) * 1024 * 5632; c.ld = 5632; c.ncols = 5632; c.kvalid = 1024; c.dst = WF + F_GU; c.dstK = 1024; c.ngran = 176; c.swiglu = 1; return true; }
        if (idx == 1) { c.src = (L < 2) ? p.in[21] + (size_t)L * 2816 * 1024 : p.in[38] + (size_t)(L - 2) * 2816 * 1024; c.ld = 1024; c.ncols = 1024; c.kvalid = 2816; c.dst = WF + F_DOWN; c.dstK = 2816; c.ngran = 32; return true; }
        return false;
    }
    if (L < 2) {
        const int i = L;
        switch (idx) {
        case 0: c.src = p.in[5] + (size_t)i * 1024 * 2816; c.ld = 2816; c.ncols = 2816; c.kvalid = 1024; c.dst = WA + A_WIN; c.dstK = 1024; c.ngran = 88; return true;
        case 1: c.src = p.in[7] + (size_t)i * 64 * 768; c.ld = 768; c.ncols = 768; c.kvalid = 64; c.dst = WA + A_DEC; c.dstK = 64; c.ngran = 24; return true;
        case 2: c.src = p.in[9] + (size_t)i * 64 * 768; c.ld = 768; c.ncols = 768; c.kvalid = 64; c.dst = WA + A_AAA; c.dstK = 64; c.ngran = 24; return true;
        case 3: c.src = p.in[11] + (size_t)i * 128 * 768; c.ld = 768; c.ncols = 768; c.kvalid = 128; c.dst = WA + A_GATE; c.dstK = 128; c.ngran = 24; return true;
        case 4: c.src = p.in[17] + (size_t)i * 1024 * 512; c.ld = 512; c.ncols = 512; c.kvalid = 1024; c.dst = WA + A_MKV; c.dstK = 1024; c.ngran = 16; return true;
        case 5: c.src = p.in[18] + (size_t)i * 1024 * 1024; c.ld = 1024; c.ncols = 1024; c.kvalid = 1024; c.dst = WA + A_WOUT; c.dstK = 1024; c.ngran = 32; return true;
        }
        if (i == 0) return false;
        switch (idx) {
        case 6: c.src = p.in[23]; c.ld = 32; c.ncols = 32; c.kvalid = 1024; c.dst = WA + A_WIN + (size_t)2816 * 1024; c.dstK = 1024; c.ngran = 1; c.rscale = p.in[22]; c.rsmode = 1; return true;
        case 7: c.src = p.in[23]; c.ld = 32; c.ncols = 32; c.kvalid = 1024; c.dst = WA + A_WIN + (size_t)2848 * 1024; c.dstK = 1024; c.ngran = 1; c.rscale = p.in[22]; c.rsmode = 2; return true;
        case 8: c.src = p.in[23]; c.ld = 32; c.ncols = 0; c.kvalid = 1024; c.dst = WA + A_WIN + (size_t)2880 * 1024; c.dstK = 1024; c.ngran = 2; return true;
        case 9: c.src = p.in[24]; c.ld = 768; c.ncols = 768; c.kvalid = 32; c.dst = WA + A_VUP; c.dstK = 64; c.ngran = 24; return true;
        }
        return false;
    }
    const int j = L - 2;
    switch (idx) {
    case 0: c.src = p.in[31] + (size_t)j * 1024 * 768; c.ld = 768; c.ncols = 768; c.kvalid = 1024; c.dst = WA + B_WIN; c.dstK = 1024; c.ngran = 24; return true;
    case 1: c.src = p.in[33] + (size_t)j * 512 * 1152; c.ld = 1152; c.ncols = 1152; c.kvalid = 512; c.dst = WA + B_QUP; c.dstK = 512; c.ngran = 36; return true;
    case 2: c.src = p.in[34] + (size_t)j * 1024 * 512; c.ld = 512; c.ncols = 512; c.kvalid = 1024; c.dst = WA + B_MKV; c.dstK = 1024; c.ngran = 16; return true;
    case 3: c.src = p.in[35] + (size_t)j * 1024 * 1024; c.ld = 1024; c.ncols = 1024; c.kvalid = 1024; c.dst = WA + B_WOUT; c.dstK = 1024; c.ngran = 32; return true;
    }
    if (j != 0) return false;
    if (idx == 4) { c.src = p.in[27]; c.ld = 288; c.ncols = 288; c.kvalid = 1024; c.dst = WA + B_KVD; c.dstK = 1024; c.ngran = 12; return true; }
    if (idx == 5) { c.src = p.in[29]; c.ld = 1536; c.ncols = 1536; c.kvalid = 256; c.dst = WA + B_KVU; c.dstK = 256; c.ngran = 48; return true; }
    return false;
}

enum { E_BF16 = 0, E_F32, E_RESID, E_SWIGLU, E_DECAY, E_SIGB, E_KV, E_MEMKV, E_MULG };
struct Epi { void* o0; void* o1; const float* bias; const float* resid; int ldc; bf16_t* halo; };
struct GemmJob { const bf16_t* A; int lda; const bf16_t* W; int K, M, N, kind; Epi e; };

template <int E, int MI> __device__ __forceinline__ void epilogue(const f32x16 (&acc)[MI][2], int m0, int n0, int wm, int wn, int lane, const Epi& e) {
    const int half = lane >> 5, l31 = lane & 31;
    if (E == E_SWIGLU) {
        bf16_t* o = (bf16_t*)e.o0; const int col = (n0 >> 1) + wn * 32 + l31;
#pragma unroll
        for (int mi = 0; mi < MI; ++mi) {
            int rb_ = m0 + wm * (MI * 32) + mi * 32 + 4 * half;
            asm volatile("" : "+v"(rb_));
#pragma unroll
            for (int i = 0; i < 16; ++i) {
                const int row = rb_ + 8 * (i >> 2) + (i & 3);
                const float g = acc[mi][0][i], u = acc[mi][1][i];
                o[(size_t)row * 2816 + col] = f2bf(g * sigmoidf_(g) * u);
            }
        }
        return;
    }
#pragma unroll
    for (int mi = 0; mi < MI; ++mi)
#pragma unroll
        for (int ni = 0; ni < 2; ++ni) {
            const int col = n0 + wn * 64 + ni * 32 + l31;
            int rbase = m0 + wm * (MI * 32) + mi * 32 + 4 * half;
            asm volatile("" : "+v"(rbase));
            if (E == E_KV || E == E_MEMKV) {
                const bool isv = (E == E_KV) ? ((col & 127) >= 64) : (col >= 256);
                if (isv) {
#pragma unroll
                    for (int g = 0; g < 4; ++g) {
                        const int row = rbase + 8 * g;
                        uint2 w; w.x = pk2(acc[mi][ni][4 * g], acc[mi][ni][4 * g + 1]); w.y = pk2(acc[mi][ni][4 * g + 2], acc[mi][ni][4 * g + 3]);
                        size_t idx;
                        if (E == E_KV) { const int b = row >> 13, s = row & 8191, head = col >> 7, d = (col & 127) - 64; idx = ((size_t)(b * 12 + head) * 64 + d) * 8192 + s; }
                        else { const int b = row >> 8, mi_ = row & 255, head = (col - 256) >> 6, d = col & 63; idx = ((size_t)(b * 4 + head) * 64 + d) * 256 + mi_; }
                        *(uint2*)((bf16_t*)e.o1 + idx) = w;
                    }
                } else {
#pragma unroll
                    for (int i = 0; i < 16; ++i) {
                        const int row = rbase + 8 * (i >> 2) + (i & 3);
                        size_t idx;
                        if (E == E_KV) { const int b = row >> 13, s = row & 8191, head = col >> 7, c = col & 127; idx = ((size_t)(b * 12 + head) * 8192 + s) * 96 + c; }
                        else { const int b = row >> 8, mi_ = row & 255, head = col >> 6, d = col & 63; idx = ((size_t)(b * 4 + head) * 256 + mi_) * 64 + d; }
                        ((bf16_t*)e.o0)[idx] = f2bf(acc[mi][ni][i]);
                    }
                }
                continue;
            }
            float bias = 0.f;
            if (E == E_DECAY || E == E_SIGB) bias = e.bias[col];
#pragma unroll
            for (int i = 0; i < 16; ++i) {
                const int row = rbase + 8 * (i >> 2) + (i & 3);
                const float v = acc[mi][ni][i];
                const size_t idx = (size_t)row * e.ldc + col;
                if (E == E_BF16) {
                    const bf16_t b = f2bf(v);
                    ((bf16_t*)e.o0)[idx] = b;
                    if (e.halo && (row & 127) == 127) e.halo[(size_t)(row >> 7) * e.ldc + col] = b;
                } else if (E == E_F32) ((float*)e.o0)[idx] = v;
                else if (E == E_RESID) ((float*)e.o0)[idx] = e.resid[idx] + v;
                else if (E == E_DECAY) ((_Float16*)e.o0)[idx] = (_Float16)(0.60653066f * sigmoidf_(bias + v));
                else if (E == E_SIGB) ((bf16_t*)e.o0)[idx] = f2bf(sigmoidf_(bias + v));
                else if (E == E_MULG) { bf16_t* o = (bf16_t*)e.o0; o[idx] = f2bf(bf2f(o[idx]) * v); }
            }
        }
}

__device__ void gemm_job(const GemmJob& gj, int& rot, char* smem) {
#ifdef NO_GEMM
    return;
#endif
    const bf16_t* A = gj.A; const bf16_t* W = gj.W; const int lda = gj.lda, K = gj.K, M = gj.M, N = gj.N; const Epi& e = gj.e;
    const int tid = opaque_tid(), lane = tid & 63, wave = tid >> 6, wm = wave >> 2, wn = wave & 3;
    const int ntn = (N + 255) >> 8, ntm = M >> 8, KT = K >> 6, G = gridDim.x;
    bf16_t* sA = (bf16_t*)smem;
    bf16_t* sB = sA + 2 * 256 * 72;
    const int half = lane >> 5, l31 = lane & 31;
    const int bp = (blockIdx.x + G - rot) % G;
    const bool xmap = (ntm & 7) == 0;
    const int xcd = bp & 7, li = bp >> 3, GL = G >> 3, mpx = ntm >> 3, mgsz = mpx < 8 ? (mpx > 0 ? mpx : 1) : 8, gsz = mgsz * ntn;
    const int tcount = xmap ? mpx * ntn : ntm * ntn, tstart = xmap ? li : bp, tstep = xmap ? GL : G;
    for (int idx = tstart; idx < tcount; idx += tstep) {
        int tm, tn;
        if (xmap) { const int grp = idx / gsz, rem = idx - grp * gsz; tn = rem / mgsz; tm = xcd * mpx + grp * mgsz + (rem - tn * mgsz); }
        else { tm = idx / ntn; tn = idx - tm * ntn; }
        const int m0 = tm << 8, n0 = tn << 8;
        const bool wact = (n0 + wn * 64) < N;
        f32x16 acc[4][2];
#pragma unroll
        for (int a = 0; a < 4; ++a)
#pragma unroll
            for (int b = 0; b < 2; ++b)
#pragma unroll
                for (int i = 0; i < 16; ++i) acc[a][b][i] = 0.f;
        u32x4 ra[4], rb[4];
        const char* Ab = (const char*)(A + (size_t)m0 * lda);
        const char* Wb = (const char*)(W + (size_t)n0 * K);
        const unsigned aoff = (unsigned)(((tid >> 3) * lda + (tid & 7) * 8) * 2), woff = (unsigned)(((tid >> 3) * K + (tid & 7) * 8) * 2);
#define GLOAD_TILE(KT_) { _Pragma("unroll") for (int i = 0; i < 4; ++i) { \
            ra[i] = *(const u32x4*)(Ab + ((size_t)(64 * i) * lda + (size_t)(KT_) * 64) * 2 + aoff); \
            rb[i] = *(const u32x4*)(Wb + ((size_t)(64 * i) * K + (size_t)(KT_) * 64) * 2 + woff); } }
        GLOAD_TILE(0)
        const int lofs = (tid >> 3) * 72 + (tid & 7) * 8;
#pragma unroll
        for (int i = 0; i < 4; ++i) { *(u32x4*)(sA + lofs + 64 * i * 72) = ra[i]; *(u32x4*)(sB + lofs + 64 * i * 72) = rb[i]; }
        if (KT > 1) GLOAD_TILE(1)
        __syncthreads();
        for (int kt = 0; kt < KT; ++kt) {
            const int buf = kt & 1;
            if (kt + 1 < KT) {
                bf16_t* da = sA + (buf ^ 1) * 256 * 72 + lofs; bf16_t* db = sB + (buf ^ 1) * 256 * 72 + lofs;
#pragma unroll
                for (int i = 0; i < 4; ++i) { *(u32x4*)(da + 64 * i * 72) = ra[i]; *(u32x4*)(db + 64 * i * 72) = rb[i]; }
            }
            if (kt + 2 < KT) GLOAD_TILE(kt + 2)
            if (wact) {
                const bf16_t* a_ = sA + buf * 256 * 72 + (wm * 128 + l31) * 72 + half * 8;
                const bf16_t* b_ = sB + buf * 256 * 72 + (wn * 64 + l31) * 72 + half * 8;
#define LDF(P_, O_) (*(const bf16x8*)((P_) + (O_)))
#define MM(I_, J_, AF, BF) acc[I_][J_] = __builtin_amdgcn_mfma_f32_32x32x16_bf16(AF, BF, acc[I_][J_], 0, 0, 0);
                bf16x8 b0 = LDF(b_, 0), b1 = LDF(b_, 32 * 72), a0 = LDF(a_, 0), a1 = LDF(a_, 32 * 72), a2, a3;
#pragma unroll
                for (int kk = 0; kk < 4; ++kk) {
                    a2 = LDF(a_, 64 * 72 + kk * 16); a3 = LDF(a_, 96 * 72 + kk * 16);
                    __builtin_amdgcn_sched_barrier(0);
                    MM(0, 0, a0, b0) MM(0, 1, a0, b1) MM(1, 0, a1, b0) MM(1, 1, a1, b1)
                    __builtin_amdgcn_sched_barrier(0);
                    if (kk < 3) { a0 = LDF(a_, (kk + 1) * 16); a1 = LDF(a_, 32 * 72 + (kk + 1) * 16); }
                    bf16x8 c0 = b0, c1 = b1;
                    if (kk < 3) { b0 = LDF(b_, (kk + 1) * 16); b1 = LDF(b_, 32 * 72 + (kk + 1) * 16); }
                    __builtin_amdgcn_sched_barrier(0);
                    MM(2, 0, a2, c0) MM(2, 1, a2, c1) MM(3, 0, a3, c0) MM(3, 1, a3, c1)
                    __builtin_amdgcn_sched_barrier(0);
                }
#undef LDF
#undef MM
            }
            __syncthreads();
        }
#undef GLOAD_TILE
        if (wact) {
            switch (gj.kind) {
            case E_BF16: epilogue<E_BF16, 4>(acc, m0, n0, wm, wn, lane, e); break;
            case E_F32: epilogue<E_F32, 4>(acc, m0, n0, wm, wn, lane, e); break;
            case E_RESID: epilogue<E_RESID, 4>(acc, m0, n0, wm, wn, lane, e); break;
            case E_SWIGLU: epilogue<E_SWIGLU, 4>(acc, m0, n0, wm, wn, lane, e); break;
            case E_DECAY: epilogue<E_DECAY, 4>(acc, m0, n0, wm, wn, lane, e); break;
            case E_SIGB: epilogue<E_SIGB, 4>(acc, m0, n0, wm, wn, lane, e); break;
            case E_KV: epilogue<E_KV, 4>(acc, m0, n0, wm, wn, lane, e); break;
            case E_MEMKV: epilogue<E_MEMKV, 4>(acc, m0, n0, wm, wn, lane, e); break;
            default: epilogue<E_MULG, 4>(acc, m0, n0, wm, wn, lane, e); break;
            }
        }
    }
    rot = (rot + (xmap ? 8 * (tcount % GL) : tcount) ) % G;
}

template <int DQK, bool CAUSAL>
__device__ void attn_phase(const bf16_t* Q, int ldq, int qcol0, const bf16_t* Kb, size_t k_bh_stride, const bf16_t* VT, size_t vt_bh_stride, int vt_ld,
                           int nheads, int nkeys, const float* rope, float scl, bf16_t* O, int ldo, int ocol0, int& rot, char* smem, int vb, int G) {
#ifdef NO_ATTN
    return;
#endif

    constexpr int KS = DQK + 8, NKK = DQK / 16, KCH = DQK / 8, NCH = 64 * KCH, NKL = (NCH + NT - 1) / NT;
    const int tid = opaque_tid(), lane = tid & 63, wave = tid >> 6, half = lane >> 5, l31 = lane & 31;
    const int xaddr = (lane ^ 32) << 2;
    bf16_t* sK = (bf16_t*)smem;
    bf16_t* sV = sK + 2 * 64 * KS;
    const int nbh = 4 * nheads, upx = (nbh >> 3) * 32;
    const int bp = (vb + G - rot) % G, xcd = bp & 7, li = bp >> 3, GL = G >> 3;
    for (int idx = li; idx < upx; idx += GL) {
        const int hr = idx >> 5, qi = idx & 31, qb = (hr & 1) ? 31 - qi : qi, bh = xcd + 8 * hr, b = bh / nheads, h = bh - b * nheads;
        const int q0 = qb * 256 + wave * 32, q = q0 + l31;
        const size_t tokq = (size_t)b * S + q;
        bf16x8 qf[NKK];
        { const bf16_t* qp = Q + tokq * ldq + qcol0 + h * DQK + half * 8;
#pragma unroll
          for (int kk = 0; kk < NKK; ++kk) qf[kk] = *(const bf16x8*)(qp + kk * 16); }
        if (rope) {
            const float* rp = rope + tokq * 32 + half * 8;
            const float4 c0 = *(const float4*)rp, c1 = *(const float4*)(rp + 4), s0 = *(const float4*)(rp + 16), s1 = *(const float4*)(rp + 20);
            u32x4 qa = __builtin_bit_cast(u32x4, qf[NKK - 2]), qb_ = __builtin_bit_cast(u32x4, qf[NKK - 1]);
#define ROT2(D, CA, SA, CB, SB) { const float x1l = bflo(qa[D]), x1h = bfhi(qa[D]), x2l = bflo(qb_[D]), x2h = bfhi(qb_[D]); \
              qa[D] = pk2(x1l * CA - x2l * SA, x1h * CB - x2h * SB); qb_[D] = pk2(x2l * CA + x1l * SA, x2h * CB + x1h * SB); }
            ROT2(0, c0.x, s0.x, c0.y, s0.y) ROT2(1, c0.z, s0.z, c0.w, s0.w) ROT2(2, c1.x, s1.x, c1.y, s1.y) ROT2(3, c1.z, s1.z, c1.w, s1.w)
#undef ROT2
            qf[NKK - 2] = __builtin_bit_cast(bf16x8, qa); qf[NKK - 1] = __builtin_bit_cast(bf16x8, qb_);
        }
        const int ntiles = CAUSAL ? (qb * 4 + 4) : (nkeys >> 6);
        f32x16 o[2];
#pragma unroll
        for (int a = 0; a < 2; ++a)
#pragma unroll
            for (int i = 0; i < 16; ++i) o[a][i] = 0.f;
        float m = -1e30f, l = 0.f;
        const bf16_t* Kg = Kb + (size_t)bh * k_bh_stride;
        const bf16_t* Vg = VT + (size_t)bh * vt_bh_stride + (size_t)(tid >> 3) * vt_ld + (tid & 7) * 8;
        u32x4 rk[NKL], rv[1];
#pragma unroll
        for (int i = 0; i < NKL; ++i) { const int c = tid + NT * i; if (c < NCH) rk[i] = *(const u32x4*)(Kg + (size_t)c * 8); }
        rv[0] = *(const u32x4*)(Vg);
#pragma unroll
        for (int i = 0; i < NKL; ++i) { const int c = tid + NT * i; if (c < NCH) *(u32x4*)(sK + (c / KCH) * KS + (c % KCH) * 8) = rk[i]; }
        *(u32x4*)(sV + (tid >> 3) * 72 + (tid & 7) * 8) = rv[0];
        __syncthreads();
        for (int kt = 0; kt < ntiles; ++kt) {
            const int buf = kt & 1;
            if (kt + 1 < ntiles) {
#pragma unroll
                for (int i = 0; i < NKL; ++i) { const int c = tid + NT * i; if (c < NCH) rk[i] = *(const u32x4*)(Kg + (size_t)(kt + 1) * 64 * DQK + (size_t)c * 8); }
                rv[0] = *(const u32x4*)(Vg + (kt + 1) * 64);
            }
            if (!CAUSAL || kt * 64 <= q0 + 31) {
                const bf16_t* kb_ = sK + buf * 64 * KS + l31 * KS + half * 8;
                const bf16_t* vb_ = sV + buf * 64 * 72 + l31 * 72 + 4 * half;
                f32x16 s[2];
                bf16x8 kf0[NKK], kf1[NKK];
                __builtin_amdgcn_sched_barrier(0);
#pragma unroll
                for (int kk = 0; kk < NKK; ++kk) kf0[kk] = *(const bf16x8*)(kb_ + kk * 16);
#pragma unroll
                for (int kk = 0; kk < NKK; ++kk) kf1[kk] = *(const bf16x8*)(kb_ + 32 * KS + kk * 16);
                __builtin_amdgcn_sched_barrier(0);
#pragma unroll
                for (int i = 0; i < 16; ++i) { s[0][i] = 0.f; s[1][i] = 0.f; }
#pragma unroll
                for (int kk = 0; kk < NKK; ++kk) s[0] = __builtin_amdgcn_mfma_f32_32x32x16_bf16(kf0[kk], qf[kk], s[0], 0, 0, 0);
#pragma unroll
                for (int kk = 0; kk < NKK; ++kk) s[1] = __builtin_amdgcn_mfma_f32_32x32x16_bf16(kf1[kk], qf[kk], s[1], 0, 0, 0);
                uint2 vfr[2][2][2][2];
#pragma unroll
                for (int kb = 0; kb < 2; ++kb)
#pragma unroll
                    for (int g = 0; g < 2; ++g)
#pragma unroll
                        for (int db = 0; db < 2; ++db) {
                            const bf16_t* vp = vb_ + db * 32 * 72 + kb * 32 + 16 * g;
                            vfr[kb][g][db][0] = *(const uint2*)vp; vfr[kb][g][db][1] = *(const uint2*)(vp + 8);
                        }
                __builtin_amdgcn_sched_barrier(0);
                if (CAUSAL && kt * 64 + 63 > q0) {
#pragma unroll
                    for (int kb = 0; kb < 2; ++kb)
#pragma unroll
                        for (int i = 0; i < 16; ++i) { const int key = kt * 64 + kb * 32 + 8 * (i >> 2) + 4 * half + (i & 3); if (key > q) s[kb][i] = -1e30f; }
                }
                float mx = s[0][0];
#pragma unroll
                for (int kb = 0; kb < 2; ++kb)
#pragma unroll
                    for (int i = 0; i < 16; ++i) mx = fmaxf(mx, s[kb][i]);
                mx = fmaxf(mx, __int_as_float(__builtin_amdgcn_ds_bpermute(xaddr, __float_as_int(mx))));
                const float mn = fmaxf(m, mx), alpha = exp2f((m - mn) * scl), mc = mn * scl;
                m = mn;
                float ls = 0.f;
#pragma unroll
                for (int kb = 0; kb < 2; ++kb)
#pragma unroll
                    for (int i = 0; i < 16; ++i) { const float pv = exp2f(s[kb][i] * scl - mc); s[kb][i] = pv; ls += pv; }
                l = l * alpha + ls;
#pragma unroll
                for (int a = 0; a < 2; ++a)
#pragma unroll
                    for (int i = 0; i < 16; ++i) o[a][i] *= alpha;
#pragma unroll
                for (int kb = 0; kb < 2; ++kb)
#pragma unroll
                    for (int g = 0; g < 2; ++g) {
                        u32x4 pu;
#pragma unroll
                        for (int j = 0; j < 4; ++j) pu[j] = pk2(s[kb][8 * g + 2 * j], s[kb][8 * g + 2 * j + 1]);
                        const bf16x8 pf = __builtin_bit_cast(bf16x8, pu);
#pragma unroll
                        for (int db = 0; db < 2; ++db) {
                            u32x4 vu; vu[0] = vfr[kb][g][db][0].x; vu[1] = vfr[kb][g][db][0].y; vu[2] = vfr[kb][g][db][1].x; vu[3] = vfr[kb][g][db][1].y;
                            o[db] = __builtin_amdgcn_mfma_f32_32x32x16_bf16(__builtin_bit_cast(bf16x8, vu), pf, o[db], 0, 0, 0);
                        }
                    }
            }
            if (kt + 1 < ntiles) {
                bf16_t* dk = sK + (buf ^ 1) * 64 * KS; bf16_t* dv = sV + (buf ^ 1) * 64 * 72;
#pragma unroll
                for (int i = 0; i < NKL; ++i) { const int c = tid + NT * i; if (c < NCH) *(u32x4*)(dk + (c / KCH) * KS + (c % KCH) * 8) = rk[i]; }
                *(u32x4*)(dv + (tid >> 3) * 72 + (tid & 7) * 8) = rv[0];
            }
            __syncthreads();
        }
        l += __int_as_float(__builtin_amdgcn_ds_bpermute(xaddr, __float_as_int(l)));
        const float inv = 1.f / l;
        bf16_t* op = O + tokq * ldo + ocol0 + h * 64 + 4 * half;
#pragma unroll
        for (int db = 0; db < 2; ++db)
#pragma unroll
            for (int g = 0; g < 4; ++g) {
                uint2 w; w.x = pk2(o[db][4 * g] * inv, o[db][4 * g + 1] * inv); w.y = pk2(o[db][4 * g + 2] * inv, o[db][4 * g + 3] * inv);
                *(uint2*)(op + db * 32 + 8 * g) = w;
            }
    }
    rot = (rot + 8 * (upx % GL)) % G;
}

__device__ void lora_in_phase(const Params& p, int layer) {
#ifdef NO_LIN
    return;
#endif

    const bf16_t* P = (const bf16_t*)(p.ws + WS_P); bf16_t* LIN = (bf16_t*)(p.ws + WS_LIN);
    const float* mu = p.in[6] + (size_t)layer * 2560 + 2304;
    const int tid_ = opaque_tid(), lane = tid_ & 63, gw = blockIdx.x * NWV + (tid_ >> 6), nw = gridDim.x * NWV;
    const float4 m4 = *(const float4*)(mu + lane * 4);
    for (int tok = gw; tok < T; tok += nw) {
        const int s = tok & (S - 1);
        const uint2 c = *(const uint2*)(P + (size_t)tok * LDP + 2304 + lane * 4);
        uint2 pv; pv.x = 0; pv.y = 0;
        if (s) pv = *(const uint2*)(P + (size_t)(tok - 1) * LDP + 2304 + lane * 4);
        float v0 = bflo(c.x), v1 = bfhi(c.x), v2 = bflo(c.y), v3 = bfhi(c.y);
        v0 += (bflo(pv.x) - v0) * m4.x; v1 += (bfhi(pv.x) - v1) * m4.y; v2 += (bflo(pv.y) - v2) * m4.z; v3 += (bfhi(pv.y) - v3) * m4.w;
        if (lane < 16) { v0 = tanhf(v0); v1 = tanhf(v1); v2 = tanhf(v2); v3 = tanhf(v3); }
        else if (lane >= 32) { v0 = sigmoidf_(v0); v1 = sigmoidf_(v1); v2 = sigmoidf_(v2); v3 = sigmoidf_(v3); }
        uint2 w; w.x = pk2(v0, v1); w.y = pk2(v2, v3);
        *(uint2*)(LIN + (size_t)tok * 320 + lane * 4) = w;
        if (layer == 1) {
            float vd = 0.f;
            if (lane < 32) { vd = bf2f(P[(size_t)tok * LDP + 2816 + lane]); if (s) vd += bf2f(P[(size_t)(tok - 1) * LDP + 2848 + lane]); }
            LIN[(size_t)tok * 320 + 256 + lane] = f2bf(vd);
        }
    }
}

__device__ void prep_phase(const Params& p, int layer) {
#ifdef NO_PREP
    return;
#endif

    bf16_t* P = (bf16_t*)(p.ws + WS_P);
    bf16_t* Z2 = (bf16_t*)(p.ws + WS_Z + ZSZ);
    bf16_t* Z3 = (bf16_t*)(p.ws + WS_Z + 2 * ZSZ);
    bf16_t* Z4 = (bf16_t*)(p.ws + WS_Z + 3 * ZSZ);
    const bf16_t* HALO = (const bf16_t*)(p.ws + WS_HALO);
    float* RK = (float*)(p.ws + WS_RK);
    const float* mu = p.in[6] + (size_t)layer * 2560;
    const float* kkw = p.in[12] + (size_t)layer * 768; const float* kaw = p.in[13] + (size_t)layer * 768; const float* rkw = p.in[14] + (size_t)layer * 768;
    const int tid = opaque_tid(), tokl = tid >> 4, cg4 = (tid & 15) * 4;
    for (int u = blockIdx.x; u < 256 * 12; u += gridDim.x) {
        const int mt = u / 12, h = u - mt * 12, m0 = mt * 128, hc = h * 64 + cg4;
        const float4 mur = *(const float4*)(mu + hc), muk = *(const float4*)(mu + 768 + hc), muv = *(const float4*)(mu + 1536 + hc);
        const float4 kkw4 = *(const float4*)(kkw + hc), kaw4 = *(const float4*)(kaw + hc), rkw4 = *(const float4*)(rkw + hc);
        for (int it = 3; it >= 0; --it) {
            const int tok = m0 + it * 32 + tokl, s = tok & (S - 1);
            bf16_t* pr = P + (size_t)tok * LDP + hc;
            const uint2 cr = *(const uint2*)pr, ck = *(const uint2*)(pr + 768), cv = *(const uint2*)(pr + 1536);
            uint2 qr, qk, qv; qr.x = qr.y = qk.x = qk.y = qv.x = qv.y = 0;
            if (s) {
                const bf16_t* pp = (it == 0 && tokl == 0) ? (HALO + (size_t)(mt - 1) * LDP + hc) : (P + (size_t)(tok - 1) * LDP + hc);
                qr = *(const uint2*)pp; qk = *(const uint2*)(pp + 768); qv = *(const uint2*)(pp + 1536);
            }
            const size_t zi = (size_t)tok * 768 + hc;
            const uint2 lr2 = *(const uint2*)(Z2 + zi);
            uint2 vs2, vf2; vs2.x = vs2.y = vf2.x = vf2.y = 0;
            if (layer == 1) { vs2 = *(const uint2*)(Z3 + zi); vf2 = *(const uint2*)(Z4 + zi); }
            __syncthreads();
            float r[4] = {bflo(cr.x), bfhi(cr.x), bflo(cr.y), bfhi(cr.y)}, k[4] = {bflo(ck.x), bfhi(ck.x), bflo(ck.y), bfhi(ck.y)}, v[4] = {bflo(cv.x), bfhi(cv.x), bflo(cv.y), bfhi(cv.y)};
            const float rp[4] = {bflo(qr.x), bfhi(qr.x), bflo(qr.y), bfhi(qr.y)}, kp[4] = {bflo(qk.x), bfhi(qk.x), bflo(qk.y), bfhi(qk.y)}, vp[4] = {bflo(qv.x), bfhi(qv.x), bflo(qv.y), bfhi(qv.y)};
            const float mr[4] = {mur.x, mur.y, mur.z, mur.w}, mk[4] = {muk.x, muk.y, muk.z, muk.w}, mv[4] = {muv.x, muv.y, muv.z, muv.w};
            const float lr[4] = {bflo(lr2.x), bfhi(lr2.x), bflo(lr2.y), bfhi(lr2.y)};
            const float vs[4] = {bflo(vs2.x), bfhi(vs2.x), bflo(vs2.y), bfhi(vs2.y)}, vf[4] = {bflo(vf2.x), bfhi(vf2.x), bflo(vf2.y), bfhi(vf2.y)};
            const float kkw_[4] = {kkw4.x, kkw4.y, kkw4.z, kkw4.w}, kaw_[4] = {kaw4.x, kaw4.y, kaw4.z, kaw4.w}, rkw_[4] = {rkw4.x, rkw4.y, rkw4.z, rkw4.w};
            float kk[4], n2 = 0.f, rks = 0.f, bb[4];
#pragma unroll
            for (int j = 0; j < 4; ++j) {
                r[j] += (rp[j] - r[j]) * mr[j]; k[j] += (kp[j] - k[j]) * mk[j]; v[j] += (vp[j] - v[j]) * mv[j];
                if (layer == 1) v[j] += (vf[j] - v[j]) * vs[j];
                kk[j] = k[j] * kkw_[j]; n2 += kk[j] * kk[j];
                k[j] = k[j] * (1.f + (lr[j] - 1.f) * kaw_[j]);
                rks += r[j] * k[j] * rkw_[j];
            }
            n2 = reduce16(n2); rks = reduce16(rks);
            const float inv = 1.f / fmaxf(sqrtf(n2), 1e-12f);
#pragma unroll
            for (int j = 0; j < 4; ++j) { kk[j] *= inv; bb[j] = kk[j] * lr[j]; }
            uint2 w;
            w.x = pk2(r[0], r[1]); w.y = pk2(r[2], r[3]); *(uint2*)pr = w;
            w.x = pk2(k[0], k[1]); w.y = pk2(k[2], k[3]); *(uint2*)(pr + 768) = w;
            w.x = pk2(v[0], v[1]); w.y = pk2(v[2], v[3]); *(uint2*)(pr + 1536) = w;
            if (layer == 0) *(uint2*)(Z4 + zi) = w;
            w.x = pk2(bb[0], bb[1]); w.y = pk2(bb[2], bb[3]); *(uint2*)(Z2 + zi) = w;
            w.x = pk2(kk[0], kk[1]); w.y = pk2(kk[2], kk[3]); *(uint2*)(Z3 + zi) = w;
            if ((tid & 15) == 0) RK[(size_t)tok * 12 + h] = rks;
        }
        __syncthreads();
    }
}

__device__ void scan_phase(const Params& p, char* smem) {
#ifdef NO_SCAN
    return;
#endif
    const bf16_t* P = (const bf16_t*)(p.ws + WS_P);
    const _Float16* E = (const _Float16*)(p.ws + WS_Z);
    const bf16_t* Bv = (const bf16_t*)(p.ws + WS_Z + ZSZ);
    const bf16_t* KK = (const bf16_t*)(p.ws + WS_Z + 2 * ZSZ);
    bf16_t* Y = (bf16_t*)(p.ws + WS_H);
    constexpr int BUFF = 11264;
    float* sBase = (float*)smem; float* sYp = sBase + 2 * BUFF;
    const int tid = opaque_tid(), lane = tid & 63, wave = tid >> 6;
    const bool comp = wave < 4;
    const int row = (wave & 3) * 4 + (lane >> 4), kg = lane & 15;
    const int stid = tid & 255, st_l = stid >> 3, c8 = (stid & 7) * 8;
    for (int u = blockIdx.x; u < 192; u += gridDim.x) {
        const int b = u / 48, h = (u % 48) >> 2, qt = u & 3;
        const size_t tok0 = (size_t)b * S;
        f32x2 S01 = {0.f, 0.f}, S23 = {0.f, 0.f};
        u32x4 gr, gk, ga, gb, gv = {0u, 0u, 0u, 0u}; h8 ge;
        auto gload = [&](int ch) {
            const size_t tok = tok0 + ch * 32 + st_l;
            gr = *(const u32x4*)(P + tok * LDP + h * 64 + c8);
            gk = *(const u32x4*)(P + tok * LDP + 768 + h * 64 + c8);
            ga = *(const u32x4*)(KK + tok * 768 + h * 64 + c8);
            gb = *(const u32x4*)(Bv + tok * 768 + h * 64 + c8);
            ge = *(const h8*)(E + tok * 768 + h * 64 + c8);
            if (stid < 64) { const size_t tk = tok0 + ch * 32 + (stid >> 1); gv = *(const u32x4*)(P + tk * LDP + 1536 + h * 64 + qt * 16 + (stid & 1) * 8); }
        };
        auto st4 = [&](float* dst, const u32x4& g) {
            f32x4 a, c; a[0] = bflo(g[0]); a[1] = bfhi(g[0]); a[2] = bflo(g[1]); a[3] = bfhi(g[1]); c[0] = bflo(g[2]); c[1] = bfhi(g[2]); c[2] = bflo(g[3]); c[3] = bfhi(g[3]);
            *(f32x4*)dst = a; *(f32x4*)(dst + 4) = c;
        };
        auto stage = [&](float* buf) {
            const int o = st_l * 64 + c8;
            st4(buf + 8192 + o, gr); st4(buf + 2048 + o, gk); st4(buf + 4096 + o, ga); st4(buf + 6144 + o, gb);
            f32x4 a, c; a[0] = __expf(-(float)ge[0]); a[1] = __expf(-(float)ge[1]); a[2] = __expf(-(float)ge[2]); a[3] = __expf(-(float)ge[3]);
            c[0] = __expf(-(float)ge[4]); c[1] = __expf(-(float)ge[5]); c[2] = __expf(-(float)ge[6]); c[3] = __expf(-(float)ge[7]);
            *(f32x4*)(buf + o) = a; *(f32x4*)(buf + o + 4) = c;
            if (stid < 64) st4(buf + 10240 + (stid >> 1) * 16 + (stid & 1) * 8, gv);
        };
        auto flush = [&](const float* buf, int ch) {
            if (stid < 64) {
                const float* yp = buf + 10752 + (stid >> 1) * 16 + (stid & 1) * 8;
                const f32x4 a = *(const f32x4*)yp, c = *(const f32x4*)(yp + 4);
                u32x4 w; w[0] = pk2(a[0], a[1]); w[1] = pk2(a[2], a[3]); w[2] = pk2(c[0], c[1]); w[3] = pk2(c[2], c[3]);
                *(u32x4*)(Y + (tok0 + ch * 32 + (stid >> 1)) * 1024 + h * 64 + qt * 16 + (stid & 1) * 8) = w;
            }
        };
        if (!comp) { gload(0); stage(sBase); gload(1); }
        __syncthreads();
        for (int ch = 0; ch < 256; ++ch) {
            float* bufc = sBase + (ch & 1) * BUFF; float* bufo = sBase + ((ch & 1) ^ 1) * BUFF;
            if (comp) {
                float* sY = bufc + 10752;
                unsigned a_cur = (unsigned)(size_t)(LAS char*)(bufc + kg * 4), v_cur = (unsigned)(size_t)(LAS char*)(bufc + 10240 + row);
                f32x4 w0, k0, a0, b0, r0, w1, k1, a1, b1, r1, w2, k2, a2, b2, r2, w3, k3, a3, b3, r3; float v0, v1, v2, v3;
#define SCAN_LOAD(W, K, A, B, R, V, AD, VD) asm volatile("ds_read_b128 %0, %6\n\tds_read_b128 %1, %6 offset:8192\n\tds_read_b128 %2, %6 offset:16384\n\tds_read_b128 %3, %6 offset:24576\n\tds_read_b128 %4, %6 offset:32768\n\tds_read_b32 %5, %7" \
                    : "=&v"(W), "=&v"(K), "=&v"(A), "=&v"(B), "=&v"(R), "=&v"(V) : "v"(AD), "v"(VD) : "memory")
#define SCAN_WAIT(W, K, A, B, R, V, DEP) asm volatile("s_waitcnt lgkmcnt(6)" : "+v"(W), "+v"(K), "+v"(A), "+v"(B), "+v"(R), "+v"(V), "+v"(DEP) :: "memory")
#define SCAN_WAIT0(W, K, A, B, R, V, DEP) asm volatile("s_waitcnt lgkmcnt(0)" : "+v"(W), "+v"(K), "+v"(A), "+v"(B), "+v"(R), "+v"(V), "+v"(DEP) :: "memory")
#define SCAN_STEP(W, K, A, B, R, V, YV) { \
                    f32x2 t = S01 * (f32x2){A[0], A[1]}; t = __builtin_elementwise_fma(S23, (f32x2){A[2], A[3]}, t); \
                    const float d = reduce16(t[0] + t[1]); const f32x2 sa2 = {-d, -d}, v2_ = {V, V}; \
                    const f32x2 u01 = __builtin_elementwise_fma(sa2, (f32x2){B[0], B[1]}, v2_ * (f32x2){K[0], K[1]}); \
                    const f32x2 u23 = __builtin_elementwise_fma(sa2, (f32x2){B[2], B[3]}, v2_ * (f32x2){K[2], K[3]}); \
                    S01 = __builtin_elementwise_fma(S01, (f32x2){W[0], W[1]}, u01); S23 = __builtin_elementwise_fma(S23, (f32x2){W[2], W[3]}, u23); \
                    f32x2 y2 = S01 * (f32x2){R[0], R[1]}; y2 = __builtin_elementwise_fma(S23, (f32x2){R[2], R[3]}, y2); \
                    YV = y2[0] + y2[1]; }
                SCAN_LOAD(w0, k0, a0, b0, r0, v0, a_cur, v_cur);
                { const unsigned an = a_cur + 256, vn = v_cur + 64; SCAN_LOAD(w1, k1, a1, b1, r1, v1, an, vn); }
                float yv = 0.f;
                float* ypw = sYp + row * 16 + kg;
#pragma unroll 1
                for (int q = 0; q < 8; ++q) {
                    const int sb = (q & 3) * 4;
                    SCAN_WAIT(w0, k0, a0, b0, r0, v0, yv);
                    { const unsigned an = a_cur + 512, vn = v_cur + 128; SCAN_LOAD(w2, k2, a2, b2, r2, v2, an, vn); }
                    SCAN_STEP(w0, k0, a0, b0, r0, v0, yv)
                    ypw[sb * 256] = yv;
                    SCAN_WAIT(w1, k1, a1, b1, r1, v1, yv);
                    { const unsigned an = a_cur + 768, vn = v_cur + 192; SCAN_LOAD(w3, k3, a3, b3, r3, v3, an, vn); }
                    SCAN_STEP(w1, k1, a1, b1, r1, v1, yv)
                    ypw[(sb + 1) * 256] = yv;
                    SCAN_WAIT(w2, k2, a2, b2, r2, v2, yv);
                    a_cur += 1024; v_cur += 256;
                    SCAN_LOAD(w0, k0, a0, b0, r0, v0, a_cur, v_cur);
                    SCAN_STEP(w2, k2, a2, b2, r2, v2, yv)
                    ypw[(sb + 2) * 256] = yv;
                    SCAN_WAIT(w3, k3, a3, b3, r3, v3, yv);
                    { const unsigned an = a_cur + 256, vn = v_cur + 64; SCAN_LOAD(w1, k1, a1, b1, r1, v1, an, vn); }
                    SCAN_STEP(w3, k3, a3, b3, r3, v3, yv)
                    ypw[(sb + 3) * 256] = yv;
                    if ((q & 3) == 3) {
                        const int hh = q >> 2, stp = lane >> 2, rw_ = (wave & 3) * 4 + (lane & 3);
                        const f32x4* pp = (const f32x4*)(sYp + stp * 256 + rw_ * 16);
                        const f32x4 q0 = pp[0], q1 = pp[1], q2 = pp[2], q3 = pp[3];
                        const float ysum = ((q0[0] + q0[1]) + (q0[2] + q0[3])) + ((q1[0] + q1[1]) + (q1[2] + q1[3])) + ((q2[0] + q2[1]) + (q2[2] + q2[3])) + ((q3[0] + q3[1]) + (q3[2] + q3[3]));
                        sY[(hh * 16 + stp) * 16 + rw_] = ysum;
                    }
                }
                SCAN_WAIT0(w0, k0, a0, b0, r0, v0, yv);
                SCAN_WAIT0(w1, k1, a1, b1, r1, v1, yv);
#undef SCAN_WAIT0
#undef SCAN_LOAD
#undef SCAN_WAIT
#undef SCAN_STEP
            } else {
                if (ch > 0) flush(bufo, ch - 1);
                if (ch + 1 < 256) { stage(bufo); if (ch + 2 < 256) gload(ch + 2); }
            }
            __syncthreads();
        }
        if (!comp) flush(sBase + BUFF, 255);
        __syncthreads();
    }
}

__device__ void post_phase(const Params& p, int layer) {
#ifdef NO_POST
    return;
#endif

    bf16_t* H = (bf16_t*)(p.ws + WS_H); const bf16_t* P = (const bf16_t*)(p.ws + WS_P); const float* RK = (const float*)(p.ws + WS_RK);
    const float* lg = p.in[15] + (size_t)layer * 768; const float* lb = p.in[16] + (size_t)layer * 768;
    const int tid = opaque_tid(), cg4 = (tid & 15) * 4;
    const int npairs = T * 12;
    for (int pr = blockIdx.x * (NT / 16) + (tid >> 4); pr < npairs; pr += gridDim.x * (NT / 16)) {
        const int tok = pr / 12, h = pr - tok * 12, hc = h * 64 + cg4;
        bf16_t* yp = H + (size_t)tok * 1024 + hc;
        const uint2 y2 = *(const uint2*)yp, v2 = *(const uint2*)(P + (size_t)tok * LDP + 1536 + hc);
        const float y[4] = {bflo(y2.x), bfhi(y2.x), bflo(y2.y), bfhi(y2.y)}, v[4] = {bflo(v2.x), bfhi(v2.x), bflo(v2.y), bfhi(v2.y)};
        const float mean = reduce16((y[0] + y[1]) + (y[2] + y[3])) * (1.f / 64.f);
        float q = 0.f;
#pragma unroll
        for (int j = 0; j < 4; ++j) { const float d = y[j] - mean; q += d * d; }
        const float rstd = rsqrtf(reduce16(q) * (1.f / 64.f) + 64e-5f);
        const float rk = RK[(size_t)tok * 12 + h];
        const float4 g4 = *(const float4*)(lg + hc), b4 = *(const float4*)(lb + hc);
        const float g[4] = {g4.x, g4.y, g4.z, g4.w}, bb[4] = {b4.x, b4.y, b4.z, b4.w};
        float o[4];
#pragma unroll
        for (int j = 0; j < 4; ++j) o[j] = (y[j] - mean) * rstd * g[j] + bb[j] + rk * v[j];
        uint2 w; w.x = pk2(o[0], o[1]); w.y = pk2(o[2], o[3]);
        *(uint2*)yp = w;
    }
}

__device__ void subnorm_phase(const Params& p, int j) {
#ifdef NO_SUB
    return;
#endif

    const bf16_t* PB = (const bf16_t*)(p.ws + WS_PROJB); bf16_t* CQ = (bf16_t*)(p.ws + WS_CQ);
    const float* CKR = (const float*)(p.ws + WS_CKR); bf16_t* CKV = (bf16_t*)(p.ws + WS_CKV); bf16_t* KF = (bf16_t*)(p.ws + WS_KFULL);
    const float* rope = (const float*)(p.ws + WS_ROPE);
    const float* gq = p.in[32] + (size_t)j * 512; const float* gl = p.in[28];
    const int tid_ = opaque_tid(), lane = tid_ & 63, gw = blockIdx.x * NWV + (tid_ >> 6), nw = gridDim.x * NWV;
    for (int tok = gw; tok < T; tok += nw) {
        {
            const uint4 c = *(const uint4*)(PB + (size_t)tok * 768 + lane * 8);
            float v[8] = {bflo(c.x), bfhi(c.x), bflo(c.y), bfhi(c.y), bflo(c.z), bfhi(c.z), bflo(c.w), bfhi(c.w)};
            float ss = 0.f;
#pragma unroll
            for (int i = 0; i < 8; ++i) ss += v[i] * v[i];
            ss = wave_sum(ss);
            const float rs = rsqrtf(ss * (1.f / 512.f) + 1e-6f);
            const float4 g0 = *(const float4*)(gq + lane * 8), g1 = *(const float4*)(gq + lane * 8 + 4);
            uint4 w; w.x = pk2(v[0] * rs * g0.x, v[1] * rs * g0.y); w.y = pk2(v[2] * rs * g0.z, v[3] * rs * g0.w);
            w.z = pk2(v[4] * rs * g1.x, v[5] * rs * g1.y); w.w = pk2(v[6] * rs * g1.z, v[7] * rs * g1.w);
            *(uint4*)(CQ + (size_t)tok * 512 + lane * 8) = w;
        }
        if (j == 0) {
            const float4 c = *(const float4*)(CKR + (size_t)tok * 384 + lane * 4);
            float ss = c.x * c.x + c.y * c.y + c.z * c.z + c.w * c.w;
            ss = wave_sum(ss);
            const float rs = rsqrtf(ss * (1.f / 256.f) + 1e-6f);
            const float4 g = *(const float4*)(gl + lane * 4);
            uint2 w; w.x = pk2(c.x * rs * g.x, c.y * rs * g.y); w.y = pk2(c.z * rs * g.z, c.w * rs * g.w);
            *(uint2*)(CKV + (size_t)tok * 256 + lane * 4) = w;
            const int i = lane & 15, hg = lane >> 4;
            const float x1 = CKR[(size_t)tok * 384 + 256 + i], x2 = CKR[(size_t)tok * 384 + 272 + i];
            const float cs = rope[(size_t)tok * 32 + i], sn = rope[(size_t)tok * 32 + 16 + i];
            const bf16_t o1 = f2bf(x1 * cs - x2 * sn), o2 = f2bf(x2 * cs + x1 * sn);
            const int b = tok >> 13, s = tok & (S - 1);
#pragma unroll
            for (int hh = 0; hh < 3; ++hh) {
                bf16_t* kp = KF + ((size_t)(b * 12 + hg * 3 + hh) * S + s) * 96 + 64 + i;
                kp[0] = o1; kp[16] = o2;
            }
        }
    }
}

__device__ void rope_phase(const Params& p) {
    const int* pos = (const int*)p.in[2]; float* rope = (float*)(p.ws + WS_ROPE);
    const int tid_ = opaque_tid();
    for (int idx = blockIdx.x * NT + tid_; idx < T * 16; idx += gridDim.x * NT) {
        const int tok = idx >> 4, i = idx & 15;
        const float invf = powf(10000.f, -(float)i / 16.f);
        const float ang = (float)pos[tok] * invf;
        rope[(size_t)tok * 32 + i] = cosf(ang); rope[(size_t)tok * 32 + 16 + i] = sinf(ang);
    }
}

__device__ bool get_gemm_job(const Params& p, int ph, int jn, GemmJob& g) {
    char* ws = p.ws;
    bf16_t* WA = (bf16_t*)(ws + WS_WA); bf16_t* WF = (bf16_t*)(ws + WS_WF); bf16_t* H = (bf16_t*)(ws + WS_H); bf16_t* P = (bf16_t*)(ws + WS_P);
    bf16_t* LIN = (bf16_t*)(ws + WS_LIN); bf16_t* KMEM = (bf16_t*)(ws + WS_KMEM); bf16_t* VTMEM = (bf16_t*)(ws + WS_VTMEM); bf16_t* MEMN = (bf16_t*)(ws + WS_MEMN);
    g.M = T; g.e.o1 = nullptr; g.e.bias = nullptr; g.e.resid = nullptr; g.e.halo = nullptr; g.e.ldc = 0;
    const bool rw = ph < 25;
    const int L = rw ? (ph - 1) / 12 : 2 + (ph - 25) / 9, r = rw ? (ph - 1) % 12 : (ph - 25) % 9;
    const int r_wout = rw ? 8 : 5, r_gu = rw ? 10 : 7, r_down = rw ? 11 : 8;
    if (r == r_wout) { if (jn) return false; g.A = H; g.lda = 1024; g.W = WA + (rw ? A_WOUT : B_WOUT); g.K = 1024; g.N = 1024; g.kind = E_RESID; g.e.o0 = p.out; g.e.resid = (L == 0) ? p.in[0] : p.out; g.e.ldc = 1024; return true; }
    if (r == r_gu) { if (jn) return false; g.A = H; g.lda = 1024; g.W = WF + F_GU; g.K = 1024; g.N = 5632; g.kind = E_SWIGLU; g.e.o0 = P; g.e.ldc = 2816; return true; }
    if (r == r_down) { if (jn) return false; g.A = P; g.lda = 2816; g.W = WF + F_DOWN; g.K = 2816; g.N = 1024; g.kind = E_RESID; g.e.o0 = p.out; g.e.resid = p.out; g.e.ldc = 1024; return true; }
    if (r == 1 && jn == 1) { g.A = MEMN; g.lda = 1024; g.W = WA + (rw ? A_MKV : B_MKV); g.K = 1024; g.M = 1024; g.N = 512; g.kind = E_MEMKV; g.e.o0 = KMEM; g.e.o1 = VTMEM; return true; }
    if (rw) {
        const int i = L;
        if (r == 1 && jn == 0) { g.A = H; g.lda = 1024; g.W = WA + A_WIN; g.K = 1024; g.N = (i == 1) ? 2944 : 2816; g.kind = E_BF16; g.e.o0 = P; g.e.ldc = LDP; g.e.halo = (bf16_t*)(ws + WS_HALO); return true; }
        if (r == 3) {
            if (jn == 0) { g.A = LIN; g.lda = 320; g.W = WA + A_DEC; g.K = 64; g.N = 768; g.kind = E_DECAY; g.e.o0 = ws + WS_Z; g.e.bias = p.in[8] + (size_t)i * 768; g.e.ldc = 768; return true; }
            if (jn == 1) { g.A = LIN + 64; g.lda = 320; g.W = WA + A_AAA; g.K = 64; g.N = 768; g.kind = E_SIGB; g.e.o0 = ws + WS_Z + ZSZ; g.e.bias = p.in[10] + (size_t)i * 768; g.e.ldc = 768; return true; }
            if (jn == 2 && i == 1) { g.A = LIN + 256; g.lda = 320; g.W = WA + A_VUP; g.K = 64; g.N = 768; g.kind = E_SIGB; g.e.o0 = ws + WS_Z + 2 * ZSZ; g.e.bias = p.in[25]; g.e.ldc = 768; return true; }
            return false;
        }
        if (r == 7 && jn == 0) { g.A = LIN + 128; g.lda = 320; g.W = WA + A_GATE; g.K = 128; g.N = 768; g.kind = E_MULG; g.e.o0 = H; g.e.ldc = 1024; return true; }
        return false;
    }
    const int j = L - 2;
    if (r == 1) {
        if (jn == 0) { g.A = H; g.lda = 1024; g.W = WA + B_WIN; g.K = 1024; g.N = 768; g.kind = E_BF16; g.e.o0 = ws + WS_PROJB; g.e.ldc = 768; return true; }
        if (jn == 2 && j == 0) { g.A = (bf16_t*)(ws + WS_QFULL); g.lda = 1024; g.W = WA + B_KVD; g.K = 1024; g.N = 384; g.kind = E_F32; g.e.o0 = ws + WS_CKR; g.e.ldc = 384; return true; }
        return false;
    }
    if (r == 3) {
        if (jn == 0) { g.A = (bf16_t*)(ws + WS_CQ); g.lda = 512; g.W = WA + B_QUP; g.K = 512; g.N = 1152; g.kind = E_BF16; g.e.o0 = ws + WS_QFULL; g.e.ldc = 1152; return true; }
        if (jn == 1 && j == 0) { g.A = (bf16_t*)(ws + WS_CKV); g.lda = 256; g.W = WA + B_KVU; g.K = 256; g.N = 1536; g.kind = E_KV; g.e.o0 = ws + WS_KFULL; g.e.o1 = ws + WS_VT; return true; }
        return false;
    }
    return false;
}

__device__ void run_phase(const Params& p, int ph, char* smem) {
    char* ws = p.ws;
    bf16_t* H = (bf16_t*)(ws + WS_H);
    const float MEMSCL = 0.125f * 1.4426950408889634f, MLASCL = 0.10206207261596575f * 1.4426950408889634f;
    int rot = 0;
    const bool rw = ph >= 1 && ph < 25, mla = ph >= 25 && ph < 43;
    const int L = rw ? (ph - 1) / 12 : (mla ? 2 + (ph - 25) / 9 : 0), r = rw ? (ph - 1) % 12 : (mla ? (ph - 25) % 9 : -1);
    {
        const float* x = nullptr; int nrows = T; const float* g1 = nullptr; bf16_t* o1 = H; const float* g2 = nullptr; bf16_t* o2 = nullptr; float* of = nullptr;
        if (ph == 0) { x = p.in[1]; nrows = 1024; g1 = p.in[3]; o1 = (bf16_t*)(ws + WS_MEMN); }
        else if (ph == 43) { x = p.out; g1 = p.in[39]; of = p.out; }
        else if (rw && r == 0) { x = (L == 0) ? p.in[0] : p.out; g1 = p.in[4] + (size_t)L * 1024; }
        else if (rw && r == 9) { x = p.out; g1 = p.in[19] + (size_t)L * 1024; }
        else if (mla && r == 0) { x = p.out; g1 = p.in[30] + (size_t)(L - 2) * 1024; if (L == 2) { g2 = p.in[26]; o2 = (bf16_t*)(ws + WS_QFULL); } }
        else if (mla && r == 6) { x = p.out; g1 = p.in[36] + (size_t)(L - 2) * 1024; }
        if (x) rmsnorm_phase(x, nrows, g1, o1, g2, o2, of);
    }
    if (ph == 0) rope_phase(p);
    int cvb = blockIdx.x, cVG = gridDim.x;
    {
        int kind = -1, CL = 0;
        if (ph == 0) { kind = 0; CL = 0; }
        else if ((rw || mla) && r == 0) { kind = 1; CL = L; }
        else if (rw && r == 9) { kind = 0; CL = L + 1; }
        else if (mla && r == 6 && L == 2) { kind = 0; CL = 3; }
        const int GG = gridDim.x; const bool split = false;

        if (split && GG == 512) { const int b_ = blockIdx.x; cvb = (b_ >= 192 && b_ < 256) ? b_ - 192 : (b_ >= 448 ? b_ - 384 : -1); cVG = 128; }
        else { cvb = split ? (int)blockIdx.x - 192 : (int)blockIdx.x; cVG = split ? GG - 192 : GG; }
        if (kind >= 0 && cvb >= 0) { ConvJob c; for (int idx = 0; get_conv_job(p, kind, CL, idx, c); ++idx) run_conv(c, rot, smem, cvb, cVG); }
    }
    { GemmJob g; for (int jn = 0; jn < 3; ++jn) if (get_gemm_job(p, ph, jn, g)) { gemm_job(g, rot, smem); } }
    if ((rw || mla) && r == 3) {
        const bf16_t* Q = rw ? (const bf16_t*)(ws + WS_P) : (const bf16_t*)(ws + WS_PROJB);
        attn_phase<64, false>(Q, rw ? LDP : 768, rw ? 2560 : 512, (const bf16_t*)(ws + WS_KMEM), 256 * 64, (const bf16_t*)(ws + WS_VTMEM), 64 * 256, 256, 4, 256, nullptr, MEMSCL, H, 1024, 768, rot, smem, cvb, cVG);
    }
    if (mla && r == 4)
        attn_phase<96, true>((const bf16_t*)(ws + WS_QFULL), 1152, 0, (const bf16_t*)(ws + WS_KFULL), (size_t)S * 96, (const bf16_t*)(ws + WS_VT), (size_t)64 * S, S, 12, S, (const float*)(ws + WS_ROPE), MLASCL, H, 1024, 0, rot, smem, blockIdx.x, gridDim.x);
    if (rw && r == 2) lora_in_phase(p, L);
    if (rw && r == 4) prep_phase(p, L);
    if (rw && r == 5 && (blockIdx.x < 192 || cVG == (int)gridDim.x)) scan_phase(p, smem);
    if (rw && r == 6) post_phase(p, L);
    if (mla && r == 2) subnorm_phase(p, L - 2);
}

#define XB_TMO      128
#define XB_XCNT(j)  (256  + 64 * (j))
#define XB_XSUB(j)  (1280 + 64 * (j))
#define XB_XGEN(j)  (2304 + 64 * (j))
#define XB_TOP      3328
#define XB_TOPGEN   3392
#define XCD_BAR_WORDS 3456
#define XB_SPIN_CAP (1u << 18)
__device__ __forceinline__ unsigned xb_ld(unsigned* p)              { return __hip_atomic_load(p, __ATOMIC_RELAXED, __HIP_MEMORY_SCOPE_AGENT); }
__device__ __forceinline__ unsigned xb_add(unsigned* p, unsigned v) { return __hip_atomic_fetch_add(p, v, __ATOMIC_RELAXED, __HIP_MEMORY_SCOPE_AGENT); }
__device__ __forceinline__ unsigned xb_xcc_id() { return (unsigned)__builtin_amdgcn_s_getreg((3 << 11) | 20) & 0xFu; }
#define XB_SPIN(cond, bar) do { unsigned _sp = 0; while (cond) { __builtin_amdgcn_s_sleep(1); \
    if ((++_sp & 255u) == 0u) { if (xb_ld(&(bar)[XB_TMO])) break; if (_sp > XB_SPIN_CAP) { atomicAdd(&(bar)[XB_TMO], 1u); break; } } } } while (0)
struct XcdBarrier { unsigned* bar; unsigned x; volatile LAS unsigned* st; };
__device__ __forceinline__ XcdBarrier xcd_barrier_post(unsigned* bar, volatile LAS unsigned* st) {
    XcdBarrier b; b.bar = bar; b.x = xb_xcc_id(); b.st = st;
    if (threadIdx.x == 0) (void)xb_add(&bar[XB_XCNT(b.x)], 1u);
    return b;
}
__device__ __forceinline__ void xcd_barrier_complete(unsigned* bar, unsigned x, unsigned& nloc, unsigned& nx) {
    const unsigned G = gridDim.x * gridDim.y * gridDim.z;
    unsigned sum, cnt, mine, sp = 0u;
    for (;;) {
        sum = 0u; cnt = 0u; mine = 0u;
#pragma unroll
        for (unsigned j = 0; j < 16; ++j) { const unsigned c = xb_ld(&bar[XB_XCNT(j)]); sum += c; cnt += (c > 0u) ? 1u : 0u; mine = (j == x) ? c : mine; }
        if (sum == G) break;
        __builtin_amdgcn_s_sleep(1);
        if ((++sp & 255u) == 0u) { if (xb_ld(&bar[XB_TMO])) break; if (sp > XB_SPIN_CAP) { atomicAdd(&bar[XB_TMO], 1u); break; } }
    }
    nloc = mine > 0u ? mine : 1u; nx = cnt > 0u ? cnt : 1u;
}
__device__ __forceinline__ void xcd_barrier(const XcdBarrier& b) {
    asm volatile("s_waitcnt vmcnt(0)" ::: "memory");
    __syncthreads();
    if (threadIdx.x == 0) {
        unsigned* bar = b.bar;
        __builtin_amdgcn_s_waitcnt(0);
        unsigned nloc = b.st[0], nx = b.st[1];
        if (nloc == 0u) { xcd_barrier_complete(bar, b.x, nloc, nx); b.st[0] = nloc; b.st[1] = nx; }
        const unsigned old = xb_add(&bar[XB_XSUB(b.x)], 1u);
        const unsigned gen = old / nloc;
        if (old + 1u == (gen + 1u) * nloc) {
            __builtin_amdgcn_fence(__ATOMIC_RELEASE, "agent");
            asm volatile("s_waitcnt vmcnt(0)" ::: "memory");
            const unsigned og = xb_add(&bar[XB_TOP], 1u);
            const unsigned tg = og / nx;
            if (og + 1u == (tg + 1u) * nx) xb_add(&bar[XB_TOPGEN], 1u);
            else XB_SPIN(xb_ld(&bar[XB_TOPGEN]) == tg, bar);
            __builtin_amdgcn_fence(__ATOMIC_ACQUIRE, "agent");
            xb_add(&bar[XB_XGEN(b.x)], 1u);
            asm volatile("s_waitcnt vmcnt(0)" ::: "memory");
        } else {
            XB_SPIN(xb_ld(&bar[XB_XGEN(b.x)]) == gen, bar);
            __builtin_amdgcn_fence(__ATOMIC_ACQUIRE, "agent");
            asm volatile("s_waitcnt vmcnt(0)" ::: "memory");
        }
    }
    __syncthreads();
}

__global__ void __launch_bounds__(NT) yoco_mega(Params p) {
    extern __shared__ __attribute__((aligned(16))) char smem[];
    cg::grid_group grid = cg::this_grid();
    volatile LAS unsigned* st = (volatile LAS unsigned*)((LAS char*)smem + LDS_MAIN);
    if (threadIdx.x == 0) { st[0] = 0u; st[1] = 0u; }
    __syncthreads();
    const XcdBarrier xb = xcd_barrier_post((unsigned*)(p.ws + WS_BAR), st);
    if (p.ph_lo < 0) grid.sync();
    for (int ph = p.ph_lo; ph < p.ph_hi; ++ph) {
        int nrep = 1;
#if PROBE_DUP
        {
            const bool rw = ph >= 1 && ph < 25, mla = ph >= 25 && ph < 43;
            const int r = rw ? (ph - 1) % 12 : (mla ? (ph - 25) % 9 : -1);
            if ((PROBE_DUP & 1) && rw && r == 5) nrep = 2;
            if ((PROBE_DUP & 2) && ((rw && r == 10) || (mla && r == 7))) nrep = 2;
            if ((PROBE_DUP & 4) && mla && r == 4) nrep = 2;
            if ((PROBE_DUP & 8) && rw && r == 3) nrep = 2;
            if ((PROBE_DUP & 16) && ((rw && (r == 0 || r == 9)) || (mla && (r == 0 || r == 6)))) nrep = 2;
            if ((PROBE_DUP & 32) && ((rw && r == 2) || (mla && (r == 2 || r == 3)))) nrep = 2;
        }
#endif
        for (int rep = 0; rep < nrep; ++rep) {
            run_phase(p, ph, smem);
            if (rep + 1 < nrep || ph + 1 < p.ph_hi) xcd_barrier(xb);
        }
    }
}

#ifndef PROBE_DUP
#define PROBE_DUP 0
#endif
#ifndef MULTI_LAUNCH
#define MULTI_LAUNCH 0
#endif

extern "C" void kernel_launch(void* const* d_in, const int* in_sizes, int n_in, void* d_out, int out_size, void* d_ws, size_t ws_size, hipStream_t stream) {
    static int grid_blocks = 0;
    if (!grid_blocks) {
        int dev = 0, cus = 0, per_cu = 0;
        hipGetDevice(&dev);
        hipDeviceGetAttribute(&cus, hipDeviceAttributeMultiprocessorCount, dev);
        hipFuncSetAttribute((const void*)yoco_mega, hipFuncAttributeMaxDynamicSharedMemorySize, LDS_BYTES);
        hipOccupancyMaxActiveBlocksPerMultiprocessor(&per_cu, (const void*)yoco_mega, NT, LDS_BYTES);
        if (per_cu < 1) per_cu = 1;
        if (per_cu > 1) per_cu = 1;
        grid_blocks = cus * per_cu;
        if (ws_size < WS_END) fprintf(stderr, "kernel_launch: workspace too small: %zu < %zu\n", ws_size, (size_t)WS_END);
        if (n_in != 40) fprintf(stderr, "kernel_launch: expected 40 inputs, got %d\n", n_in);
    }
    Params p{};
    for (int i = 0; i < 40; ++i) p.in[i] = (const float*)d_in[i];
    p.out = (float*)d_out; p.ws = (char*)d_ws;
#if MULTI_LAUNCH
    for (int ph = 0; ph < 44; ++ph) {
        p.ph_lo = ph; p.ph_hi = ph + 1;
        hipLaunchKernelGGL(yoco_mega, dim3(grid_blocks), dim3(NT), LDS_BYTES, stream, p);
    }
#else
    p.ph_lo = 0; p.ph_hi = 44;
    (void)hipMemsetAsync((char*)d_ws + WS_BAR, 0, 16384, stream);
    void* args[] = {&p};
    hipError_t e = hipLaunchCooperativeKernel((const void*)yoco_mega, dim3(grid_blocks), dim3(NT), args, LDS_BYTES, stream);
    if (e != hipSuccess) fprintf(stderr, "cooperative launch failed: %s (grid %d)\n", hipGetErrorString(e), grid_blocks);
#endif
}
```

```cpp
#include <hip/hip_runtime.h>
#include <hip/hip_cooperative_groups.h>
#include <cstdio>
#include <cstdint>
namespace cg = cooperative_groups;
#define PROBE_DUP 0

typedef unsigned short bf16_t;
typedef short bf16x8 __attribute__((ext_vector_type(8)));
typedef float f32x16 __attribute__((ext_vector_type(16)));
typedef _Float16 h8 __attribute__((ext_vector_type(8)));
typedef unsigned u32x4 __attribute__((ext_vector_type(4)));
typedef float f32x2 __attribute__((ext_vector_type(2)));
#define LAS __attribute__((address_space(3)))
typedef float f32x4 __attribute__((ext_vector_type(4)));

constexpr int T = 32768, S = 8192;
constexpr int LDP = 2944;
constexpr int NT = 512, NWV = 8;
constexpr int LDS_MAIN = 147456;
constexpr int LDS_BYTES = LDS_MAIN + 16;

constexpr size_t WS_WA = 0;
constexpr size_t WS_WF = WS_WA + 10485760;
constexpr size_t WS_H = WS_WF + 17825792;
constexpr size_t WS_P = WS_H + 67108864;
constexpr size_t WS_Z = WS_P + 192937984;
constexpr size_t ZSZ = 50331648;
constexpr size_t WS_LIN = WS_Z + 4 * ZSZ;
constexpr size_t WS_RK = WS_LIN + 20971520;
constexpr size_t WS_ROPE = WS_RK + 1572864;
constexpr size_t WS_KMEM = WS_ROPE + 4194304;
constexpr size_t WS_VTMEM = WS_KMEM + 524288;
constexpr size_t WS_MEMN = WS_VTMEM + 524288;
constexpr size_t WS_HALO = WS_MEMN + 2097152;
constexpr size_t WS_BAR = WS_HALO + 1507328;
constexpr size_t WS_END = WS_BAR + 16384;
constexpr size_t WS_KFULL = WS_Z;
constexpr size_t WS_VT = WS_KFULL + 75497472;
constexpr size_t WS_PROJB = WS_VT + 50331648;
constexpr size_t WS_QFULL = WS_P;
constexpr size_t WS_CQ = WS_QFULL + 75497472;
constexpr size_t WS_CKR = WS_CQ + 33554432;
constexpr size_t WS_CKV = WS_CKR + 50331648;
constexpr size_t A_WIN = 0, A_DEC = 3014656, A_AAA = 3063808, A_GATE = 3112960, A_VUP = 3211264, A_MKV = 3260416, A_WOUT = 3784704;
constexpr size_t B_WIN = 0, B_QUP = 786432, B_MKV = 1376256, B_WOUT = 1900544, B_KVD = 2949120, B_KVU = 3342336;
constexpr size_t F_GU = 0, F_DOWN = 5767168;

struct Params { const float* in[40]; float* out; char* ws; int ph_lo, ph_hi; };

__device__ __forceinline__ bf16_t f2bf(float f) { unsigned u = __float_as_uint(f); u += 0x7fffu + ((u >> 16) & 1u); return (bf16_t)(u >> 16); }
__device__ __forceinline__ unsigned pk2(float lo, float hi) { unsigned r; asm("v_cvt_pk_bf16_f32 %0, %1, %2" : "=v"(r) : "v"(lo), "v"(hi)); return r; }
__device__ __forceinline__ float bflo(unsigned u) { return __uint_as_float(u << 16); }
__device__ __forceinline__ float bfhi(unsigned u) { return __uint_as_float(u & 0xffff0000u); }
__device__ __forceinline__ float bf2f(bf16_t v) { return __uint_as_float((unsigned)v << 16); }
__device__ __forceinline__ float reduce16(float x);
__device__ __forceinline__ float wave_sum(float v) {
    v = reduce16(v);
    const int b = __float_as_int(v);
    return (__int_as_float(__builtin_amdgcn_readlane(b, 0)) + __int_as_float(__builtin_amdgcn_readlane(b, 16))) +
           (__int_as_float(__builtin_amdgcn_readlane(b, 32)) + __int_as_float(__builtin_amdgcn_readlane(b, 48)));
}
template <int CTRL> __device__ __forceinline__ float dppmov(float x) { return __int_as_float(__builtin_amdgcn_update_dpp(0, __float_as_int(x), CTRL, 0xF, 0xF, true)); }
__device__ __forceinline__ float reduce16(float x) {
    x += dppmov<0xB1>(x); x += dppmov<0x4E>(x); x += dppmov<0x141>(x); x += dppmov<0x140>(x); return x;
}
__device__ __forceinline__ int opaque_tid() { int t = threadIdx.x; asm volatile("" : "+v"(t)); return t; }
__device__ __forceinline__ float sigmoidf_(float x) { return __builtin_amdgcn_rcpf(1.f + __expf(-x)); }

__device__ void rmsnorm_phase(const float* x, int nrows, const float* g1, bf16_t* o1, const float* g2, bf16_t* o2, float* of) {
    const int tid_ = opaque_tid(), lane = tid_ & 63, gw = blockIdx.x * NWV + (tid_ >> 6), nw = gridDim.x * NWV;
    for (int row = gw; row < nrows; row += nw) {
        const float4* xr = (const float4*)(x + (size_t)row * 1024);
        float4 v[4]; float ss = 0.f;
#pragma unroll
        for (int i = 0; i < 4; ++i) { v[i] = xr[lane + 64 * i]; ss += v[i].x * v[i].x + v[i].y * v[i].y + v[i].z * v[i].z + v[i].w * v[i].w; }
        ss = wave_sum(ss);
        const float rs = rsqrtf(ss * (1.f / 1024.f) + 1e-6f);
#pragma unroll
        for (int i = 0; i < 4; ++i) {
            const float4 g = ((const float4*)g1)[lane + 64 * i];
            const float a = v[i].x * rs, b = v[i].y * rs, c = v[i].z * rs, d = v[i].w * rs;
            if (of) { float4 o; o.x = a * g.x; o.y = b * g.y; o.z = c * g.z; o.w = d * g.w; ((float4*)(of + (size_t)row * 1024))[lane + 64 * i] = o; }
            else {
                uint2 w; w.x = pk2(a * g.x, b * g.y); w.y = pk2(c * g.z, d * g.w);
                *(uint2*)(o1 + (size_t)row * 1024 + (lane + 64 * i) * 4) = w;
                if (o2) { const float4 h = ((const float4*)g2)[lane + 64 * i]; uint2 w2; w2.x = pk2(a * h.x, b * h.y); w2.y = pk2(c * h.z, d * h.w);
                    *(uint2*)(o2 + (size_t)row * 1024 + (lane + 64 * i) * 4) = w2; }
            }
        }
    }
}

struct ConvJob { const float* src; int ld; int ncols; int kvalid; bf16_t* dst; int dstK; int ngran; int swiglu; const float* rscale; int rsmode; };
__device__ void run_conv(const ConvJob& j, int& rot, char* smem, int vb, int G) {
#ifdef NO_CONV
    return;
#endif

    bf16_t* lds = (bf16_t*)smem;
    const int tid = opaque_tid(), nkt = j.dstK >> 6, units = j.ngran * nkt;
    for (int u = (vb + G - rot) % G; u < units; u += G) {
        const int g = u / nkt, kt = u - g * nkt, k0 = kt * 64;
        int col0 = j.swiglu ? ((g & 1) * 2816 + 32 * (g >> 1)) : 32 * g;
        const bool colok = (col0 + 32 <= j.ncols);
#pragma unroll
        for (int i = 0; i < 4; ++i) {
            const int kr = (tid >> 5) + 16 * i, c = tid & 31, k = k0 + kr;
            float v = 0.f;
            if (colok && k < j.kvalid) {
                v = j.src[(size_t)k * j.ld + col0 + c];
                if (j.rsmode == 1) v *= (1.f - j.rscale[k]); else if (j.rsmode == 2) v *= j.rscale[k];
            }
            lds[c * 72 + kr] = f2bf(v);
        }
        __syncthreads();
        if (tid < 256) { const int c = tid >> 3, kc = (tid & 7) * 8;
          const uint4 w = *(const uint4*)(lds + c * 72 + kc);
          *(uint4*)(j.dst + (size_t)(g * 32 + c) * j.dstK + k0 + kc) = w; }
        __syncthreads();
    }
    rot = (rot + units) % G;
}
__device__ bool get_conv_job(const Params& p, int kind, int L, int idx, ConvJob& c) {
    bf16_t* WA = (bf16_t*)(p.ws + WS_WA); bf16_t* WF = (bf16_t*)(p.ws + WS_WF);
    c.swiglu = 0; c.rscale = nullptr; c.rsmode = 0;
    if (kind == 1) {
        if (idx == 0) { c.src = (L < 2) ? p.in[20] + (size_t)L * 1024 * 5632 : p.in[37] + (size_t)(L - 2) * 1024 * 5632; c.ld = 5632; c.ncols = 5632; c.kvalid = 1024; c.dst = WF + F_GU; c.dstK = 1024; c.ngran = 176; c.swiglu = 1; return true; }
        if (idx == 1) { c.src = (L < 2) ? p.in[21] + (size_t)L * 2816 * 1024 : p.in[38] + (size_t)(L - 2) * 2816 * 1024; c.ld = 1024; c.ncols = 1024; c.kvalid = 2816; c.dst = WF + F_DOWN; c.dstK = 2816; c.ngran = 32; return true; }
        return false;
    }
    if (L < 2) {
        const int i = L;
        switch (idx) {
        case 0: c.src = p.in[5] + (size_t)i * 1024 * 2816; c.ld = 2816; c.ncols = 2816; c.kvalid = 1024; c.dst = WA + A_WIN; c.dstK = 1024; c.ngran = 88; return true;
        case 1: c.src = p.in[7] + (size_t)i * 64 * 768; c.ld = 768; c.ncols = 768; c.kvalid = 64; c.dst = WA + A_DEC; c.dstK = 64; c.ngran = 24; return true;
        case 2: c.src = p.in[9] + (size_t)i * 64 * 768; c.ld = 768; c.ncols = 768; c.kvalid = 64; c.dst = WA + A_AAA; c.dstK = 64; c.ngran = 24; return true;
        case 3: c.src = p.in[11] + (size_t)i * 128 * 768; c.ld = 768; c.ncols = 768; c.kvalid = 128; c.dst = WA + A_GATE; c.dstK = 128; c.ngran = 24; return true;
        case 4: c.src = p.in[17] + (size_t)i * 1024 * 512; c.ld = 512; c.ncols = 512; c.kvalid = 1024; c.dst = WA + A_MKV; c.dstK = 1024; c.ngran = 16; return true;
        case 5: c.src = p.in[18] + (size_t)i * 1024 * 1024; c.ld = 1024; c.ncols = 1024; c.kvalid = 1024; c.dst = WA + A_WOUT; c.dstK = 1024; c.ngran = 32; return true;
        }
        if (i == 0) return false;
        switch (idx) {
        case 6: c.src = p.in[23]; c.ld = 32; c.ncols = 32; c.kvalid = 1024; c.dst = WA + A_WIN + (size_t)2816 * 1024; c.dstK = 1024; c.ngran = 1; c.rscale = p.in[22]; c.rsmode = 1; return true;
        case 7: c.src = p.in[23]; c.ld = 32; c.ncols = 32; c.kvalid = 1024; c.dst = WA + A_WIN + (size_t)2848 * 1024; c.dstK = 1024; c.ngran = 1; c.rscale = p.in[22]; c.rsmode = 2; return true;
        case 8: c.src = p.in[23]; c.ld = 32; c.ncols = 0; c.kvalid = 1024; c.dst = WA + A_WIN + (size_t)2880 * 1024; c.dstK = 1024; c.ngran = 2; return true;
        case 9: c.src = p.in[24]; c.ld = 768; c.ncols = 768; c.kvalid = 32; c.dst = WA + A_VUP; c.dstK = 64; c.ngran = 24; return true;
        }
        return false;
    }
    const int j = L - 2;
    switch (idx) {
    case 0: c.src = p.in[31] + (size_t)j * 1024 * 768; c.ld = 768; c.ncols = 768; c.kvalid = 1024; c.dst = WA + B_WIN; c.dstK = 1024; c.ngran = 24; return true;
    case 1: c.src = p.in[33] + (size_t)j * 512 * 1152; c.ld = 1152; c.ncols = 1152; c.kvalid = 512; c.dst = WA + B_QUP; c.dstK = 512; c.ngran = 36; return true;
    case 2: c.src = p.in[34] + (size_t)j * 1024 * 512; c.ld = 512; c.ncols = 512; c.kvalid = 1024; c.dst = WA + B_MKV; c.dstK = 1024; c.ngran = 16; return true;
    case 3: c.src = p.in[35] + (size_t)j * 1024 * 1024; c.ld = 1024; c.ncols = 1024; c.kvalid = 1024; c.dst = WA + B_WOUT; c.dstK = 1024; c.ngran = 32; return true;
    }
    if (j != 0) return false;
    if (idx == 4) { c.src = p.in[27]; c.ld = 288; c.ncols = 288; c.kvalid = 1024; c.dst = WA + B_KVD; c.dstK = 1024; c.ngran = 12; return true; }
    if (idx == 5) { c.src = p.in[29]; c.ld = 1536; c.ncols = 1536; c.kvalid = 256; c.dst = WA + B_KVU; c.dstK = 256; c.ngran = 48; return true; }
    return false;
}

enum { E_BF16 = 0, E_F32, E_RESID, E_SWIGLU, E_DECAY, E_SIGB, E_KV, E_MEMKV, E_MULG };
struct Epi { void* o0; void* o1; const float* bias; const float* resid; int ldc; bf16_t* halo; };
struct GemmJob { const bf16_t* A; int lda; const bf16_t* W; int K, M, N, kind; Epi e; };

template <int E, int MI> __device__ __forceinline__ void epilogue(const f32x16 (&acc)[MI][2], int m0, int n0, int wm, int wn, int lane, const Epi& e) {
    const int half = lane >> 5, l31 = lane & 31;
    if (E == E_SWIGLU) {
        bf16_t* o = (bf16_t*)e.o0; const int col = (n0 >> 1) + wn * 32 + l31;
#pragma unroll
        for (int mi = 0; mi < MI; ++mi) {
            int rb_ = m0 + wm * (MI * 32) + mi * 32 + 4 * half;
            asm volatile("" : "+v"(rb_));
#pragma unroll
            for (int i = 0; i < 16; ++i) {
                const int row = rb_ + 8 * (i >> 2) + (i & 3);
                const float g = acc[mi][0][i], u = acc[mi][1][i];
                o[(size_t)row * 2816 + col] = f2bf(g * sigmoidf_(g) * u);
            }
        }
        return;
    }
#pragma unroll
    for (int mi = 0; mi < MI; ++mi)
#pragma unroll
        for (int ni = 0; ni < 2; ++ni) {
            const int col = n0 + wn * 64 + ni * 32 + l31;
            int rbase = m0 + wm * (MI * 32) + mi * 32 + 4 * half;
            asm volatile("" : "+v"(rbase));
            if (E == E_KV || E == E_MEMKV) {
                const bool isv = (E == E_KV) ? ((col & 127) >= 64) : (col >= 256);
                if (isv) {
#pragma unroll
                    for (int g = 0; g < 4; ++g) {
                        const int row = rbase + 8 * g;
                        uint2 w; w.x = pk2(acc[mi][ni][4 * g], acc[mi][ni][4 * g + 1]); w.y = pk2(acc[mi][ni][4 * g + 2], acc[mi][ni][4 * g + 3]);
                        size_t idx;
                        if (E == E_KV) { const int b = row >> 13, s = row & 8191, head = col >> 7, d = (col & 127) - 64; idx = ((size_t)(b * 12 + head) * 64 + d) * 8192 + s; }
                        else { const int b = row >> 8, mi_ = row & 255, head = (col - 256) >> 6, d = col & 63; idx = ((size_t)(b * 4 + head) * 64 + d) * 256 + mi_; }
                        *(uint2*)((bf16_t*)e.o1 + idx) = w;
                    }
                } else {
#pragma unroll
                    for (int i = 0; i < 16; ++i) {
                        const int row = rbase + 8 * (i >> 2) + (i & 3);
                        size_t idx;
                        if (E == E_KV) { const int b = row >> 13, s = row & 8191, head = col >> 7, c = col & 127; idx = ((size_t)(b * 12 + head) * 8192 + s) * 96 + c; }
                        else { const int b = row >> 8, mi_ = row & 255, head = col >> 6, d = col & 63; idx = ((size_t)(b * 4 + head) * 256 + mi_) * 64 + d; }
                        ((bf16_t*)e.o0)[idx] = f2bf(acc[mi][ni][i]);
                    }
                }
                continue;
            }
            float bias = 0.f;
            if (E == E_DECAY || E == E_SIGB) bias = e.bias[col];
#pragma unroll
            for (int i = 0; i < 16; ++i) {
                const int row = rbase + 8 * (i >> 2) + (i & 3);
                const float v = acc[mi][ni][i];
                const size_t idx = (size_t)row * e.ldc + col;
                if (E == E_BF16) {
                    const bf16_t b = f2bf(v);
                    ((bf16_t*)e.o0)[idx] = b;
                    if (e.halo && (row & 127) == 127) e.halo[(size_t)(row >> 7) * e.ldc + col] = b;
                } else if (E == E_F32) ((float*)e.o0)[idx] = v;
                else if (E == E_RESID) ((float*)e.o0)[idx] = e.resid[idx] + v;
                else if (E == E_DECAY) ((_Float16*)e.o0)[idx] = (_Float16)(0.60653066f * sigmoidf_(bias + v));
                else if (E == E_SIGB) ((bf16_t*)e.o0)[idx] = f2bf(sigmoidf_(bias + v));
                else if (E == E_MULG) { bf16_t* o = (bf16_t*)e.o0; o[idx] = f2bf(bf2f(o[idx]) * v); }
            }
        }
}

__device__ void gemm_job(const GemmJob& gj, int& rot, char* smem) {
#ifdef NO_GEMM
    return;
#endif
    const bf16_t* A = gj.A; const bf16_t* W = gj.W; const int lda = gj.lda, K = gj.K, M = gj.M, N = gj.N; const Epi& e = gj.e;
    const int tid = opaque_tid(), lane = tid & 63, wave = tid >> 6, wm = wave >> 2, wn = wave & 3;
    const int ntn = (N + 255) >> 8, ntm = M >> 8, KT = K >> 6, G = gridDim.x;
    bf16_t* sA = (bf16_t*)smem;
    bf16_t* sB = sA + 2 * 256 * 72;
    const int half = lane >> 5, l31 = lane & 31;
    const int bp = (blockIdx.x + G - rot) % G;
    const bool xmap = (ntm & 7) == 0;
    const int xcd = bp & 7, li = bp >> 3, GL = G >> 3, mpx = ntm >> 3, mgsz = mpx < 8 ? (mpx > 0 ? mpx : 1) : 8, gsz = mgsz * ntn;
    const int tcount = xmap ? mpx * ntn : ntm * ntn, tstart = xmap ? li : bp, tstep = xmap ? GL : G;
    for (int idx = tstart; idx < tcount; idx += tstep) {
        int tm, tn;
        if (xmap) { const int grp = idx / gsz, rem = idx - grp * gsz; tn = rem / mgsz; tm = xcd * mpx + grp * mgsz + (rem - tn * mgsz); }
        else { tm = idx / ntn; tn = idx - tm * ntn; }
        const int m0 = tm << 8, n0 = tn << 8;
        const bool wact = (n0 + wn * 64) < N;
        f32x16 acc[4][2];
#pragma unroll
        for (int a = 0; a < 4; ++a)
#pragma unroll
            for (int b = 0; b < 2; ++b)
#pragma unroll
                for (int i = 0; i < 16; ++i) acc[a][b][i] = 0.f;
        u32x4 ra[4], rb[4];
        const char* Ab = (const char*)(A + (size_t)m0 * lda);
        const char* Wb = (const char*)(W + (size_t)n0 * K);
        const unsigned aoff = (unsigned)(((tid >> 3) * lda + (tid & 7) * 8) * 2), woff = (unsigned)(((tid >> 3) * K + (tid & 7) * 8) * 2);
#define GLOAD_TILE(KT_) { _Pragma("unroll") for (int i = 0; i < 4; ++i) { \
            ra[i] = *(const u32x4*)(Ab + ((size_t)(64 * i) * lda + (size_t)(KT_) * 64) * 2 + aoff); \
            rb[i] = *(const u32x4*)(Wb + ((size_t)(64 * i) * K + (size_t)(KT_) * 64) * 2 + woff); } }
        GLOAD_TILE(0)
        const int lofs = (tid >> 3) * 72 + (tid & 7) * 8;
#pragma unroll
        for (int i = 0; i < 4; ++i) { *(u32x4*)(sA + lofs + 64 * i * 72) = ra[i]; *(u32x4*)(sB + lofs + 64 * i * 72) = rb[i]; }
        if (KT > 1) GLOAD_TILE(1)
        __syncthreads();
        for (int kt = 0; kt < KT; ++kt) {
            const int buf = kt & 1;
            if (kt + 1 < KT) {
                bf16_t* da = sA + (buf ^ 1) * 256 * 72 + lofs; bf16_t* db = sB + (buf ^ 1) * 256 * 72 + lofs;
#pragma unroll
                for (int i = 0; i < 4; ++i) { *(u32x4*)(da + 64 * i * 72) = ra[i]; *(u32x4*)(db + 64 * i * 72) = rb[i]; }
            }
            if (kt + 2 < KT) GLOAD_TILE(kt + 2)
            if (wact) {
                const bf16_t* a_ = sA + buf * 256 * 72 + (wm * 128 + l31) * 72 + half * 8;
                const bf16_t* b_ = sB + buf * 256 * 72 + (wn * 64 + l31) * 72 + half * 8;
#define LDF(P_, O_) (*(const bf16x8*)((P_) + (O_)))
#define MM(I_, J_, AF, BF) acc[I_][J_] = __builtin_amdgcn_mfma_f32_32x32x16_bf16(AF, BF, acc[I_][J_], 0, 0, 0);
                bf16x8 b0 = LDF(b_, 0), b1 = LDF(b_, 32 * 72), a0 = LDF(a_, 0), a1 = LDF(a_, 32 * 72), a2, a3;
#pragma unroll
                for (int kk = 0; kk < 4; ++kk) {
                    a2 = LDF(a_, 64 * 72 + kk * 16); a3 = LDF(a_, 96 * 72 + kk * 16);
                    __builtin_amdgcn_sched_barrier(0);
                    MM(0, 0, a0, b0) MM(0, 1, a0, b1) MM(1, 0, a1, b0) MM(1, 1, a1, b1)
                    __builtin_amdgcn_sched_barrier(0);
                    if (kk < 3) { a0 = LDF(a_, (kk + 1) * 16); a1 = LDF(a_, 32 * 72 + (kk + 1) * 16); }
                    bf16x8 c0 = b0, c1 = b1;
                    if (kk < 3) { b0 = LDF(b_, (kk + 1) * 16); b1 = LDF(b_, 32 * 72 + (kk + 1) * 16); }
                    __builtin_amdgcn_sched_barrier(0);
                    MM(2, 0, a2, c0) MM(2, 1, a2, c1) MM(3, 0, a3, c0) MM(3, 1, a3, c1)
                    __builtin_amdgcn_sched_barrier(0);
                }
#undef LDF
#undef MM
            }
            __syncthreads();
        }
#undef GLOAD_TILE
        if (wact) {
            switch (gj.kind) {
            case E_BF16: epilogue<E_BF16, 4>(acc, m0, n0, wm, wn, lane, e); break;
            case E_F32: epilogue<E_F32, 4>(acc, m0, n0, wm, wn, lane, e); break;
            case E_RESID: epilogue<E_RESID, 4>(acc, m0, n0, wm, wn, lane, e); break;
            case E_SWIGLU: epilogue<E_SWIGLU, 4>(acc, m0, n0, wm, wn, lane, e); break;
            case E_DECAY: epilogue<E_DECAY, 4>(acc, m0, n0, wm, wn, lane, e); break;
            case E_SIGB: epilogue<E_SIGB, 4>(acc, m0, n0, wm, wn, lane, e); break;
            case E_KV: epilogue<E_KV, 4>(acc, m0, n0, wm, wn, lane, e); break;
            case E_MEMKV: epilogue<E_MEMKV, 4>(acc, m0, n0, wm, wn, lane, e); break;
            default: epilogue<E_MULG, 4>(acc, m0, n0, wm, wn, lane, e); break;
            }
        }
    }
    rot = (rot + (xmap ? 8 * (tcount % GL) : tcount) ) % G;
}

template <int DQK, bool CAUSAL>
__device__ void attn_phase(const bf16_t* Q, int ldq, int qcol0, const bf16_t* Kb, size_t k_bh_stride, const bf16_t* VT, size_t vt_bh_stride, int vt_ld,
                           int nheads, int nkeys, const float* rope, float scl, bf16_t* O, int ldo, int ocol0, int& rot, char* smem, int vb, int G) {
#ifdef NO_ATTN
    return;
#endif

    constexpr int KS = DQK + 8, NKK = DQK / 16, KCH = DQK / 8, NCH = 64 * KCH, NKL = (NCH + NT - 1) / NT;
    const int tid = opaque_tid(), lane = tid & 63, wave = tid >> 6, half = lane >> 5, l31 = lane & 31;
    const int xaddr = (lane ^ 32) << 2;
    bf16_t* sK = (bf16_t*)smem;
    bf16_t* sV = sK + 2 * 64 * KS;
    const int nbh = 4 * nheads, upx = (nbh >> 3) * 32;
    const int bp = (vb + G - rot) % G, xcd = bp & 7, li = bp >> 3, GL = G >> 3;
    for (int idx = li; idx < upx; idx += GL) {
        const int hr = idx >> 5, qi = idx & 31, qb = (hr & 1) ? 31 - qi : qi, bh = xcd + 8 * hr, b = bh / nheads, h = bh - b * nheads;
        const int q0 = qb * 256 + wave * 32, q = q0 + l31;
        const size_t tokq = (size_t)b * S + q;
        bf16x8 qf[NKK];
        { const bf16_t* qp = Q + tokq * ldq + qcol0 + h * DQK + half * 8;
#pragma unroll
          for (int kk = 0; kk < NKK; ++kk) qf[kk] = *(const bf16x8*)(qp + kk * 16); }
        if (rope) {
            const float* rp = rope + tokq * 32 + half * 8;
            const float4 c0 = *(const float4*)rp, c1 = *(const float4*)(rp + 4), s0 = *(const float4*)(rp + 16), s1 = *(const float4*)(rp + 20);
            u32x4 qa = __builtin_bit_cast(u32x4, qf[NKK - 2]), qb_ = __builtin_bit_cast(u32x4, qf[NKK - 1]);
#define ROT2(D, CA, SA, CB, SB) { const float x1l = bflo(qa[D]), x1h = bfhi(qa[D]), x2l = bflo(qb_[D]), x2h = bfhi(qb_[D]); \
              qa[D] = pk2(x1l * CA - x2l * SA, x1h * CB - x2h * SB); qb_[D] = pk2(x2l * CA + x1l * SA, x2h * CB + x1h * SB); }
            ROT2(0, c0.x, s0.x, c0.y, s0.y) ROT2(1, c0.z, s0.z, c0.w, s0.w) ROT2(2, c1.x, s1.x, c1.y, s1.y) ROT2(3, c1.z, s1.z, c1.w, s1.w)
#undef ROT2
            qf[NKK - 2] = __builtin_bit_cast(bf16x8, qa); qf[NKK - 1] = __builtin_bit_cast(bf16x8, qb_);
        }
        const int ntiles = CAUSAL ? (qb * 4 + 4) : (nkeys >> 6);
        f32x16 o[2];
#pragma unroll
        for (int a = 0; a < 2; ++a)
#pragma unroll
            for (int i = 0; i < 16; ++i) o[a][i] = 0.f;
        float m = -1e30f, l = 0.f;
        const bf16_t* Kg = Kb + (size_t)bh * k_bh_stride;
        const bf16_t* Vg = VT + (size_t)bh * vt_bh_stride + (size_t)(tid >> 3) * vt_ld + (tid & 7) * 8;
        u32x4 rk[NKL], rv[1];
#pragma unroll
        for (int i = 0; i < NKL; ++i) { const int c = tid + NT * i; if (c < NCH) rk[i] = *(const u32x4*)(Kg + (size_t)c * 8); }
        rv[0] = *(const u32x4*)(Vg);
#pragma unroll
        for (int i = 0; i < NKL; ++i) { const int c = tid + NT * i; if (c < NCH) *(u32x4*)(sK + (c / KCH) * KS + (c % KCH) * 8) = rk[i]; }
        *(u32x4*)(sV + (tid >> 3) * 72 + (tid & 7) * 8) = rv[0];
        __syncthreads();
        for (int kt = 0; kt < ntiles; ++kt) {
            const int buf = kt & 1;
            if (kt + 1 < ntiles) {
#pragma unroll
                for (int i = 0; i < NKL; ++i) { const int c = tid + NT * i; if (c < NCH) rk[i] = *(const u32x4*)(Kg + (size_t)(kt + 1) * 64 * DQK + (size_t)c * 8); }
                rv[0] = *(const u32x4*)(Vg + (kt + 1) * 64);
            }
            if (!CAUSAL || kt * 64 <= q0 + 31) {
                const bf16_t* kb_ = sK + buf * 64 * KS + l31 * KS + half * 8;
                const bf16_t* vb_ = sV + buf * 64 * 72 + l31 * 72 + 4 * half;
                f32x16 s[2];
                bf16x8 kf0[NKK], kf1[NKK];
                __builtin_amdgcn_sched_barrier(0);
#pragma unroll
                for (int kk = 0; kk < NKK; ++kk) kf0[kk] = *(const bf16x8*)(kb_ + kk * 16);
#pragma unroll
                for (int kk = 0; kk < NKK; ++kk) kf1[kk] = *(const bf16x8*)(kb_ + 32 * KS + kk * 16);
                __builtin_amdgcn_sched_barrier(0);
#pragma unroll
                for (int i = 0; i < 16; ++i) { s[0][i] = 0.f; s[1][i] = 0.f; }
#pragma unroll
                for (int kk = 0; kk < NKK; ++kk) s[0] = __builtin_amdgcn_mfma_f32_32x32x16_bf16(kf0[kk], qf[kk], s[0], 0, 0, 0);
#pragma unroll
                for (int kk = 0; kk < NKK; ++kk) s[1] = __builtin_amdgcn_mfma_f32_32x32x16_bf16(kf1[kk], qf[kk], s[1], 0, 0, 0);
                uint2 vfr[2][2][2][2];
#pragma unroll
                for (int kb = 0; kb < 2; ++kb)
#pragma unroll
                    for (int g = 0; g < 2; ++g)
#pragma unroll
                        for (int db = 0; db < 2; ++db) {
                            const bf16_t* vp = vb_ + db * 32 * 72 + kb * 32 + 16 * g;
                            vfr[kb][g][db][0] = *(const uint2*)vp; vfr[kb][g][db][1] = *(const uint2*)(vp + 8);
                        }
                __builtin_amdgcn_sched_barrier(0);
                if (CAUSAL && kt * 64 + 63 > q0) {
#pragma unroll
                    for (int kb = 0; kb < 2; ++kb)
#pragma unroll
                        for (int i = 0; i < 16; ++i) { const int key = kt * 64 + kb * 32 + 8 * (i >> 2) + 4 * half + (i & 3); if (key > q) s[kb][i] = -1e30f; }
                }
                float mx = s[0][0];
#pragma unroll
                for (int kb = 0; kb < 2; ++kb)
#pragma unroll
                    for (int i = 0; i < 16; ++i) mx = fmaxf(mx, s[kb][i]);
                mx = fmaxf(mx, __int_as_float(__builtin_amdgcn_ds_bpermute(xaddr, __float_as_int(mx))));
                const float mn = fmaxf(m, mx), alpha = __builtin_amdgcn_exp2f((m - mn) * scl), mc = mn * scl;
                m = mn;
                f32x2 ls2 = {0.f, 0.f};
                const f32x2 scl2 = {scl, scl}, nmc2 = {-mc, -mc};
#pragma unroll
                for (int kb = 0; kb < 2; ++kb)
#pragma unroll
                    for (int i = 0; i < 16; i += 2) {
                        const f32x2 t = __builtin_elementwise_fma((f32x2){s[kb][i], s[kb][i + 1]}, scl2, nmc2);
                        const f32x2 pv = {__builtin_amdgcn_exp2f(t[0]), __builtin_amdgcn_exp2f(t[1])};
                        s[kb][i] = pv[0]; s[kb][i + 1] = pv[1]; ls2 += pv;
                    }
                const float ls = ls2[0] + ls2[1];
                l = l * alpha + ls;
#pragma unroll
                for (int a = 0; a < 2; ++a)
#pragma unroll
                    for (int i = 0; i < 16; ++i) o[a][i] *= alpha;
#pragma unroll
                for (int kb = 0; kb < 2; ++kb)
#pragma unroll
                    for (int g = 0; g < 2; ++g) {
                        u32x4 pu;
#pragma unroll
                        for (int j = 0; j < 4; ++j) pu[j] = pk2(s[kb][8 * g + 2 * j], s[kb][8 * g + 2 * j + 1]);
                        const bf16x8 pf = __builtin_bit_cast(bf16x8, pu);
#pragma unroll
                        for (int db = 0; db < 2; ++db) {
                            u32x4 vu; vu[0] = vfr[kb][g][db][0].x; vu[1] = vfr[kb][g][db][0].y; vu[2] = vfr[kb][g][db][1].x; vu[3] = vfr[kb][g][db][1].y;
                            o[db] = __builtin_amdgcn_mfma_f32_32x32x16_bf16(__builtin_bit_cast(bf16x8, vu), pf, o[db], 0, 0, 0);
                        }
                    }
            }
            if (kt + 1 < ntiles) {
                bf16_t* dk = sK + (buf ^ 1) * 64 * KS; bf16_t* dv = sV + (buf ^ 1) * 64 * 72;
#pragma unroll
                for (int i = 0; i < NKL; ++i) { const int c = tid + NT * i; if (c < NCH) *(u32x4*)(dk + (c / KCH) * KS + (c % KCH) * 8) = rk[i]; }
                *(u32x4*)(dv + (tid >> 3) * 72 + (tid & 7) * 8) = rv[0];
            }
            __syncthreads();
        }
        l += __int_as_float(__builtin_amdgcn_ds_bpermute(xaddr, __float_as_int(l)));
        const float inv = 1.f / l;
        bf16_t* op = O + tokq * ldo + ocol0 + h * 64 + 4 * half;
#pragma unroll
        for (int db = 0; db < 2; ++db)
#pragma unroll
            for (int g = 0; g < 4; ++g) {
                uint2 w; w.x = pk2(o[db][4 * g] * inv, o[db][4 * g + 1] * inv); w.y = pk2(o[db][4 * g + 2] * inv, o[db][4 * g + 3] * inv);
                *(uint2*)(op + db * 32 + 8 * g) = w;
            }
    }
    rot = (rot + 8 * (upx % GL)) % G;
}

__device__ void lora_in_phase(const Params& p, int layer) {
#ifdef NO_LIN
    return;
#endif

    const bf16_t* P = (const bf16_t*)(p.ws + WS_P); bf16_t* LIN = (bf16_t*)(p.ws + WS_LIN);
    const float* mu = p.in[6] + (size_t)layer * 2560 + 2304;
    const int tid_ = opaque_tid(), lane = tid_ & 63, gw = blockIdx.x * NWV + (tid_ >> 6), nw = gridDim.x * NWV;
    const float4 m4 = *(const float4*)(mu + lane * 4);
    for (int tok = gw; tok < T; tok += nw) {
        const int s = tok & (S - 1);
        const uint2 c = *(const uint2*)(P + (size_t)tok * LDP + 2304 + lane * 4);
        uint2 pv; pv.x = 0; pv.y = 0;
        if (s) pv = *(const uint2*)(P + (size_t)(tok - 1) * LDP + 2304 + lane * 4);
        float v0 = bflo(c.x), v1 = bfhi(c.x), v2 = bflo(c.y), v3 = bfhi(c.y);
        v0 += (bflo(pv.x) - v0) * m4.x; v1 += (bfhi(pv.x) - v1) * m4.y; v2 += (bflo(pv.y) - v2) * m4.z; v3 += (bfhi(pv.y) - v3) * m4.w;
        if (lane < 16) { v0 = tanhf(v0); v1 = tanhf(v1); v2 = tanhf(v2); v3 = tanhf(v3); }
        else if (lane >= 32) { v0 = sigmoidf_(v0); v1 = sigmoidf_(v1); v2 = sigmoidf_(v2); v3 = sigmoidf_(v3); }
        uint2 w; w.x = pk2(v0, v1); w.y = pk2(v2, v3);
        *(uint2*)(LIN + (size_t)tok * 320 + lane * 4) = w;
        if (layer == 1) {
            float vd = 0.f;
            if (lane < 32) { vd = bf2f(P[(size_t)tok * LDP + 2816 + lane]); if (s) vd += bf2f(P[(size_t)(tok - 1) * LDP + 2848 + lane]); }
            LIN[(size_t)tok * 320 + 256 + lane] = f2bf(vd);
        }
    }
}

__device__ void prep_phase(const Params& p, int layer) {
#ifdef NO_PREP
    return;
#endif

    bf16_t* P = (bf16_t*)(p.ws + WS_P);
    bf16_t* Z2 = (bf16_t*)(p.ws + WS_Z + ZSZ);
    bf16_t* Z3 = (bf16_t*)(p.ws + WS_Z + 2 * ZSZ);
    bf16_t* Z4 = (bf16_t*)(p.ws + WS_Z + 3 * ZSZ);
    const bf16_t* HALO = (const bf16_t*)(p.ws + WS_HALO);
    float* RK = (float*)(p.ws + WS_RK);
    const float* mu = p.in[6] + (size_t)layer * 2560;
    const float* kkw = p.in[12] + (size_t)layer * 768; const float* kaw = p.in[13] + (size_t)layer * 768; const float* rkw = p.in[14] + (size_t)layer * 768;
    const int tid = opaque_tid(), tokl = tid >> 4, cg4 = (tid & 15) * 4;
    for (int u = blockIdx.x; u < 256 * 12; u += gridDim.x) {
        const int mt = u / 12, h = u - mt * 12, m0 = mt * 128, hc = h * 64 + cg4;
        const float4 mur = *(const float4*)(mu + hc), muk = *(const float4*)(mu + 768 + hc), muv = *(const float4*)(mu + 1536 + hc);
        const float4 kkw4 = *(const float4*)(kkw + hc), kaw4 = *(const float4*)(kaw + hc), rkw4 = *(const float4*)(rkw + hc);
        for (int it = 3; it >= 0; --it) {
            const int tok = m0 + it * 32 + tokl, s = tok & (S - 1);
            bf16_t* pr = P + (size_t)tok * LDP + hc;
            const uint2 cr = *(const uint2*)pr, ck = *(const uint2*)(pr + 768), cv = *(const uint2*)(pr + 1536);
            uint2 qr, qk, qv; qr.x = qr.y = qk.x = qk.y = qv.x = qv.y = 0;
            if (s) {
                const bf16_t* pp = (it == 0 && tokl == 0) ? (HALO + (size_t)(mt - 1) * LDP + hc) : (P + (size_t)(tok - 1) * LDP + hc);
                qr = *(const uint2*)pp; qk = *(const uint2*)(pp + 768); qv = *(const uint2*)(pp + 1536);
            }
            const size_t zi = (size_t)tok * 768 + hc;
            const uint2 lr2 = *(const uint2*)(Z2 + zi);
            uint2 vs2, vf2; vs2.x = vs2.y = vf2.x = vf2.y = 0;
            if (layer == 1) { vs2 = *(const uint2*)(Z3 + zi); vf2 = *(const uint2*)(Z4 + zi); }
            __syncthreads();
            float r[4] = {bflo(cr.x), bfhi(cr.x), bflo(cr.y), bfhi(cr.y)}, k[4] = {bflo(ck.x), bfhi(ck.x), bflo(ck.y), bfhi(ck.y)}, v[4] = {bflo(cv.x), bfhi(cv.x), bflo(cv.y), bfhi(cv.y)};
            const float rp[4] = {bflo(qr.x), bfhi(qr.x), bflo(qr.y), bfhi(qr.y)}, kp[4] = {bflo(qk.x), bfhi(qk.x), bflo(qk.y), bfhi(qk.y)}, vp[4] = {bflo(qv.x), bfhi(qv.x), bflo(qv.y), bfhi(qv.y)};
            const float mr[4] = {mur.x, mur.y, mur.z, mur.w}, mk[4] = {muk.x, muk.y, muk.z, muk.w}, mv[4] = {muv.x, muv.y, muv.z, muv.w};
            const float lr[4] = {bflo(lr2.x), bfhi(lr2.x), bflo(lr2.y), bfhi(lr2.y)};
            const float vs[4] = {bflo(vs2.x), bfhi(vs2.x), bflo(vs2.y), bfhi(vs2.y)}, vf[4] = {bflo(vf2.x), bfhi(vf2.x), bflo(vf2.y), bfhi(vf2.y)};
            const float kkw_[4] = {kkw4.x, kkw4.y, kkw4.z, kkw4.w}, kaw_[4] = {kaw4.x, kaw4.y, kaw4.z, kaw4.w}, rkw_[4] = {rkw4.x, rkw4.y, rkw4.z, rkw4.w};
            float kk[4], n2 = 0.f, rks = 0.f, bb[4];
#pragma unroll
            for (int j = 0; j < 4; ++j) {
                r[j] += (rp[j] - r[j]) * mr[j]; k[j] += (kp[j] - k[j]) * mk[j]; v[j] += (vp[j] - v[j]) * mv[j];
                if (layer == 1) v[j] += (vf[j] - v[j]) * vs[j];
                kk[j] = k[j] * kkw_[j]; n2 += kk[j] * kk[j];
                k[j] = k[j] * (1.f + (lr[j] - 1.f) * kaw_[j]);
                rks += r[j] * k[j] * rkw_[j];
            }
            n2 = reduce16(n2); rks = reduce16(rks);
            const float inv = 1.f / fmaxf(sqrtf(n2), 1e-12f);
#pragma unroll
            for (int j = 0; j < 4; ++j) { kk[j] *= inv; bb[j] = kk[j] * lr[j]; }
            uint2 w;
            w.x = pk2(r[0], r[1]); w.y = pk2(r[2], r[3]); *(uint2*)pr = w;
            w.x = pk2(k[0], k[1]); w.y = pk2(k[2], k[3]); *(uint2*)(pr + 768) = w;
            w.x = pk2(v[0], v[1]); w.y = pk2(v[2], v[3]); *(uint2*)(pr + 1536) = w;
            if (layer == 0) *(uint2*)(Z4 + zi) = w;
            w.x = pk2(bb[0], bb[1]); w.y = pk2(bb[2], bb[3]); *(uint2*)(Z2 + zi) = w;
            w.x = pk2(kk[0], kk[1]); w.y = pk2(kk[2], kk[3]); *(uint2*)(Z3 + zi) = w;
            if ((tid & 15) == 0) RK[(size_t)tok * 12 + h] = rks;
        }
        __syncthreads();
    }
}

__device__ void scan_phase(const Params& p, char* smem) {
#ifdef NO_SCAN
    return;
#endif
    const bf16_t* P = (const bf16_t*)(p.ws + WS_P);
    const _Float16* E = (const _Float16*)(p.ws + WS_Z);
    const bf16_t* Bv = (const bf16_t*)(p.ws + WS_Z + ZSZ);
    const bf16_t* KK = (const bf16_t*)(p.ws + WS_Z + 2 * ZSZ);
    bf16_t* Y = (bf16_t*)(p.ws + WS_H);
    constexpr int BUFF = 11264;
    float* sBase = (float*)smem; float* sYp = sBase + 2 * BUFF;
    const int tid = opaque_tid(), lane = tid & 63, wave = tid >> 6;
    const bool comp = wave < 4;
    const int row = (wave & 3) * 4 + (lane >> 4), kg = lane & 15;
    const int stid = tid & 255, st_l = stid >> 3, c8 = (stid & 7) * 8;
    for (int u = blockIdx.x; u < 192; u += gridDim.x) {
        const int b = u / 48, h = (u % 48) >> 2, qt = u & 3;
        const size_t tok0 = (size_t)b * S;
        f32x2 S01 = {0.f, 0.f}, S23 = {0.f, 0.f};
        u32x4 gr, gk, ga, gb, gv = {0u, 0u, 0u, 0u}; h8 ge;
        auto gload = [&](int ch) {
            const size_t tok = tok0 + ch * 32 + st_l;
            gr = *(const u32x4*)(P + tok * LDP + h * 64 + c8);
            gk = *(const u32x4*)(P + tok * LDP + 768 + h * 64 + c8);
            ga = *(const u32x4*)(KK + tok * 768 + h * 64 + c8);
            gb = *(const u32x4*)(Bv + tok * 768 + h * 64 + c8);
            ge = *(const h8*)(E + tok * 768 + h * 64 + c8);
            if (stid < 64) { const size_t tk = tok0 + ch * 32 + (stid >> 1); gv = *(const u32x4*)(P + tk * LDP + 1536 + h * 64 + qt * 16 + (stid & 1) * 8); }
        };
        auto st4 = [&](float* dst, const u32x4& g) {
            f32x4 a, c; a[0] = bflo(g[0]); a[1] = bfhi(g[0]); a[2] = bflo(g[1]); a[3] = bfhi(g[1]); c[0] = bflo(g[2]); c[1] = bfhi(g[2]); c[2] = bflo(g[3]); c[3] = bfhi(g[3]);
            *(f32x4*)dst = a; *(f32x4*)(dst + 4) = c;
        };
        auto stage = [&](float* buf) {
            const int o = st_l * 64 + c8;
            st4(buf + 8192 + o, gr); st4(buf + 2048 + o, gk); st4(buf + 4096 + o, ga); st4(buf + 6144 + o, gb);
            f32x4 a, c; a[0] = __expf(-(float)ge[0]); a[1] = __expf(-(float)ge[1]); a[2] = __expf(-(float)ge[2]); a[3] = __expf(-(float)ge[3]);
            c[0] = __expf(-(float)ge[4]); c[1] = __expf(-(float)ge[5]); c[2] = __expf(-(float)ge[6]); c[3] = __expf(-(float)ge[7]);
            *(f32x4*)(buf + o) = a; *(f32x4*)(buf + o + 4) = c;
            if (stid < 64) st4(buf + 10240 + (stid >> 1) * 16 + (stid & 1) * 8, gv);
        };
        auto flush = [&](const float* buf, int ch) {
            if (stid < 64) {
                const float* yp = buf + 10752 + (stid >> 1) * 16 + (stid & 1) * 8;
                const f32x4 a = *(const f32x4*)yp, c = *(const f32x4*)(yp + 4);
                u32x4 w; w[0] = pk2(a[0], a[1]); w[1] = pk2(a[2], a[3]); w[2] = pk2(c[0], c[1]); w[3] = pk2(c[2], c[3]);
                *(u32x4*)(Y + (tok0 + ch * 32 + (stid >> 1)) * 1024 + h * 64 + qt * 16 + (stid & 1) * 8) = w;
            }
        };
        if (!comp) { gload(0); stage(sBase); gload(1); }
        __syncthreads();
        for (int ch = 0; ch < 256; ++ch) {
            float* bufc = sBase + (ch & 1) * BUFF; float* bufo = sBase + ((ch & 1) ^ 1) * BUFF;
            if (comp) {
                float* sY = bufc + 10752;
                unsigned a_cur = (unsigned)(size_t)(LAS char*)(bufc + kg * 4), v_cur = (unsigned)(size_t)(LAS char*)(bufc + 10240 + row);
                f32x4 w0, k0, a0, b0, r0, w1, k1, a1, b1, r1, w2, k2, a2, b2, r2, w3, k3, a3, b3, r3; float v0, v1, v2, v3;
#define SCAN_LOAD(W, K, A, B, R, V, AD, VD) asm volatile("ds_read_b128 %0, %6\n\tds_read_b128 %1, %6 offset:8192\n\tds_read_b128 %2, %6 offset:16384\n\tds_read_b128 %3, %6 offset:24576\n\tds_read_b128 %4, %6 offset:32768\n\tds_read_b32 %5, %7" \
                    : "=&v"(W), "=&v"(K), "=&v"(A), "=&v"(B), "=&v"(R), "=&v"(V) : "v"(AD), "v"(VD) : "memory")
#define SCAN_WAIT(W, K, A, B, R, V, DEP) asm volatile("s_waitcnt lgkmcnt(6)" : "+v"(W), "+v"(K), "+v"(A), "+v"(B), "+v"(R), "+v"(V), "+v"(DEP) :: "memory")
#define SCAN_WAIT0(W, K, A, B, R, V, DEP) asm volatile("s_waitcnt lgkmcnt(0)" : "+v"(W), "+v"(K), "+v"(A), "+v"(B), "+v"(R), "+v"(V), "+v"(DEP) :: "memory")
#define SCAN_STEP(W, K, A, B, R, V, YV) { \
                    f32x2 t = S01 * (f32x2){A[0], A[1]}; t = __builtin_elementwise_fma(S23, (f32x2){A[2], A[3]}, t); \
                    const float d = reduce16(t[0] + t[1]); const f32x2 sa2 = {-d, -d}, v2_ = {V, V}; \
                    const f32x2 u01 = __builtin_elementwise_fma(sa2, (f32x2){B[0], B[1]}, v2_ * (f32x2){K[0], K[1]}); \
                    const f32x2 u23 = __builtin_elementwise_fma(sa2, (f32x2){B[2], B[3]}, v2_ * (f32x2){K[2], K[3]}); \
                    S01 = __builtin_elementwise_fma(S01, (f32x2){W[0], W[1]}, u01); S23 = __builtin_elementwise_fma(S23, (f32x2){W[2], W[3]}, u23); \
                    f32x2 y2 = S01 * (f32x2){R[0], R[1]}; y2 = __builtin_elementwise_fma(S23, (f32x2){R[2], R[3]}, y2); \
                    YV = y2[0] + y2[1]; }
                SCAN_LOAD(w0, k0, a0, b0, r0, v0, a_cur, v_cur);
                { const unsigned an = a_cur + 256, vn = v_cur + 64; SCAN_LOAD(w1, k1, a1, b1, r1, v1, an, vn); }
                float yv = 0.f;
                float* ypw = sYp + row * 16 + kg;
#pragma unroll 1
                for (int q = 0; q < 8; ++q) {
                    const int sb = (q & 3) * 4;
                    SCAN_WAIT(w0, k0, a0, b0, r0, v0, yv);
                    { const unsigned an = a_cur + 512, vn = v_cur + 128; SCAN_LOAD(w2, k2, a2, b2, r2, v2, an, vn); }
                    SCAN_STEP(w0, k0, a0, b0, r0, v0, yv)
                    ypw[sb * 256] = yv;
                    SCAN_WAIT(w1, k1, a1, b1, r1, v1, yv);
                    { const unsigned an = a_cur + 768, vn = v_cur + 192; SCAN_LOAD(w3, k3, a3, b3, r3, v3, an, vn); }
                    SCAN_STEP(w1, k1, a1, b1, r1, v1, yv)
                    ypw[(sb + 1) * 256] = yv;
                    SCAN_WAIT(w2, k2, a2, b2, r2, v2, yv);
                    a_cur += 1024; v_cur += 256;
                    SCAN_LOAD(w0, k0, a0, b0, r0, v0, a_cur, v_cur);
                    SCAN_STEP(w2, k2, a2, b2, r2, v2, yv)
                    ypw[(sb + 2) * 256] = yv;
                    SCAN_WAIT(w3, k3, a3, b3, r3, v3, yv);
                    { const unsigned an = a_cur + 256, vn = v_cur + 64; SCAN_LOAD(w1, k1, a1, b1, r1, v1, an, vn); }
                    SCAN_STEP(w3, k3, a3, b3, r3, v3, yv)
                    ypw[(sb + 3) * 256] = yv;
                    if ((q & 3) == 3) {
                        const int hh = q >> 2, stp = lane >> 2, rw_ = (wave & 3) * 4 + (lane & 3);
                        const f32x4* pp = (const f32x4*)(sYp + stp * 256 + rw_ * 16);
                        const f32x4 q0 = pp[0], q1 = pp[1], q2 = pp[2], q3 = pp[3];
                        const float ysum = ((q0[0] + q0[1]) + (q0[2] + q0[3])) + ((q1[0] + q1[1]) + (q1[2] + q1[3])) + ((q2[0] + q2[1]) + (q2[2] + q2[3])) + ((q3[0] + q3[1]) + (q3[2] + q3[3]));
                        sY[(hh * 16 + stp) * 16 + rw_] = ysum;
                    }
                }
                SCAN_WAIT0(w0, k0, a0, b0, r0, v0, yv);
                SCAN_WAIT0(w1, k1, a1, b1, r1, v1, yv);
#undef SCAN_WAIT0
#undef SCAN_LOAD
#undef SCAN_WAIT
#undef SCAN_STEP
            } else {
                if (ch > 0) flush(bufo, ch - 1);
                if (ch + 1 < 256) { stage(bufo); if (ch + 2 < 256) gload(ch + 2); }
            }
            __syncthreads();
        }
        if (!comp) flush(sBase + BUFF, 255);
        __syncthreads();
    }
}

__device__ void post_phase(const Params& p, int layer) {
#ifdef NO_POST
    return;
#endif

    bf16_t* H = (bf16_t*)(p.ws + WS_H); const bf16_t* P = (const bf16_t*)(p.ws + WS_P); const float* RK = (const float*)(p.ws + WS_RK);
    const float* lg = p.in[15] + (size_t)layer * 768; const float* lb = p.in[16] + (size_t)layer * 768;
    const int tid = opaque_tid(), cg4 = (tid & 15) * 4;
    const int npairs = T * 12;
    for (int pr = blockIdx.x * (NT / 16) + (tid >> 4); pr < npairs; pr += gridDim.x * (NT / 16)) {
        const int tok = pr / 12, h = pr - tok * 12, hc = h * 64 + cg4;
        bf16_t* yp = H + (size_t)tok * 1024 + hc;
        const uint2 y2 = *(const uint2*)yp, v2 = *(const uint2*)(P + (size_t)tok * LDP + 1536 + hc);
        const float y[4] = {bflo(y2.x), bfhi(y2.x), bflo(y2.y), bfhi(y2.y)}, v[4] = {bflo(v2.x), bfhi(v2.x), bflo(v2.y), bfhi(v2.y)};
        const float mean = reduce16((y[0] + y[1]) + (y[2] + y[3])) * (1.f / 64.f);
        float q = 0.f;
#pragma unroll
        for (int j = 0; j < 4; ++j) { const float d = y[j] - mean; q += d * d; }
        const float rstd = rsqrtf(reduce16(q) * (1.f / 64.f) + 64e-5f);
        const float rk = RK[(size_t)tok * 12 + h];
        const float4 g4 = *(const float4*)(lg + hc), b4 = *(const float4*)(lb + hc);
        const float g[4] = {g4.x, g4.y, g4.z, g4.w}, bb[4] = {b4.x, b4.y, b4.z, b4.w};
        float o[4];
#pragma unroll
        for (int j = 0; j < 4; ++j) o[j] = (y[j] - mean) * rstd * g[j] + bb[j] + rk * v[j];
        uint2 w; w.x = pk2(o[0], o[1]); w.y = pk2(o[2], o[3]);
        *(uint2*)yp = w;
    }
}

__device__ void subnorm_phase(const Params& p, int j) {
#ifdef NO_SUB
    return;
#endif

    const bf16_t* PB = (const bf16_t*)(p.ws + WS_PROJB); bf16_t* CQ = (bf16_t*)(p.ws + WS_CQ);
    const float* CKR = (const float*)(p.ws + WS_CKR); bf16_t* CKV = (bf16_t*)(p.ws + WS_CKV); bf16_t* KF = (bf16_t*)(p.ws + WS_KFULL);
    const float* rope = (const float*)(p.ws + WS_ROPE);
    const float* gq = p.in[32] + (size_t)j * 512; const float* gl = p.in[28];
    const int tid_ = opaque_tid(), lane = tid_ & 63, gw = blockIdx.x * NWV + (tid_ >> 6), nw = gridDim.x * NWV;
    for (int tok = gw; tok < T; tok += nw) {
        {
            const uint4 c = *(const uint4*)(PB + (size_t)tok * 768 + lane * 8);
            float v[8] = {bflo(c.x), bfhi(c.x), bflo(c.y), bfhi(c.y), bflo(c.z), bfhi(c.z), bflo(c.w), bfhi(c.w)};
            float ss = 0.f;
#pragma unroll
            for (int i = 0; i < 8; ++i) ss += v[i] * v[i];
            ss = wave_sum(ss);
            const float rs = rsqrtf(ss * (1.f / 512.f) + 1e-6f);
            const float4 g0 = *(const float4*)(gq + lane * 8), g1 = *(const float4*)(gq + lane * 8 + 4);
            uint4 w; w.x = pk2(v[0] * rs * g0.x, v[1] * rs * g0.y); w.y = pk2(v[2] * rs * g0.z, v[3] * rs * g0.w);
            w.z = pk2(v[4] * rs * g1.x, v[5] * rs * g1.y); w.w = pk2(v[6] * rs * g1.z, v[7] * rs * g1.w);
            *(uint4*)(CQ + (size_t)tok * 512 + lane * 8) = w;
        }
        if (j == 0) {
            const float4 c = *(const float4*)(CKR + (size_t)tok * 384 + lane * 4);
            float ss = c.x * c.x + c.y * c.y + c.z * c.z + c.w * c.w;
            ss = wave_sum(ss);
            const float rs = rsqrtf(ss * (1.f / 256.f) + 1e-6f);
            const float4 g = *(const float4*)(gl + lane * 4);
            uint2 w; w.x = pk2(c.x * rs * g.x, c.y * rs * g.y); w.y = pk2(c.z * rs * g.z, c.w * rs * g.w);
            *(uint2*)(CKV + (size_t)tok * 256 + lane * 4) = w;
            const int i = lane & 15, hg = lane >> 4;
            const float x1 = CKR[(size_t)tok * 384 + 256 + i], x2 = CKR[(size_t)tok * 384 + 272 + i];
            const float cs = rope[(size_t)tok * 32 + i], sn = rope[(size_t)tok * 32 + 16 + i];
            const bf16_t o1 = f2bf(x1 * cs - x2 * sn), o2 = f2bf(x2 * cs + x1 * sn);
            const int b = tok >> 13, s = tok & (S - 1);
#pragma unroll
            for (int hh = 0; hh < 3; ++hh) {
                bf16_t* kp = KF + ((size_t)(b * 12 + hg * 3 + hh) * S + s) * 96 + 64 + i;
                kp[0] = o1; kp[16] = o2;
            }
        }
    }
}

__device__ void rope_phase(const Params& p) {
    const int* pos = (const int*)p.in[2]; float* rope = (float*)(p.ws + WS_ROPE);
    const int tid_ = opaque_tid();
    for (int idx = blockIdx.x * NT + tid_; idx < T * 16; idx += gridDim.x * NT) {
        const int tok = idx >> 4, i = idx & 15;
        const float invf = powf(10000.f, -(float)i / 16.f);
        const float ang = (float)pos[tok] * invf;
        rope[(size_t)tok * 32 + i] = cosf(ang); rope[(size_t)tok * 32 + 16 + i] = sinf(ang);
    }
}

__device__ bool get_gemm_job(const Params& p, int ph, int jn, GemmJob& g) {
    char* ws = p.ws;
    bf16_t* WA = (bf16_t*)(ws + WS_WA); bf16_t* WF = (bf16_t*)(ws + WS_WF); bf16_t* H = (bf16_t*)(ws + WS_H); bf16_t* P = (bf16_t*)(ws + WS_P);
    bf16_t* LIN = (bf16_t*)(ws + WS_LIN); bf16_t* KMEM = (bf16_t*)(ws + WS_KMEM); bf16_t* VTMEM = (bf16_t*)(ws + WS_VTMEM); bf16_t* MEMN = (bf16_t*)(ws + WS_MEMN);
    g.M = T; g.e.o1 = nullptr; g.e.bias = nullptr; g.e.resid = nullptr; g.e.halo = nullptr; g.e.ldc = 0;
    const bool rw = ph < 25;
    const int L = rw ? (ph - 1) / 12 : 2 + (ph - 25) / 9, r = rw ? (ph - 1) % 12 : (ph - 25) % 9;
    const int r_wout = rw ? 8 : 5, r_gu = rw ? 10 : 7, r_down = rw ? 11 : 8;
    if (r == r_wout) { if (jn) return false; g.A = H; g.lda = 1024; g.W = WA + (rw ? A_WOUT : B_WOUT); g.K = 1024; g.N = 1024; g.kind = E_RESID; g.e.o0 = p.out; g.e.resid = (L == 0) ? p.in[0] : p.out; g.e.ldc = 1024; return true; }
    if (r == r_gu) { if (jn) return false; g.A = H; g.lda = 1024; g.W = WF + F_GU; g.K = 1024; g.N = 5632; g.kind = E_SWIGLU; g.e.o0 = P; g.e.ldc = 2816; return true; }
    if (r == r_down) { if (jn) return false; g.A = P; g.lda = 2816; g.W = WF + F_DOWN; g.K = 2816; g.N = 1024; g.kind = E_RESID; g.e.o0 = p.out; g.e.resid = p.out; g.e.ldc = 1024; return true; }
    if (r == 1 && jn == 1) { g.A = MEMN; g.lda = 1024; g.W = WA + (rw ? A_MKV : B_MKV); g.K = 1024; g.M = 1024; g.N = 512; g.kind = E_MEMKV; g.e.o0 = KMEM; g.e.o1 = VTMEM; return true; }
    if (rw) {
        const int i = L;
        if (r == 1 && jn == 0) { g.A = H; g.lda = 1024; g.W = WA + A_WIN; g.K = 1024; g.N = (i == 1) ? 2944 : 2816; g.kind = E_BF16; g.e.o0 = P; g.e.ldc = LDP; g.e.halo = (bf16_t*)(ws + WS_HALO); return true; }
        if (r == 3) {
            if (jn == 0) { g.A = LIN; g.lda = 320; g.W = WA + A_DEC; g.K = 64; g.N = 768; g.kind = E_DECAY; g.e.o0 = ws + WS_Z; g.e.bias = p.in[8] + (size_t)i * 768; g.e.ldc = 768; return true; }
            if (jn == 1) { g.A = LIN + 64; g.lda = 320; g.W = WA + A_AAA; g.K = 64; g.N = 768; g.kind = E_SIGB; g.e.o0 = ws + WS_Z + ZSZ; g.e.bias = p.in[10] + (size_t)i * 768; g.e.ldc = 768; return true; }
            if (jn == 2 && i == 1) { g.A = LIN + 256; g.lda = 320; g.W = WA + A_VUP; g.K = 64; g.N = 768; g.kind = E_SIGB; g.e.o0 = ws + WS_Z + 2 * ZSZ; g.e.bias = p.in[25]; g.e.ldc = 768; return true; }
            return false;
        }
        if (r == 7 && jn == 0) { g.A = LIN + 128; g.lda = 320; g.W = WA + A_GATE; g.K = 128; g.N = 768; g.kind = E_MULG; g.e.o0 = H; g.e.ldc = 1024; return true; }
        return false;
    }
    const int j = L - 2;
    if (r == 1) {
        if (jn == 0) { g.A = H; g.lda = 1024; g.W = WA + B_WIN; g.K = 1024; g.N = 768; g.kind = E_BF16; g.e.o0 = ws + WS_PROJB; g.e.ldc = 768; return true; }
        if (jn == 2 && j == 0) { g.A = (bf16_t*)(ws + WS_QFULL); g.lda = 1024; g.W = WA + B_KVD; g.K = 1024; g.N = 384; g.kind = E_F32; g.e.o0 = ws + WS_CKR; g.e.ldc = 384; return true; }
        return false;
    }
    if (r == 3) {
        if (jn == 0) { g.A = (bf16_t*)(ws + WS_CQ); g.lda = 512; g.W = WA + B_QUP; g.K = 512; g.N = 1152; g.kind = E_BF16; g.e.o0 = ws + WS_QFULL; g.e.ldc = 1152; return true; }
        if (jn == 1 && j == 0) { g.A = (bf16_t*)(ws + WS_CKV); g.lda = 256; g.W = WA + B_KVU; g.K = 256; g.N = 1536; g.kind = E_KV; g.e.o0 = ws + WS_KFULL; g.e.o1 = ws + WS_VT; return true; }
        return false;
    }
    return false;
}

__device__ void run_phase(const Params& p, int ph, char* smem) {
    char* ws = p.ws;
    bf16_t* H = (bf16_t*)(ws + WS_H);
    const float MEMSCL = 0.125f * 1.4426950408889634f, MLASCL = 0.10206207261596575f * 1.4426950408889634f;
    int rot = 0;
    const bool rw = ph >= 1 && ph < 25, mla = ph >= 25 && ph < 43;
    const int L = rw ? (ph - 1) / 12 : (mla ? 2 + (ph - 25) / 9 : 0), r = rw ? (ph - 1) % 12 : (mla ? (ph - 25) % 9 : -1);
    {
        const float* x = nullptr; int nrows = T; const float* g1 = nullptr; bf16_t* o1 = H; const float* g2 = nullptr; bf16_t* o2 = nullptr; float* of = nullptr;
        if (ph == 0) { x = p.in[1]; nrows = 1024; g1 = p.in[3]; o1 = (bf16_t*)(ws + WS_MEMN); }
        else if (ph == 43) { x = p.out; g1 = p.in[39]; of = p.out; }
        else if (rw && r == 0) { x = (L == 0) ? p.in[0] : p.out; g1 = p.in[4] + (size_t)L * 1024; }
        else if (rw && r == 9) { x = p.out; g1 = p.in[19] + (size_t)L * 1024; }
        else if (mla && r == 0) { x = p.out; g1 = p.in[30] + (size_t)(L - 2) * 1024; if (L == 2) { g2 = p.in[26]; o2 = (bf16_t*)(ws + WS_QFULL); } }
        else if (mla && r == 6) { x = p.out; g1 = p.in[36] + (size_t)(L - 2) * 1024; }
        if (x) rmsnorm_phase(x, nrows, g1, o1, g2, o2, of);
    }
    if (ph == 0) rope_phase(p);
    int cvb = blockIdx.x, cVG = gridDim.x;
    {
        int kind = -1, CL = 0;
        if (ph == 0) { kind = 0; CL = 0; }
        else if ((rw || mla) && r == 0) { kind = 1; CL = L; }
        else if (rw && r == 9) { kind = 0; CL = L + 1; }
        else if (mla && r == 6 && L == 2) { kind = 0; CL = 3; }
        const int GG = gridDim.x; const bool split = false;

        if (split && GG == 512) { const int b_ = blockIdx.x; cvb = (b_ >= 192 && b_ < 256) ? b_ - 192 : (b_ >= 448 ? b_ - 384 : -1); cVG = 128; }
        else { cvb = split ? (int)blockIdx.x - 192 : (int)blockIdx.x; cVG = split ? GG - 192 : GG; }
        if (kind >= 0 && cvb >= 0) { ConvJob c; for (int idx = 0; get_conv_job(p, kind, CL, idx, c); ++idx) run_conv(c, rot, smem, cvb, cVG); }
    }
    { GemmJob g; for (int jn = 0; jn < 3; ++jn) if (get_gemm_job(p, ph, jn, g)) { gemm_job(g, rot, smem); } }
    if ((rw || mla) && r == 3) {
        const bf16_t* Q = rw ? (const bf16_t*)(ws + WS_P) : (const bf16_t*)(ws + WS_PROJB);
        attn_phase<64, false>(Q, rw ? LDP : 768, rw ? 2560 : 512, (const bf16_t*)(ws + WS_KMEM), 256 * 64, (const bf16_t*)(ws + WS_VTMEM), 64 * 256, 256, 4, 256, nullptr, MEMSCL, H, 1024, 768, rot, smem, cvb, cVG);
    }
    if (mla && r == 4)
        attn_phase<96, true>((const bf16_t*)(ws + WS_QFULL), 1152, 0, (const bf16_t*)(ws + WS_KFULL), (size_t)S * 96, (const bf16_t*)(ws + WS_VT), (size_t)64 * S, S, 12, S, (const float*)(ws + WS_ROPE), MLASCL, H, 1024, 0, rot, smem, blockIdx.x, gridDim.x);
    if (rw && r == 2) lora_in_phase(p, L);
    if (rw && r == 4) prep_phase(p, L);
    if (rw && r == 5 && (blockIdx.x < 192 || cVG == (int)gridDim.x)) scan_phase(p, smem);
    if (rw && r == 6) post_phase(p, L);
    if (mla && r == 2) subnorm_phase(p, L - 2);
}

#define XB_TMO      128
#define XB_XCNT(j)  (256  + 64 * (j))
#define XB_XSUB(j)  (1280 + 64 * (j))
#define XB_XGEN(j)  (2304 + 64 * (j))
#define XB_TOP      3328
#define XB_TOPGEN   3392
#define XCD_BAR_WORDS 3456
#define XB_SPIN_CAP (1u << 18)
__device__ __forceinline__ unsigned xb_ld(unsigned* p)              { return __hip_atomic_load(p, __ATOMIC_RELAXED, __HIP_MEMORY_SCOPE_AGENT); }
__device__ __forceinline__ unsigned xb_add(unsigned* p, unsigned v) { return __hip_atomic_fetch_add(p, v, __ATOMIC_RELAXED, __HIP_MEMORY_SCOPE_AGENT); }
__device__ __forceinline__ unsigned xb_xcc_id() { return (unsigned)__builtin_amdgcn_s_getreg((3 << 11) | 20) & 0xFu; }
#define XB_SPIN(cond, bar) do { unsigned _sp = 0; while (cond) { __builtin_amdgcn_s_sleep(1); \
    if ((++_sp & 255u) == 0u) { if (xb_ld(&(bar)[XB_TMO])) break; if (_sp > XB_SPIN_CAP) { atomicAdd(&(bar)[XB_TMO], 1u); break; } } } } while (0)
struct XcdBarrier { unsigned* bar; unsigned x; volatile LAS unsigned* st; };
__device__ __forceinline__ XcdBarrier xcd_barrier_post(unsigned* bar, volatile LAS unsigned* st) {
    XcdBarrier b; b.bar = bar; b.x = xb_xcc_id(); b.st = st;
    if (threadIdx.x == 0) (void)xb_add(&bar[XB_XCNT(b.x)], 1u);
    return b;
}
__device__ __forceinline__ void xcd_barrier_complete(unsigned* bar, unsigned x, unsigned& nloc, unsigned& nx) {
    const unsigned G = gridDim.x * gridDim.y * gridDim.z;
    unsigned sum, cnt, mine, sp = 0u;
    for (;;) {
        sum = 0u; cnt = 0u; mine = 0u;
#pragma unroll
        for (unsigned j = 0; j < 16; ++j) { const unsigned c = xb_ld(&bar[XB_XCNT(j)]); sum += c; cnt += (c > 0u) ? 1u : 0u; mine = (j == x) ? c : mine; }
        if (sum == G) break;
        __builtin_amdgcn_s_sleep(1);
        if ((++sp & 255u) == 0u) { if (xb_ld(&bar[XB_TMO])) break; if (sp > XB_SPIN_CAP) { atomicAdd(&bar[XB_TMO], 1u); break; } }
    }
    nloc = mine > 0u ? mine : 1u; nx = cnt > 0u ? cnt : 1u;
}
__device__ __forceinline__ void xcd_barrier(const XcdBarrier& b) {
    asm volatile("s_waitcnt vmcnt(0)" ::: "memory");
    __syncthreads();
    if (threadIdx.x == 0) {
        unsigned* bar = b.bar;
        __builtin_amdgcn_s_waitcnt(0);
        unsigned nloc = b.st[0], nx = b.st[1];
        if (nloc == 0u) { xcd_barrier_complete(bar, b.x, nloc, nx); b.st[0] = nloc; b.st[1] = nx; }
        const unsigned old = xb_add(&bar[XB_XSUB(b.x)], 1u);
        const unsigned gen = old / nloc;
        if (old + 1u == (gen + 1u) * nloc) {
            __builtin_amdgcn_fence(__ATOMIC_RELEASE, "agent");
            asm volatile("s_waitcnt vmcnt(0)" ::: "memory");
            const unsigned og = xb_add(&bar[XB_TOP], 1u);
            const unsigned tg = og / nx;
            if (og + 1u == (tg + 1u) * nx) xb_add(&bar[XB_TOPGEN], 1u);
            else XB_SPIN(xb_ld(&bar[XB_TOPGEN]) == tg, bar);
            __builtin_amdgcn_fence(__ATOMIC_ACQUIRE, "agent");
            xb_add(&bar[XB_XGEN(b.x)], 1u);
            asm volatile("s_waitcnt vmcnt(0)" ::: "memory");
        } else {
            XB_SPIN(xb_ld(&bar[XB_XGEN(b.x)]) == gen, bar);
            __builtin_amdgcn_fence(__ATOMIC_ACQUIRE, "agent");
            asm volatile("s_waitcnt vmcnt(0)" ::: "memory");
        }
    }
    __syncthreads();
}

__global__ void __launch_bounds__(NT) yoco_mega(Params p) {
    extern __shared__ __attribute__((aligned(16))) char smem[];
    cg::grid_group grid = cg::this_grid();
    volatile LAS unsigned* st = (volatile LAS unsigned*)((LAS char*)smem + LDS_MAIN);
    if (threadIdx.x == 0) { st[0] = 0u; st[1] = 0u; }
    __syncthreads();
    const XcdBarrier xb = xcd_barrier_post((unsigned*)(p.ws + WS_BAR), st);
    if (p.ph_lo < 0) grid.sync();
    for (int ph = p.ph_lo; ph < p.ph_hi; ++ph) {
        int nrep = 1;
#if PROBE_DUP
        {
            const bool rw = ph >= 1 && ph < 25, mla = ph >= 25 && ph < 43;
            const int r = rw ? (ph - 1) % 12 : (mla ? (ph - 25) % 9 : -1);
            if ((PROBE_DUP & 1) && rw && r == 5) nrep = 2;
            if ((PROBE_DUP & 2) && ((rw && r == 10) || (mla && r == 7))) nrep = 2;
            if ((PROBE_DUP & 4) && mla && r == 4) nrep = 2;
            if ((PROBE_DUP & 8) && rw && r == 3) nrep = 2;
            if ((PROBE_DUP & 16) && ((rw && (r == 0 || r == 9)) || (mla && (r == 0 || r == 6)))) nrep = 2;
            if ((PROBE_DUP & 32) && ((rw && r == 2) || (mla && (r == 2 || r == 3)))) nrep = 2;
        }
#endif
        for (int rep = 0; rep < nrep; ++rep) {
            run_phase(p, ph, smem);
            if (rep + 1 < nrep || ph + 1 < p.ph_hi) xcd_barrier(xb);
        }
    }
}

#ifndef PROBE_DUP
#define PROBE_DUP 0
#endif
#ifndef MULTI_LAUNCH
#define MULTI_LAUNCH 0
#endif

extern "C" void kernel_launch(void* const* d_in, const int* in_sizes, int n_in, void* d_out, int out_size, void* d_ws, size_t ws_size, hipStream_t stream) {
    static int grid_blocks = 0;
    if (!grid_blocks) {
        int dev = 0, cus = 0, per_cu = 0;
        hipGetDevice(&dev);
        hipDeviceGetAttribute(&cus, hipDeviceAttributeMultiprocessorCount, dev);
        hipFuncSetAttribute((const void*)yoco_mega, hipFuncAttributeMaxDynamicSharedMemorySize, LDS_BYTES);
        hipOccupancyMaxActiveBlocksPerMultiprocessor(&per_cu, (const void*)yoco_mega, NT, LDS_BYTES);
        if (per_cu < 1) per_cu = 1;
        if (per_cu > 1) per_cu = 1;
        grid_blocks = cus * per_cu;
        if (ws_size < WS_END) fprintf(stderr, "kernel_launch: workspace too small: %zu < %zu\n", ws_size, (size_t)WS_END);
        if (n_in != 40) fprintf(stderr, "kernel_launch: expected 40 inputs, got %d\n", n_in);
    }
    Params p{};
    for (int i = 0; i < 40; ++i) p.in[i] = (const float*)d_in[i];
    p.out = (float*)d_out; p.ws = (char*)d_ws;
#if MULTI_LAUNCH
    for (int ph = 0; ph < 44; ++ph) {
        p.ph_lo = ph; p.ph_hi = ph + 1;
        hipLaunchKernelGGL(yoco_mega, dim3(grid_blocks), dim3(NT), LDS_BYTES, stream, p);
    }
#else
    p.ph_lo = 0; p.ph_hi = 44;
    (void)hipMemsetAsync((char*)d_ws + WS_BAR, 0, 16384, stream);
    void* args[] = {&p};
    hipError_t e = hipLaunchCooperativeKernel((const void*)yoco_mega, dim3(grid_blocks), dim3(NT), args, LDS_BYTES, stream);
    if (e != hipSuccess) fprintf(stderr, "cooperative launch failed: %s (grid %d)\n", hipGetErrorString(e), grid_blocks);
#endif
}
```

```cpp
#include <hip/hip_runtime.h>
#include <hip/hip_cooperative_groups.h>
#include <cstdio>
#include <cstdint>
namespace cg = cooperative_groups;
#define PROBE_DUP 0

typedef unsigned short bf16_t;
typedef short bf16x8 __attribute__((ext_vector_type(8)));
typedef float f32x16 __attribute__((ext_vector_type(16)));
typedef _Float16 h8 __attribute__((ext_vector_type(8)));
typedef unsigned u32x4 __attribute__((ext_vector_type(4)));
typedef float f32x2 __attribute__((ext_vector_type(2)));
#define LAS __attribute__((address_space(3)))
typedef float f32x4 __attribute__((ext_vector_type(4)));

constexpr int T = 32768, S = 8192;
constexpr int LDP = 2944;
constexpr int NT = 512, NWV = 8;
constexpr int LDS_MAIN = 147456;
constexpr int LDS_BYTES = LDS_MAIN + 16;

constexpr size_t WS_WA = 0;
constexpr size_t WS_WF = WS_WA + 10485760;
constexpr size_t WS_H = WS_WF + 17825792;
constexpr size_t WS_P = WS_H + 67108864;
constexpr size_t WS_Z = WS_P + 192937984;
constexpr size_t ZSZ = 50331648;
constexpr size_t WS_LIN = WS_Z + 4 * ZSZ;
constexpr size_t WS_RK = WS_LIN + 20971520;
constexpr size_t WS_ROPE = WS_RK + 1572864;
constexpr size_t WS_KMEM = WS_ROPE + 4194304;
constexpr size_t WS_VTMEM = WS_KMEM + 524288;
constexpr size_t WS_MEMN = WS_VTMEM + 524288;
constexpr size_t WS_HALO = WS_MEMN + 2097152;
constexpr size_t WS_BAR = WS_HALO + 1507328;
constexpr size_t WS_END = WS_BAR + 16384;
constexpr size_t WS_KFULL = WS_Z;
constexpr size_t WS_VT = WS_KFULL + 75497472;
constexpr size_t WS_PROJB = WS_VT + 50331648;
constexpr size_t WS_QFULL = WS_P;
constexpr size_t WS_CQ = WS_QFULL + 75497472;
constexpr size_t WS_CKR = WS_CQ + 33554432;
constexpr size_t WS_CKV = WS_CKR + 50331648;
constexpr size_t A_WIN = 0, A_DEC = 3014656, A_AAA = 3063808, A_GATE = 3112960, A_VUP = 3211264, A_MKV = 3260416, A_WOUT = 3784704;
constexpr size_t B_WIN = 0, B_QUP = 786432, B_MKV = 1376256, B_WOUT = 1900544, B_KVD = 2949120, B_KVU = 3342336;
constexpr size_t F_GU = 0, F_DOWN = 5767168;

struct Params { const float* in[40]; float* out; char* ws; int ph_lo, ph_hi; };

__device__ __forceinline__ bf16_t f2bf(float f) { unsigned u = __float_as_uint(f); u += 0x7fffu + ((u >> 16) & 1u); return (bf16_t)(u >> 16); }
__device__ __forceinline__ unsigned pk2(float lo, float hi) { unsigned r; asm("v_cvt_pk_bf16_f32 %0, %1, %2" : "=v"(r) : "v"(lo), "v"(hi)); return r; }
__device__ __forceinline__ float bflo(unsigned u) { return __uint_as_float(u << 16); }
__device__ __forceinline__ float bfhi(unsigned u) { return __uint_as_float(u & 0xffff0000u); }
__device__ __forceinline__ float bf2f(bf16_t v) { return __uint_as_float((unsigned)v << 16); }
__device__ __forceinline__ float reduce16(float x);
__device__ __forceinline__ float wave_sum(float v) {
    v = reduce16(v);
    const int b = __float_as_int(v);
    return (__int_as_float(__builtin_amdgcn_readlane(b, 0)) + __int_as_float(__builtin_amdgcn_readlane(b, 16))) +
           (__int_as_float(__builtin_amdgcn_readlane(b, 32)) + __int_as_float(__builtin_amdgcn_readlane(b, 48)));
}
template <int CTRL> __device__ __forceinline__ float dppmov(float x) { return __int_as_float(__builtin_amdgcn_update_dpp(0, __float_as_int(x), CTRL, 0xF, 0xF, true)); }
__device__ __forceinline__ float reduce16(float x) {
    x += dppmov<0xB1>(x); x += dppmov<0x4E>(x); x += dppmov<0x141>(x); x += dppmov<0x140>(x); return x;
}
__device__ __forceinline__ int opaque_tid() { int t = threadIdx.x; asm volatile("" : "+v"(t)); return t; }
__device__ __forceinline__ float sigmoidf_(float x) { return __builtin_amdgcn_rcpf(1.f + __expf(-x)); }

__device__ void rmsnorm_phase(const float* x, int nrows, const float* g1, bf16_t* o1, const float* g2, bf16_t* o2, float* of) {
    const int tid_ = opaque_tid(), lane = tid_ & 63, gw = blockIdx.x * NWV + (tid_ >> 6), nw = gridDim.x * NWV;
    for (int row = gw; row < nrows; row += nw) {
        const float4* xr = (const float4*)(x + (size_t)row * 1024);
        float4 v[4]; float ss = 0.f;
#pragma unroll
        for (int i = 0; i < 4; ++i) { v[i] = xr[lane + 64 * i]; ss += v[i].x * v[i].x + v[i].y * v[i].y + v[i].z * v[i].z + v[i].w * v[i].w; }
        ss = wave_sum(ss);
        const float rs = rsqrtf(ss * (1.f / 1024.f) + 1e-6f);
#pragma unroll
        for (int i = 0; i < 4; ++i) {
            const float4 g = ((const float4*)g1)[lane + 64 * i];
            const float a = v[i].x * rs, b = v[i].y * rs, c = v[i].z * rs, d = v[i].w * rs;
            if (of) { float4 o; o.x = a * g.x; o.y = b * g.y; o.z = c * g.z; o.w = d * g.w; ((float4*)(of + (size_t)row * 1024))[lane + 64 * i] = o; }
            else {
                uint2 w; w.x = pk2(a * g.x, b * g.y); w.y = pk2(c * g.z, d * g.w);
                *(uint2*)(o1 + (size_t)row * 1024 + (lane + 64 * i) * 4) = w;
                if (o2) { const float4 h = ((const float4*)g2)[lane + 64 * i]; uint2 w2; w2.x = pk2(a * h.x, b * h.y); w2.y = pk2(c * h.z, d * h.w);
                    *(uint2*)(o2 + (size_t)row * 1024 + (lane + 64 * i) * 4) = w2; }
            }
        }
    }
}

struct ConvJob { const float* src; int ld; int ncols; int kvalid; bf16_t* dst; int dstK; int ngran; int swiglu; const float* rscale; int rsmode; };
__device__ void run_conv(const ConvJob& j, int& rot, char* smem, int vb, int G) {
#ifdef NO_CONV
    return;
#endif

    bf16_t* lds = (bf16_t*)smem;
    const int tid = opaque_tid(), nkt = j.dstK >> 6, units = j.ngran * nkt;
    for (int u = (vb + G - rot) % G; u < units; u += G) {
        const int g = u / nkt, kt = u - g * nkt, k0 = kt * 64;
        int col0 = j.swiglu ? ((g & 1) * 2816 + 32 * (g >> 1)) : 32 * g;
        const bool colok = (col0 + 32 <= j.ncols);
#pragma unroll
        for (int i = 0; i < 4; ++i) {
            const int kr = (tid >> 5) + 16 * i, c = tid & 31, k = k0 + kr;
            float v = 0.f;
            if (colok && k < j.kvalid) {
                v = j.src[(size_t)k * j.ld + col0 + c];
                if (j.rsmode == 1) v *= (1.f - j.rscale[k]); else if (j.rsmode == 2) v *= j.rscale[k];
            }
            lds[c * 72 + kr] = f2bf(v);
        }
        __syncthreads();
        if (tid < 256) { const int c = tid >> 3, kc = (tid & 7) * 8;
          const uint4 w = *(const uint4*)(lds + c * 72 + kc);
          *(uint4*)(j.dst + (size_t)(g * 32 + c) * j.dstK + k0 + kc) = w; }
        __syncthreads();
    }
    rot = (rot + units) % G;
}
__device__ bool get_conv_job(const Params& p, int kind, int L, int idx, ConvJob& c) {
    bf16_t* WA = (bf16_t*)(p.ws + WS_WA); bf16_t* WF = (bf16_t*)(p.ws + WS_WF);
    c.swiglu = 0; c.rscale = nullptr; c.rsmode = 0;
    if (kind == 1) {
        if (idx == 0) { c.src = (L < 2) ? p.in[20] + (size_t)L * 1024 * 5632 : p.in[37] + (size_t)(L - 2) * 1024 * 5632; c.ld = 5632; c.ncols = 5632; c.kvalid = 1024; c.dst = WF + F_GU; c.dstK = 1024; c.ngran = 176; c.swiglu = 1; return true; }
        if (idx == 1) { c.src = (L < 2) ? p.in[21] + (size_t)L * 2816 * 1024 : p.in[38] + (size_t)(L - 2) * 2816 * 1024; c.ld = 1024; c.ncols = 1024; c.kvalid = 2816; c.dst = WF + F_DOWN; c.dstK = 2816; c.ngran = 32; return true; }
        return false;
    }
    if (L < 2) {
        const int i = L;
        switch (idx) {
        case 0: c.src = p.in[5] + (size_t)i * 1024 * 2816; c.ld = 2816; c.ncols = 2816; c.kvalid = 1024; c.dst = WA + A_WIN; c.dstK = 1024; c.ngran = 88; return true;
        case 1: c.src = p.in[7] + (size_t)i * 64 * 768; c.ld = 768; c.ncols = 768; c.kvalid = 64; c.dst = WA + A_DEC; c.dstK = 64; c.ngran = 24; return true;
        case 2: c.src = p.in[9] + (size_t)i * 64 * 768; c.ld = 768; c.ncols = 768; c.kvalid = 64; c.dst = WA + A_AAA; c.dstK = 64; c.ngran = 24; return true;
        case 3: c.src = p.in[11] + (size_t)i * 128 * 768; c.ld = 768; c.ncols = 768; c.kvalid = 128; c.dst = WA + A_GATE; c.dstK = 128; c.ngran = 24; return true;
        case 4: c.src = p.in[17] + (size_t)i * 1024 * 512; c.ld = 512; c.ncols = 512; c.kvalid = 1024; c.dst = WA + A_MKV; c.dstK = 1024; c.ngran = 16; return true;
        case 5: c.src = p.in[18] + (size_t)i * 1024 * 1024; c.ld = 1024; c.ncols = 1024; c.kvalid = 1024; c.dst = WA + A_WOUT; c.dstK = 1024; c.ngran = 32; return true;
        }
        if (i == 0) return false;
        switch (idx) {
        case 6: c.src = p.in[23]; c.ld = 32; c.ncols = 32; c.kvalid = 1024; c.dst = WA + A_WIN + (size_t)2816 * 1024; c.dstK = 1024; c.ngran = 1; c.rscale = p.in[22]; c.rsmode = 1; return true;
        case 7: c.src = p.in[23]; c.ld = 32; c.ncols = 32; c.kvalid = 1024; c.dst = WA + A_WIN + (size_t)2848 * 1024; c.dstK = 1024; c.ngran = 1; c.rscale = p.in[22]; c.rsmode = 2; return true;
        case 8: c.src = p.in[23]; c.ld = 32; c.ncols = 0; c.kvalid = 1024; c.dst = WA + A_WIN + (size_t)2880 * 1024; c.dstK = 1024; c.ngran = 2; return true;
        case 9: c.src = p.in[24]; c.ld = 768; c.ncols = 768; c.kvalid = 32; c.dst = WA + A_VUP; c.dstK = 64; c.ngran = 24; return true;
        }
        return false;
    }
    const int j = L - 2;
    switch (idx) {
    case 0: c.src = p.in[31] + (size_t)j * 1024 * 768; c.ld = 768; c.ncols = 768; c.kvalid = 1024; c.dst = WA + B_WIN; c.dstK = 1024; c.ngran = 24; return true;
    case 1: c.src = p.in[33] + (size_t)j * 512 * 1152; c.ld = 1152; c.ncols = 1152; c.kvalid = 512; c.dst = WA + B_QUP; c.dstK = 512; c.ngran = 36; return true;
    case 2: c.src = p.in[34] + (size_t)j * 1024 * 512; c.ld = 512; c.ncols = 512; c.kvalid = 1024; c.dst = WA + B_MKV; c.dstK = 1024; c.ngran = 16; return true;
    case 3: c.src = p.in[35] + (size_t)j * 1024 * 1024; c.ld = 1024; c.ncols = 1024; c.kvalid = 1024; c.dst = WA + B_WOUT; c.dstK = 1024; c.ngran = 32; return true;
    }
    if (j != 0) return false;
    if (idx == 4) { c.src = p.in[27]; c.ld = 288; c.ncols = 288; c.kvalid = 1024; c.dst = WA + B_KVD; c.dstK = 1024; c.ngran = 12; return true; }
    if (idx == 5) { c.src = p.in[29]; c.ld = 1536; c.ncols = 1536; c.kvalid = 256; c.dst = WA + B_KVU; c.dstK = 256; c.ngran = 48; return true; }
    return false;
}

enum { E_BF16 = 0, E_F32, E_RESID, E_SWIGLU, E_DECAY, E_SIGB, E_KV, E_MEMKV, E_MULG };
struct Epi { void* o0; void* o1; const float* bias; const float* resid; int ldc; bf16_t* halo; };
struct GemmJob { const bf16_t* A; int lda; const bf16_t* W; int K, M, N, kind; Epi e; };

template <int E, int MI> __device__ __forceinline__ void epilogue(const f32x16 (&acc)[MI][2], int m0, int n0, int wm, int wn, int lane, const Epi& e) {
    const int half = lane >> 5, l31 = lane & 31;
    if (E == E_SWIGLU) {
        bf16_t* o = (bf16_t*)e.o0; const int col = (n0 >> 1) + wn * 32 + l31;
#pragma unroll
        for (int mi = 0; mi < MI; ++mi) {
            int rb_ = m0 + wm * (MI * 32) + mi * 32 + 4 * half;
            asm volatile("" : "+v"(rb_));
#pragma unroll
            for (int i = 0; i < 16; i += 2) {
                const int row = rb_ + 8 * (i >> 2) + (i & 3);
                const float g0 = acc[mi][0][i], u0 = acc[mi][1][i], g1 = acc[mi][0][i + 1], u1 = acc[mi][1][i + 1];
                const unsigned w = pk2(g0 * sigmoidf_(g0) * u0, g1 * sigmoidf_(g1) * u1);
                o[(size_t)row * 2816 + col] = (bf16_t)w; o[(size_t)(row + 1) * 2816 + col] = (bf16_t)(w >> 16);
            }
        }
        return;
    }
#pragma unroll
    for (int mi = 0; mi < MI; ++mi)
#pragma unroll
        for (int ni = 0; ni < 2; ++ni) {
            const int col = n0 + wn * 64 + ni * 32 + l31;
            int rbase = m0 + wm * (MI * 32) + mi * 32 + 4 * half;
            asm volatile("" : "+v"(rbase));
            if (E == E_KV || E == E_MEMKV) {
                const bool isv = (E == E_KV) ? ((col & 127) >= 64) : (col >= 256);
                if (isv) {
#pragma unroll
                    for (int g = 0; g < 4; ++g) {
                        const int row = rbase + 8 * g;
                        uint2 w; w.x = pk2(acc[mi][ni][4 * g], acc[mi][ni][4 * g + 1]); w.y = pk2(acc[mi][ni][4 * g + 2], acc[mi][ni][4 * g + 3]);
                        size_t idx;
                        if (E == E_KV) { const int b = row >> 13, s = row & 8191, head = col >> 7, d = (col & 127) - 64; idx = ((size_t)(b * 12 + head) * 64 + d) * 8192 + s; }
                        else { const int b = row >> 8, mi_ = row & 255, head = (col - 256) >> 6, d = col & 63; idx = ((size_t)(b * 4 + head) * 64 + d) * 256 + mi_; }
                        *(uint2*)((bf16_t*)e.o1 + idx) = w;
                    }
                } else {
#pragma unroll
                    for (int i = 0; i < 16; ++i) {
                        const int row = rbase + 8 * (i >> 2) + (i & 3);
                        size_t idx;
                        if (E == E_KV) { const int b = row >> 13, s = row & 8191, head = col >> 7, c = col & 127; idx = ((size_t)(b * 12 + head) * 8192 + s) * 96 + c; }
                        else { const int b = row >> 8, mi_ = row & 255, head = col >> 6, d = col & 63; idx = ((size_t)(b * 4 + head) * 256 + mi_) * 64 + d; }
                        ((bf16_t*)e.o0)[idx] = f2bf(acc[mi][ni][i]);
                    }
                }
                continue;
            }
            float bias = 0.f;
            if (E == E_DECAY || E == E_SIGB) bias = e.bias[col];
#pragma unroll
            for (int i = 0; i < 16; ++i) {
                const int row = rbase + 8 * (i >> 2) + (i & 3);
                const float v = acc[mi][ni][i];
                const size_t idx = (size_t)row * e.ldc + col;
                if (E == E_BF16) {
                    if ((i & 1) == 0) {
                        const unsigned w = pk2(v, acc[mi][ni][i + 1]);
                        const bf16_t b0 = (bf16_t)w, b1 = (bf16_t)(w >> 16);
                        ((bf16_t*)e.o0)[idx] = b0; ((bf16_t*)e.o0)[idx + e.ldc] = b1;
                        if (e.halo && ((row + 1) & 127) == 127) e.halo[(size_t)((row + 1) >> 7) * e.ldc + col] = b1;
                    }
                } else if (E == E_F32) ((float*)e.o0)[idx] = v;
                else if (E == E_RESID) ((float*)e.o0)[idx] = e.resid[idx] + v;
                else if (E == E_DECAY) ((_Float16*)e.o0)[idx] = (_Float16)(0.60653066f * sigmoidf_(bias + v));
                else if (E == E_SIGB) ((bf16_t*)e.o0)[idx] = f2bf(sigmoidf_(bias + v));
                else if (E == E_MULG) { bf16_t* o = (bf16_t*)e.o0; o[idx] = f2bf(bf2f(o[idx]) * v); }
            }
        }
}

__device__ void gemm_job(const GemmJob& gj, int& rot, char* smem) {
#ifdef NO_GEMM
    return;
#endif
    const bf16_t* A = gj.A; const bf16_t* W = gj.W; const int lda = gj.lda, K = gj.K, M = gj.M, N = gj.N; const Epi& e = gj.e;
    const int tid = opaque_tid(), lane = tid & 63, wave = tid >> 6, wm = wave >> 2, wn = wave & 3;
    const int ntn = (N + 255) >> 8, ntm = M >> 8, KT = K >> 6, G = gridDim.x;
    bf16_t* sA = (bf16_t*)smem;
    bf16_t* sB = sA + 2 * 256 * 72;
    const int half = lane >> 5, l31 = lane & 31;
    const int bp = (blockIdx.x + G - rot) % G;
    const bool xmap = (ntm & 7) == 0;
    const int xcd = bp & 7, li = bp >> 3, GL = G >> 3, mpx = ntm >> 3, mgsz = mpx < 8 ? (mpx > 0 ? mpx : 1) : 8, gsz = mgsz * ntn;
    const int tcount = xmap ? mpx * ntn : ntm * ntn, tstart = xmap ? li : bp, tstep = xmap ? GL : G;
    for (int idx = tstart; idx < tcount; idx += tstep) {
        int tm, tn;
        if (xmap) { const int grp = idx / gsz, rem = idx - grp * gsz; tn = rem / mgsz; tm = xcd * mpx + grp * mgsz + (rem - tn * mgsz); }
        else { tm = idx / ntn; tn = idx - tm * ntn; }
        const int m0 = tm << 8, n0 = tn << 8;
        const bool wact = (n0 + wn * 64) < N;
        f32x16 acc[4][2];
#pragma unroll
        for (int a = 0; a < 4; ++a)
#pragma unroll
            for (int b = 0; b < 2; ++b)
#pragma unroll
                for (int i = 0; i < 16; ++i) acc[a][b][i] = 0.f;
        u32x4 ra[4], rb[4];
        const char* Ab = (const char*)(A + (size_t)m0 * lda);
        const char* Wb = (const char*)(W + (size_t)n0 * K);
        const unsigned aoff = (unsigned)(((tid >> 3) * lda + (tid & 7) * 8) * 2), woff = (unsigned)(((tid >> 3) * K + (tid & 7) * 8) * 2);
#define GLOAD_TILE(KT_) { _Pragma("unroll") for (int i = 0; i < 4; ++i) { \
            ra[i] = *(const u32x4*)(Ab + ((size_t)(64 * i) * lda + (size_t)(KT_) * 64) * 2 + aoff); \
            rb[i] = *(const u32x4*)(Wb + ((size_t)(64 * i) * K + (size_t)(KT_) * 64) * 2 + woff); } }
        GLOAD_TILE(0)
        const int lofs = (tid >> 3) * 72 + (tid & 7) * 8;
#pragma unroll
        for (int i = 0; i < 4; ++i) { *(u32x4*)(sA + lofs + 64 * i * 72) = ra[i]; *(u32x4*)(sB + lofs + 64 * i * 72) = rb[i]; }
        if (KT > 1) GLOAD_TILE(1)
        __syncthreads();
        for (int kt = 0; kt < KT; ++kt) {
            const int buf = kt & 1;
            if (kt + 1 < KT) {
                bf16_t* da = sA + (buf ^ 1) * 256 * 72 + lofs; bf16_t* db = sB + (buf ^ 1) * 256 * 72 + lofs;
#pragma unroll
                for (int i = 0; i < 4; ++i) { *(u32x4*)(da + 64 * i * 72) = ra[i]; *(u32x4*)(db + 64 * i * 72) = rb[i]; }
            }
            if (kt + 2 < KT) GLOAD_TILE(kt + 2)
            if (wact) {
                const bf16_t* a_ = sA + buf * 256 * 72 + (wm * 128 + l31) * 72 + half * 8;
                const bf16_t* b_ = sB + buf * 256 * 72 + (wn * 64 + l31) * 72 + half * 8;
#define LDF(P_, O_) (*(const bf16x8*)((P_) + (O_)))
#define MM(I_, J_, AF, BF) acc[I_][J_] = __builtin_amdgcn_mfma_f32_32x32x16_bf16(AF, BF, acc[I_][J_], 0, 0, 0);
                bf16x8 b0 = LDF(b_, 0), b1 = LDF(b_, 32 * 72), a0 = LDF(a_, 0), a1 = LDF(a_, 32 * 72), a2, a3;
#pragma unroll
                for (int kk = 0; kk < 4; ++kk) {
                    a2 = LDF(a_, 64 * 72 + kk * 16); a3 = LDF(a_, 96 * 72 + kk * 16);
                    __builtin_amdgcn_sched_barrier(0);
                    MM(0, 0, a0, b0) MM(0, 1, a0, b1) MM(1, 0, a1, b0) MM(1, 1, a1, b1)
                    __builtin_amdgcn_sched_barrier(0);
                    if (kk < 3) { a0 = LDF(a_, (kk + 1) * 16); a1 = LDF(a_, 32 * 72 + (kk + 1) * 16); }
                    bf16x8 c0 = b0, c1 = b1;
                    if (kk < 3) { b0 = LDF(b_, (kk + 1) * 16); b1 = LDF(b_, 32 * 72 + (kk + 1) * 16); }
                    __builtin_amdgcn_sched_barrier(0);
                    MM(2, 0, a2, c0) MM(2, 1, a2, c1) MM(3, 0, a3, c0) MM(3, 1, a3, c1)
                    __builtin_amdgcn_sched_barrier(0);
                }
#undef LDF
#undef MM
            }
            __syncthreads();
        }
#undef GLOAD_TILE
        if (wact) {
            switch (gj.kind) {
            case E_BF16: epilogue<E_BF16, 4>(acc, m0, n0, wm, wn, lane, e); break;
            case E_F32: epilogue<E_F32, 4>(acc, m0, n0, wm, wn, lane, e); break;
            case E_RESID: epilogue<E_RESID, 4>(acc, m0, n0, wm, wn, lane, e); break;
            case E_SWIGLU: epilogue<E_SWIGLU, 4>(acc, m0, n0, wm, wn, lane, e); break;
            case E_DECAY: epilogue<E_DECAY, 4>(acc, m0, n0, wm, wn, lane, e); break;
            case E_SIGB: epilogue<E_SIGB, 4>(acc, m0, n0, wm, wn, lane, e); break;
            case E_KV: epilogue<E_KV, 4>(acc, m0, n0, wm, wn, lane, e); break;
            case E_MEMKV: epilogue<E_MEMKV, 4>(acc, m0, n0, wm, wn, lane, e); break;
            default: epilogue<E_MULG, 4>(acc, m0, n0, wm, wn, lane, e); break;
            }
        }
    }
    rot = (rot + (xmap ? 8 * (tcount % GL) : tcount) ) % G;
}

template <int DQK, bool CAUSAL>
__device__ void attn_phase(const bf16_t* Q, int ldq, int qcol0, const bf16_t* Kb, size_t k_bh_stride, const bf16_t* VT, size_t vt_bh_stride, int vt_ld,
                           int nheads, int nkeys, const float* rope, float scl, bf16_t* O, int ldo, int ocol0, int& rot, char* smem, int vb, int G) {
#ifdef NO_ATTN
    return;
#endif

    constexpr int KS = DQK + 8, NKK = DQK / 16, KCH = DQK / 8, NCH = 64 * KCH, NKL = (NCH + NT - 1) / NT;
    const int tid = opaque_tid(), lane = tid & 63, wave = tid >> 6, half = lane >> 5, l31 = lane & 31;
    const int xaddr = (lane ^ 32) << 2;
    bf16_t* sK = (bf16_t*)smem;
    bf16_t* sV = sK + 2 * 64 * KS;
    const int nbh = 4 * nheads, upx = (nbh >> 3) * 32;
    const int bp = (vb + G - rot) % G, xcd = bp & 7, li = bp >> 3, GL = G >> 3;
    for (int idx = li; idx < upx; idx += GL) {
        const int hr = idx >> 5, qi = idx & 31, qb = (hr & 1) ? 31 - qi : qi, bh = xcd + 8 * hr, b = bh / nheads, h = bh - b * nheads;
        const int q0 = qb * 256 + wave * 32, q = q0 + l31;
        const size_t tokq = (size_t)b * S + q;
        bf16x8 qf[NKK];
        { const bf16_t* qp = Q + tokq * ldq + qcol0 + h * DQK + half * 8;
#pragma unroll
          for (int kk = 0; kk < NKK; ++kk) qf[kk] = *(const bf16x8*)(qp + kk * 16); }
        if (rope) {
            const float* rp = rope + tokq * 32 + half * 8;
            const float4 c0 = *(const float4*)rp, c1 = *(const float4*)(rp + 4), s0 = *(const float4*)(rp + 16), s1 = *(const float4*)(rp + 20);
            u32x4 qa = __builtin_bit_cast(u32x4, qf[NKK - 2]), qb_ = __builtin_bit_cast(u32x4, qf[NKK - 1]);
#define ROT2(D, CA, SA, CB, SB) { const float x1l = bflo(qa[D]), x1h = bfhi(qa[D]), x2l = bflo(qb_[D]), x2h = bfhi(qb_[D]); \
              qa[D] = pk2(x1l * CA - x2l * SA, x1h * CB - x2h * SB); qb_[D] = pk2(x2l * CA + x1l * SA, x2h * CB + x1h * SB); }
            ROT2(0, c0.x, s0.x, c0.y, s0.y) ROT2(1, c0.z, s0.z, c0.w, s0.w) ROT2(2, c1.x, s1.x, c1.y, s1.y) ROT2(3, c1.z, s1.z, c1.w, s1.w)
#undef ROT2
            qf[NKK - 2] = __builtin_bit_cast(bf16x8, qa); qf[NKK - 1] = __builtin_bit_cast(bf16x8, qb_);
        }
        const int ntiles = CAUSAL ? (qb * 4 + 4) : (nkeys >> 6);
        f32x16 o[2];
#pragma unroll
        for (int a = 0; a < 2; ++a)
#pragma unroll
            for (int i = 0; i < 16; ++i) o[a][i] = 0.f;
        float m = -1e30f, l = 0.f;
        const bf16_t* Kg = Kb + (size_t)bh * k_bh_stride;
        const bf16_t* Vg = VT + (size_t)bh * vt_bh_stride + (size_t)(tid >> 3) * vt_ld + (tid & 7) * 8;
        u32x4 rk[NKL], rv[1];
#pragma unroll
        for (int i = 0; i < NKL; ++i) { const int c = tid + NT * i; if (c < NCH) rk[i] = *(const u32x4*)(Kg + (size_t)c * 8); }
        rv[0] = *(const u32x4*)(Vg);
#pragma unroll
        for (int i = 0; i < NKL; ++i) { const int c = tid + NT * i; if (c < NCH) *(u32x4*)(sK + (c / KCH) * KS + (c % KCH) * 8) = rk[i]; }
        *(u32x4*)(sV + (tid >> 3) * 72 + (tid & 7) * 8) = rv[0];
        __syncthreads();
        for (int kt = 0; kt < ntiles; ++kt) {
            const int buf = kt & 1;
            if (kt + 1 < ntiles) {
#pragma unroll
                for (int i = 0; i < NKL; ++i) { const int c = tid + NT * i; if (c < NCH) rk[i] = *(const u32x4*)(Kg + (size_t)(kt + 1) * 64 * DQK + (size_t)c * 8); }
                rv[0] = *(const u32x4*)(Vg + (kt + 1) * 64);
            }
            if (!CAUSAL || kt * 64 <= q0 + 31) {
                const bf16_t* kb_ = sK + buf * 64 * KS + l31 * KS + half * 8;
                const bf16_t* vb_ = sV + buf * 64 * 72 + l31 * 72 + 4 * half;
                f32x16 s[2];
                bf16x8 kf0[NKK], kf1[NKK];
                __builtin_amdgcn_sched_barrier(0);
#pragma unroll
                for (int kk = 0; kk < NKK; ++kk) kf0[kk] = *(const bf16x8*)(kb_ + kk * 16);
#pragma unroll
                for (int kk = 0; kk < NKK; ++kk) kf1[kk] = *(const bf16x8*)(kb_ + 32 * KS + kk * 16);
                __builtin_amdgcn_sched_barrier(0);
#pragma unroll
                for (int i = 0; i < 16; ++i) { s[0][i] = 0.f; s[1][i] = 0.f; }
#pragma unroll
                for (int kk = 0; kk < NKK; ++kk) s[0] = __builtin_amdgcn_mfma_f32_32x32x16_bf16(kf0[kk], qf[kk], s[0], 0, 0, 0);
#pragma unroll
                for (int kk = 0; kk < NKK; ++kk) s[1] = __builtin_amdgcn_mfma_f32_32x32x16_bf16(kf1[kk], qf[kk], s[1], 0, 0, 0);
                uint2 vfr[2][2][2][2];
#pragma unroll
                for (int kb = 0; kb < 2; ++kb)
#pragma unroll
                    for (int g = 0; g < 2; ++g)
#pragma unroll
                        for (int db = 0; db < 2; ++db) {
                            const bf16_t* vp = vb_ + db * 32 * 72 + kb * 32 + 16 * g;
                            vfr[kb][g][db][0] = *(const uint2*)vp; vfr[kb][g][db][1] = *(const uint2*)(vp + 8);
                        }
                __builtin_amdgcn_sched_barrier(0);
                if (CAUSAL && kt * 64 + 63 > q0) {
#pragma unroll
                    for (int kb = 0; kb < 2; ++kb)
#pragma unroll
                        for (int i = 0; i < 16; ++i) { const int key = kt * 64 + kb * 32 + 8 * (i >> 2) + 4 * half + (i & 3); if (key > q) s[kb][i] = -1e30f; }
                }
                float mx = s[0][0];
#pragma unroll
                for (int kb = 0; kb < 2; ++kb)
#pragma unroll
                    for (int i = 0; i < 16; ++i) mx = fmaxf(mx, s[kb][i]);
                mx = fmaxf(mx, __int_as_float(__builtin_amdgcn_ds_bpermute(xaddr, __float_as_int(mx))));
                const float mn = fmaxf(m, mx), alpha = __builtin_amdgcn_exp2f((m - mn) * scl), mc = mn * scl;
                m = mn;
                f32x2 ls2 = {0.f, 0.f};
                const f32x2 scl2 = {scl, scl}, nmc2 = {-mc, -mc};
#pragma unroll
                for (int kb = 0; kb < 2; ++kb)
#pragma unroll
                    for (int i = 0; i < 16; i += 2) {
                        const f32x2 t = __builtin_elementwise_fma((f32x2){s[kb][i], s[kb][i + 1]}, scl2, nmc2);
                        const f32x2 pv = {__builtin_amdgcn_exp2f(t[0]), __builtin_amdgcn_exp2f(t[1])};
                        s[kb][i] = pv[0]; s[kb][i + 1] = pv[1]; ls2 += pv;
                    }
                const float ls = ls2[0] + ls2[1];
                l = l * alpha + ls;
#pragma unroll
                for (int a = 0; a < 2; ++a)
#pragma unroll
                    for (int i = 0; i < 16; ++i) o[a][i] *= alpha;
#pragma unroll
                for (int kb = 0; kb < 2; ++kb)
#pragma unroll
                    for (int g = 0; g < 2; ++g) {
                        u32x4 pu;
#pragma unroll
                        for (int j = 0; j < 4; ++j) pu[j] = pk2(s[kb][8 * g + 2 * j], s[kb][8 * g + 2 * j + 1]);
                        const bf16x8 pf = __builtin_bit_cast(bf16x8, pu);
#pragma unroll
                        for (int db = 0; db < 2; ++db) {
                            u32x4 vu; vu[0] = vfr[kb][g][db][0].x; vu[1] = vfr[kb][g][db][0].y; vu[2] = vfr[kb][g][db][1].x; vu[3] = vfr[kb][g][db][1].y;
                            o[db] = __builtin_amdgcn_mfma_f32_32x32x16_bf16(__builtin_bit_cast(bf16x8, vu), pf, o[db], 0, 0, 0);
                        }
                    }
            }
            if (kt + 1 < ntiles) {
                bf16_t* dk = sK + (buf ^ 1) * 64 * KS; bf16_t* dv = sV + (buf ^ 1) * 64 * 72;
#pragma unroll
                for (int i = 0; i < NKL; ++i) { const int c = tid + NT * i; if (c < NCH) *(u32x4*)(dk + (c / KCH) * KS + (c % KCH) * 8) = rk[i]; }
                *(u32x4*)(dv + (tid >> 3) * 72 + (tid & 7) * 8) = rv[0];
            }
            __syncthreads();
        }
        l += __int_as_float(__builtin_amdgcn_ds_bpermute(xaddr, __float_as_int(l)));
        const float inv = 1.f / l;
        bf16_t* op = O + tokq * ldo + ocol0 + h * 64 + 4 * half;
#pragma unroll
        for (int db = 0; db < 2; ++db)
#pragma unroll
            for (int g = 0; g < 4; ++g) {
                uint2 w; w.x = pk2(o[db][4 * g] * inv, o[db][4 * g + 1] * inv); w.y = pk2(o[db][4 * g + 2] * inv, o[db][4 * g + 3] * inv);
                *(uint2*)(op + db * 32 + 8 * g) = w;
            }
    }
    rot = (rot + 8 * (upx % GL)) % G;
}

__device__ void lora_in_phase(const Params& p, int layer) {
#ifdef NO_LIN
    return;
#endif

    const bf16_t* P = (const bf16_t*)(p.ws + WS_P); bf16_t* LIN = (bf16_t*)(p.ws + WS_LIN);
    const float* mu = p.in[6] + (size_t)layer * 2560 + 2304;
    const int tid_ = opaque_tid(), lane = tid_ & 63, gw = blockIdx.x * NWV + (tid_ >> 6), nw = gridDim.x * NWV;
    const float4 m4 = *(const float4*)(mu + lane * 4);
    for (int tok = gw; tok < T; tok += nw) {
        const int s = tok & (S - 1);
        const uint2 c = *(const uint2*)(P + (size_t)tok * LDP + 2304 + lane * 4);
        uint2 pv; pv.x = 0; pv.y = 0;
        if (s) pv = *(const uint2*)(P + (size_t)(tok - 1) * LDP + 2304 + lane * 4);
        float v0 = bflo(c.x), v1 = bfhi(c.x), v2 = bflo(c.y), v3 = bfhi(c.y);
        v0 += (bflo(pv.x) - v0) * m4.x; v1 += (bfhi(pv.x) - v1) * m4.y; v2 += (bflo(pv.y) - v2) * m4.z; v3 += (bfhi(pv.y) - v3) * m4.w;
        if (lane < 16) { v0 = tanhf(v0); v1 = tanhf(v1); v2 = tanhf(v2); v3 = tanhf(v3); }
        else if (lane >= 32) { v0 = sigmoidf_(v0); v1 = sigmoidf_(v1); v2 = sigmoidf_(v2); v3 = sigmoidf_(v3); }
        uint2 w; w.x = pk2(v0, v1); w.y = pk2(v2, v3);
        *(uint2*)(LIN + (size_t)tok * 320 + lane * 4) = w;
        if (layer == 1) {
            float vd = 0.f;
            if (lane < 32) { vd = bf2f(P[(size_t)tok * LDP + 2816 + lane]); if (s) vd += bf2f(P[(size_t)(tok - 1) * LDP + 2848 + lane]); }
            LIN[(size_t)tok * 320 + 256 + lane] = f2bf(vd);
        }
    }
}

__device__ void prep_phase(const Params& p, int layer) {
#ifdef NO_PREP
    return;
#endif

    bf16_t* P = (bf16_t*)(p.ws + WS_P);
    bf16_t* Z2 = (bf16_t*)(p.ws + WS_Z + ZSZ);
    bf16_t* Z3 = (bf16_t*)(p.ws + WS_Z + 2 * ZSZ);
    bf16_t* Z4 = (bf16_t*)(p.ws + WS_Z + 3 * ZSZ);
    const bf16_t* HALO = (const bf16_t*)(p.ws + WS_HALO);
    float* RK = (float*)(p.ws + WS_RK);
    const float* mu = p.in[6] + (size_t)layer * 2560;
    const float* kkw = p.in[12] + (size_t)layer * 768; const float* kaw = p.in[13] + (size_t)layer * 768; const float* rkw = p.in[14] + (size_t)layer * 768;
    const int tid = opaque_tid(), tokl = tid >> 4, cg4 = (tid & 15) * 4;
    for (int u = blockIdx.x; u < 256 * 12; u += gridDim.x) {
        const int mt = u / 12, h = u - mt * 12, m0 = mt * 128, hc = h * 64 + cg4;
        const float4 mur = *(const float4*)(mu + hc), muk = *(const float4*)(mu + 768 + hc), muv = *(const float4*)(mu + 1536 + hc);
        const float4 kkw4 = *(const float4*)(kkw + hc), kaw4 = *(const float4*)(kaw + hc), rkw4 = *(const float4*)(rkw + hc);
        for (int it = 3; it >= 0; --it) {
            const int tok = m0 + it * 32 + tokl, s = tok & (S - 1);
            bf16_t* pr = P + (size_t)tok * LDP + hc;
            const uint2 cr = *(const uint2*)pr, ck = *(const uint2*)(pr + 768), cv = *(const uint2*)(pr + 1536);
            uint2 qr, qk, qv; qr.x = qr.y = qk.x = qk.y = qv.x = qv.y = 0;
            if (s) {
                const bf16_t* pp = (it == 0 && tokl == 0) ? (HALO + (size_t)(mt - 1) * LDP + hc) : (P + (size_t)(tok - 1) * LDP + hc);
                qr = *(const uint2*)pp; qk = *(const uint2*)(pp + 768); qv = *(const uint2*)(pp + 1536);
            }
            const size_t zi = (size_t)tok * 768 + hc;
            const uint2 lr2 = *(const uint2*)(Z2 + zi);
            uint2 vs2, vf2; vs2.x = vs2.y = vf2.x = vf2.y = 0;
            if (layer == 1) { vs2 = *(const uint2*)(Z3 + zi); vf2 = *(const uint2*)(Z4 + zi); }
            __syncthreads();
            float r[4] = {bflo(cr.x), bfhi(cr.x), bflo(cr.y), bfhi(cr.y)}, k[4] = {bflo(ck.x), bfhi(ck.x), bflo(ck.y), bfhi(ck.y)}, v[4] = {bflo(cv.x), bfhi(cv.x), bflo(cv.y), bfhi(cv.y)};
            const float rp[4] = {bflo(qr.x), bfhi(qr.x), bflo(qr.y), bfhi(qr.y)}, kp[4] = {bflo(qk.x), bfhi(qk.x), bflo(qk.y), bfhi(qk.y)}, vp[4] = {bflo(qv.x), bfhi(qv.x), bflo(qv.y), bfhi(qv.y)};
            const float mr[4] = {mur.x, mur.y, mur.z, mur.w}, mk[4] = {muk.x, muk.y, muk.z, muk.w}, mv[4] = {muv.x, muv.y, muv.z, muv.w};
            const float lr[4] = {bflo(lr2.x), bfhi(lr2.x), bflo(lr2.y), bfhi(lr2.y)};
            const float vs[4] = {bflo(vs2.x), bfhi(vs2.x), bflo(vs2.y), bfhi(vs2.y)}, vf[4] = {bflo(vf2.x), bfhi(vf2.x), bflo(vf2.y), bfhi(vf2.y)};
            const float kkw_[4] = {kkw4.x, kkw4.y, kkw4.z, kkw4.w}, kaw_[4] = {kaw4.x, kaw4.y, kaw4.z, kaw4.w}, rkw_[4] = {rkw4.x, rkw4.y, rkw4.z, rkw4.w};
            float kk[4], n2 = 0.f, rks = 0.f, bb[4];
#pragma unroll
            for (int j = 0; j < 4; ++j) {
                r[j] += (rp[j] - r[j]) * mr[j]; k[j] += (kp[j] - k[j]) * mk[j]; v[j] += (vp[j] - v[j]) * mv[j];
                if (layer == 1) v[j] += (vf[j] - v[j]) * vs[j];
                kk[j] = k[j] * kkw_[j]; n2 += kk[j] * kk[j];
                k[j] = k[j] * (1.f + (lr[j] - 1.f) * kaw_[j]);
                rks += r[j] * k[j] * rkw_[j];
            }
            n2 = reduce16(n2); rks = reduce16(rks);
            const float inv = 1.f / fmaxf(sqrtf(n2), 1e-12f);
#pragma unroll
            for (int j = 0; j < 4; ++j) { kk[j] *= inv; bb[j] = kk[j] * lr[j]; }
            uint2 w;
            w.x = pk2(r[0], r[1]); w.y = pk2(r[2], r[3]); *(uint2*)pr = w;
            w.x = pk2(k[0], k[1]); w.y = pk2(k[2], k[3]); *(uint2*)(pr + 768) = w;
            w.x = pk2(v[0], v[1]); w.y = pk2(v[2], v[3]); *(uint2*)(pr + 1536) = w;
            if (layer == 0) *(uint2*)(Z4 + zi) = w;
            w.x = pk2(bb[0], bb[1]); w.y = pk2(bb[2], bb[3]); *(uint2*)(Z2 + zi) = w;
            w.x = pk2(kk[0], kk[1]); w.y = pk2(kk[2], kk[3]); *(uint2*)(Z3 + zi) = w;
            if ((tid & 15) == 0) RK[(size_t)tok * 12 + h] = rks;
        }
        __syncthreads();
    }
}

__device__ void scan_phase(const Params& p, char* smem) {
#ifdef NO_SCAN
    return;
#endif
    const bf16_t* P = (const bf16_t*)(p.ws + WS_P);
    const _Float16* E = (const _Float16*)(p.ws + WS_Z);
    const bf16_t* Bv = (const bf16_t*)(p.ws + WS_Z + ZSZ);
    const bf16_t* KK = (const bf16_t*)(p.ws + WS_Z + 2 * ZSZ);
    bf16_t* Y = (bf16_t*)(p.ws + WS_H);
    constexpr int BUFF = 11264;
    float* sBase = (float*)smem; float* sYp = sBase + 2 * BUFF;
    const int tid = opaque_tid(), lane = tid & 63, wave = tid >> 6;
    const bool comp = wave < 4;
    const int row = (wave & 3) * 4 + (lane >> 4), kg = lane & 15;
    const int stid = tid & 255, st_l = stid >> 3, c8 = (stid & 7) * 8;
    for (int u = blockIdx.x; u < 192; u += gridDim.x) {
        const int b = u / 48, h = (u % 48) >> 2, qt = u & 3;
        const size_t tok0 = (size_t)b * S;
        f32x2 S01 = {0.f, 0.f}, S23 = {0.f, 0.f};
        u32x4 gr, gk, ga, gb, gv = {0u, 0u, 0u, 0u}; h8 ge;
        auto gload = [&](int ch) {
            const size_t tok = tok0 + ch * 32 + st_l;
            gr = *(const u32x4*)(P + tok * LDP + h * 64 + c8);
            gk = *(const u32x4*)(P + tok * LDP + 768 + h * 64 + c8);
            ga = *(const u32x4*)(KK + tok * 768 + h * 64 + c8);
            gb = *(const u32x4*)(Bv + tok * 768 + h * 64 + c8);
            ge = *(const h8*)(E + tok * 768 + h * 64 + c8);
            if (stid < 64) { const size_t tk = tok0 + ch * 32 + (stid >> 1); gv = *(const u32x4*)(P + tk * LDP + 1536 + h * 64 + qt * 16 + (stid & 1) * 8); }
        };
        auto st4 = [&](float* dst, const u32x4& g) {
            f32x4 a, c; a[0] = bflo(g[0]); a[1] = bfhi(g[0]); a[2] = bflo(g[1]); a[3] = bfhi(g[1]); c[0] = bflo(g[2]); c[1] = bfhi(g[2]); c[2] = bflo(g[3]); c[3] = bfhi(g[3]);
            *(f32x4*)dst = a; *(f32x4*)(dst + 4) = c;
        };
        auto stage = [&](float* buf) {
            const int o = st_l * 64 + c8;
            st4(buf + 8192 + o, gr); st4(buf + 2048 + o, gk); st4(buf + 4096 + o, ga); st4(buf + 6144 + o, gb);
            f32x4 a, c; a[0] = __expf(-(float)ge[0]); a[1] = __expf(-(float)ge[1]); a[2] = __expf(-(float)ge[2]); a[3] = __expf(-(float)ge[3]);
            c[0] = __expf(-(float)ge[4]); c[1] = __expf(-(float)ge[5]); c[2] = __expf(-(float)ge[6]); c[3] = __expf(-(float)ge[7]);
            *(f32x4*)(buf + o) = a; *(f32x4*)(buf + o + 4) = c;
            if (stid < 64) st4(buf + 10240 + (stid >> 1) * 16 + (stid & 1) * 8, gv);
        };
        auto flush = [&](const float* buf, int ch) {
            if (stid < 64) {
                const float* yp = buf + 10752 + (stid >> 1) * 16 + (stid & 1) * 8;
                const f32x4 a = *(const f32x4*)yp, c = *(const f32x4*)(yp + 4);
                u32x4 w; w[0] = pk2(a[0], a[1]); w[1] = pk2(a[2], a[3]); w[2] = pk2(c[0], c[1]); w[3] = pk2(c[2], c[3]);
                *(u32x4*)(Y + (tok0 + ch * 32 + (stid >> 1)) * 1024 + h * 64 + qt * 16 + (stid & 1) * 8) = w;
            }
        };
        if (!comp) { gload(0); stage(sBase); gload(1); }
        __syncthreads();
        for (int ch = 0; ch < 256; ++ch) {
            float* bufc = sBase + (ch & 1) * BUFF; float* bufo = sBase + ((ch & 1) ^ 1) * BUFF;
            if (comp) {
                float* sY = bufc + 10752;
                unsigned a_cur = (unsigned)(size_t)(LAS char*)(bufc + kg * 4), v_cur = (unsigned)(size_t)(LAS char*)(bufc + 10240 + row);
                f32x4 w0, k0, a0, b0, r0, w1, k1, a1, b1, r1, w2, k2, a2, b2, r2, w3, k3, a3, b3, r3; float v0, v1, v2, v3;
#define SCAN_LOAD(W, K, A, B, R, V, AD, VD) asm volatile("ds_read_b128 %0, %6\n\tds_read_b128 %1, %6 offset:8192\n\tds_read_b128 %2, %6 offset:16384\n\tds_read_b128 %3, %6 offset:24576\n\tds_read_b128 %4, %6 offset:32768\n\tds_read_b32 %5, %7" \
                    : "=&v"(W), "=&v"(K), "=&v"(A), "=&v"(B), "=&v"(R), "=&v"(V) : "v"(AD), "v"(VD) : "memory")
#define SCAN_WAIT(W, K, A, B, R, V, DEP) asm volatile("s_waitcnt lgkmcnt(6)" : "+v"(W), "+v"(K), "+v"(A), "+v"(B), "+v"(R), "+v"(V), "+v"(DEP) :: "memory")
#define SCAN_WAIT0(W, K, A, B, R, V, DEP) asm volatile("s_waitcnt lgkmcnt(0)" : "+v"(W), "+v"(K), "+v"(A), "+v"(B), "+v"(R), "+v"(V), "+v"(DEP) :: "memory")
#define SCAN_STEP(W, K, A, B, R, V, YV) { \
                    f32x2 t = S01 * (f32x2){A[0], A[1]}; t = __builtin_elementwise_fma(S23, (f32x2){A[2], A[3]}, t); \
                    const float d = reduce16(t[0] + t[1]); const f32x2 sa2 = {-d, -d}, v2_ = {V, V}; \
                    const f32x2 u01 = __builtin_elementwise_fma(sa2, (f32x2){B[0], B[1]}, v2_ * (f32x2){K[0], K[1]}); \
                    const f32x2 u23 = __builtin_elementwise_fma(sa2, (f32x2){B[2], B[3]}, v2_ * (f32x2){K[2], K[3]}); \
                    S01 = __builtin_elementwise_fma(S01, (f32x2){W[0], W[1]}, u01); S23 = __builtin_elementwise_fma(S23, (f32x2){W[2], W[3]}, u23); \
                    f32x2 y2 = S01 * (f32x2){R[0], R[1]}; y2 = __builtin_elementwise_fma(S23, (f32x2){R[2], R[3]}, y2); \
                    YV = y2[0] + y2[1]; }
                SCAN_LOAD(w0, k0, a0, b0, r0, v0, a_cur, v_cur);
                { const unsigned an = a_cur + 256, vn = v_cur + 64; SCAN_LOAD(w1, k1, a1, b1, r1, v1, an, vn); }
                float yv = 0.f;
                float* ypw = sYp + row * 16 + kg;
#pragma unroll 1
                for (int q = 0; q < 8; ++q) {
                    const int sb = (q & 3) * 4;
                    SCAN_WAIT(w0, k0, a0, b0, r0, v0, yv);
                    { const unsigned an = a_cur + 512, vn = v_cur + 128; SCAN_LOAD(w2, k2, a2, b2, r2, v2, an, vn); }
                    SCAN_STEP(w0, k0, a0, b0, r0, v0, yv)
                    ypw[sb * 256] = yv;
                    SCAN_WAIT(w1, k1, a1, b1, r1, v1, yv);
                    { const unsigned an = a_cur + 768, vn = v_cur + 192; SCAN_LOAD(w3, k3, a3, b3, r3, v3, an, vn); }
                    SCAN_STEP(w1, k1, a1, b1, r1, v1, yv)
                    ypw[(sb + 1) * 256] = yv;
                    SCAN_WAIT(w2, k2, a2, b2, r2, v2, yv);
                    a_cur += 1024; v_cur += 256;
                    SCAN_LOAD(w0, k0, a0, b0, r0, v0, a_cur, v_cur);
                    SCAN_STEP(w2, k2, a2, b2, r2, v2, yv)
                    ypw[(sb + 2) * 256] = yv;
                    SCAN_WAIT(w3, k3, a3, b3, r3, v3, yv);
                    { const unsigned an = a_cur + 256, vn = v_cur + 64; SCAN_LOAD(w1, k1, a1, b1, r1, v1, an, vn); }
                    SCAN_STEP(w3, k3, a3, b3, r3, v3, yv)
                    ypw[(sb + 3) * 256] = yv;
                    if ((q & 3) == 3) {
                        const int hh = q >> 2, stp = lane >> 2, rw_ = (wave & 3) * 4 + (lane & 3);
                        const f32x4* pp = (const f32x4*)(sYp + stp * 256 + rw_ * 16);
                        const f32x4 q0 = pp[0], q1 = pp[1], q2 = pp[2], q3 = pp[3];
                        const float ysum = ((q0[0] + q0[1]) + (q0[2] + q0[3])) + ((q1[0] + q1[1]) + (q1[2] + q1[3])) + ((q2[0] + q2[1]) + (q2[2] + q2[3])) + ((q3[0] + q3[1]) + (q3[2] + q3[3]));
                        sY[(hh * 16 + stp) * 16 + rw_] = ysum;
                    }
                }
                SCAN_WAIT0(w0, k0, a0, b0, r0, v0, yv);
                SCAN_WAIT0(w1, k1, a1, b1, r1, v1, yv);
#undef SCAN_WAIT0
#undef SCAN_LOAD
#undef SCAN_WAIT
#undef SCAN_STEP
            } else {
                if (ch > 0) flush(bufo, ch - 1);
                if (ch + 1 < 256) { stage(bufo); if (ch + 2 < 256) gload(ch + 2); }
            }
            __syncthreads();
        }
        if (!comp) flush(sBase + BUFF, 255);
        __syncthreads();
    }
}

__device__ void post_phase(const Params& p, int layer) {
#ifdef NO_POST
    return;
#endif

    bf16_t* H = (bf16_t*)(p.ws + WS_H); const bf16_t* P = (const bf16_t*)(p.ws + WS_P); const float* RK = (const float*)(p.ws + WS_RK);
    const float* lg = p.in[15] + (size_t)layer * 768; const float* lb = p.in[16] + (size_t)layer * 768;
    const int tid = opaque_tid(), cg4 = (tid & 15) * 4;
    const int npairs = T * 12;
    for (int pr = blockIdx.x * (NT / 16) + (tid >> 4); pr < npairs; pr += gridDim.x * (NT / 16)) {
        const int tok = pr / 12, h = pr - tok * 12, hc = h * 64 + cg4;
        bf16_t* yp = H + (size_t)tok * 1024 + hc;
        const uint2 y2 = *(const uint2*)yp, v2 = *(const uint2*)(P + (size_t)tok * LDP + 1536 + hc);
        const float y[4] = {bflo(y2.x), bfhi(y2.x), bflo(y2.y), bfhi(y2.y)}, v[4] = {bflo(v2.x), bfhi(v2.x), bflo(v2.y), bfhi(v2.y)};
        const float mean = reduce16((y[0] + y[1]) + (y[2] + y[3])) * (1.f / 64.f);
        float q = 0.f;
#pragma unroll
        for (int j = 0; j < 4; ++j) { const float d = y[j] - mean; q += d * d; }
        const float rstd = rsqrtf(reduce16(q) * (1.f / 64.f) + 64e-5f);
        const float rk = RK[(size_t)tok * 12 + h];
        const float4 g4 = *(const float4*)(lg + hc), b4 = *(const float4*)(lb + hc);
        const float g[4] = {g4.x, g4.y, g4.z, g4.w}, bb[4] = {b4.x, b4.y, b4.z, b4.w};
        float o[4];
#pragma unroll
        for (int j = 0; j < 4; ++j) o[j] = (y[j] - mean) * rstd * g[j] + bb[j] + rk * v[j];
        uint2 w; w.x = pk2(o[0], o[1]); w.y = pk2(o[2], o[3]);
        *(uint2*)yp = w;
    }
}

__device__ void subnorm_phase(const Params& p, int j) {
#ifdef NO_SUB
    return;
#endif

    const bf16_t* PB = (const bf16_t*)(p.ws + WS_PROJB); bf16_t* CQ = (bf16_t*)(p.ws + WS_CQ);
    const float* CKR = (const float*)(p.ws + WS_CKR); bf16_t* CKV = (bf16_t*)(p.ws + WS_CKV); bf16_t* KF = (bf16_t*)(p.ws + WS_KFULL);
    const float* rope = (const float*)(p.ws + WS_ROPE);
    const float* gq = p.in[32] + (size_t)j * 512; const float* gl = p.in[28];
    const int tid_ = opaque_tid(), lane = tid_ & 63, gw = blockIdx.x * NWV + (tid_ >> 6), nw = gridDim.x * NWV;
    for (int tok = gw; tok < T; tok += nw) {
        {
            const uint4 c = *(const uint4*)(PB + (size_t)tok * 768 + lane * 8);
            float v[8] = {bflo(c.x), bfhi(c.x), bflo(c.y), bfhi(c.y), bflo(c.z), bfhi(c.z), bflo(c.w), bfhi(c.w)};
            float ss = 0.f;
#pragma unroll
            for (int i = 0; i < 8; ++i) ss += v[i] * v[i];
            ss = wave_sum(ss);
            const float rs = rsqrtf(ss * (1.f / 512.f) + 1e-6f);
            const float4 g0 = *(const float4*)(gq + lane * 8), g1 = *(const float4*)(gq + lane * 8 + 4);
            uint4 w; w.x = pk2(v[0] * rs * g0.x, v[1] * rs * g0.y); w.y = pk2(v[2] * rs * g0.z, v[3] * rs * g0.w);
            w.z = pk2(v[4] * rs * g1.x, v[5] * rs * g1.y); w.w = pk2(v[6] * rs * g1.z, v[7] * rs * g1.w);
            *(uint4*)(CQ + (size_t)tok * 512 + lane * 8) = w;
        }
        if (j == 0) {
            const float4 c = *(const float4*)(CKR + (size_t)tok * 384 + lane * 4);
            float ss = c.x * c.x + c.y * c.y + c.z * c.z + c.w * c.w;
            ss = wave_sum(ss);
            const float rs = rsqrtf(ss * (1.f / 256.f) + 1e-6f);
            const float4 g = *(const float4*)(gl + lane * 4);
            uint2 w; w.x = pk2(c.x * rs * g.x, c.y * rs * g.y); w.y = pk2(c.z * rs * g.z, c.w * rs * g.w);
            *(uint2*)(CKV + (size_t)tok * 256 + lane * 4) = w;
            const int i = lane & 15, hg = lane >> 4;
            const float x1 = CKR[(size_t)tok * 384 + 256 + i], x2 = CKR[(size_t)tok * 384 + 272 + i];
            const float cs = rope[(size_t)tok * 32 + i], sn = rope[(size_t)tok * 32 + 16 + i];
            const bf16_t o1 = f2bf(x1 * cs - x2 * sn), o2 = f2bf(x2 * cs + x1 * sn);
            const int b = tok >> 13, s = tok & (S - 1);
#pragma unroll
            for (int hh = 0; hh < 3; ++hh) {
                bf16_t* kp = KF + ((size_t)(b * 12 + hg * 3 + hh) * S + s) * 96 + 64 + i;
                kp[0] = o1; kp[16] = o2;
            }
        }
    }
}

__device__ void rope_phase(const Params& p) {
    const int* pos = (const int*)p.in[2]; float* rope = (float*)(p.ws + WS_ROPE);
    const int tid_ = opaque_tid();
    for (int idx = blockIdx.x * NT + tid_; idx < T * 16; idx += gridDim.x * NT) {
        const int tok = idx >> 4, i = idx & 15;
        const float invf = powf(10000.f, -(float)i / 16.f);
        const float ang = (float)pos[tok] * invf;
        rope[(size_t)tok * 32 + i] = cosf(ang); rope[(size_t)tok * 32 + 16 + i] = sinf(ang);
    }
}

__device__ bool get_gemm_job(const Params& p, int ph, int jn, GemmJob& g) {
    char* ws = p.ws;
    bf16_t* WA = (bf16_t*)(ws + WS_WA); bf16_t* WF = (bf16_t*)(ws + WS_WF); bf16_t* H = (bf16_t*)(ws + WS_H); bf16_t* P = (bf16_t*)(ws + WS_P);
    bf16_t* LIN = (bf16_t*)(ws + WS_LIN); bf16_t* KMEM = (bf16_t*)(ws + WS_KMEM); bf16_t* VTMEM = (bf16_t*)(ws + WS_VTMEM); bf16_t* MEMN = (bf16_t*)(ws + WS_MEMN);
    g.M = T; g.e.o1 = nullptr; g.e.bias = nullptr; g.e.resid = nullptr; g.e.halo = nullptr; g.e.ldc = 0;
    const bool rw = ph < 25;
    const int L = rw ? (ph - 1) / 12 : 2 + (ph - 25) / 9, r = rw ? (ph - 1) % 12 : (ph - 25) % 9;
    const int r_wout = rw ? 8 : 5, r_gu = rw ? 10 : 7, r_down = rw ? 11 : 8;
    if (r == r_wout) { if (jn) return false; g.A = H; g.lda = 1024; g.W = WA + (rw ? A_WOUT : B_WOUT); g.K = 1024; g.N = 1024; g.kind = E_RESID; g.e.o0 = p.out; g.e.resid = (L == 0) ? p.in[0] : p.out; g.e.ldc = 1024; return true; }
    if (r == r_gu) { if (jn) return false; g.A = H; g.lda = 1024; g.W = WF + F_GU; g.K = 1024; g.N = 5632; g.kind = E_SWIGLU; g.e.o0 = P; g.e.ldc = 2816; return true; }
    if (r == r_down) { if (jn) return false; g.A = P; g.lda = 2816; g.W = WF + F_DOWN; g.K = 2816; g.N = 1024; g.kind = E_RESID; g.e.o0 = p.out; g.e.resid = p.out; g.e.ldc = 1024; return true; }
    if (r == 1 && jn == 1) { g.A = MEMN; g.lda = 1024; g.W = WA + (rw ? A_MKV : B_MKV); g.K = 1024; g.M = 1024; g.N = 512; g.kind = E_MEMKV; g.e.o0 = KMEM; g.e.o1 = VTMEM; return true; }
    if (rw) {
        const int i = L;
        if (r == 1 && jn == 0) { g.A = H; g.lda = 1024; g.W = WA + A_WIN; g.K = 1024; g.N = (i == 1) ? 2944 : 2816; g.kind = E_BF16; g.e.o0 = P; g.e.ldc = LDP; g.e.halo = (bf16_t*)(ws + WS_HALO); return true; }
        if (r == 3) {
            if (jn == 0) { g.A = LIN; g.lda = 320; g.W = WA + A_DEC; g.K = 64; g.N = 768; g.kind = E_DECAY; g.e.o0 = ws + WS_Z; g.e.bias = p.in[8] + (size_t)i * 768; g.e.ldc = 768; return true; }
            if (jn == 1) { g.A = LIN + 64; g.lda = 320; g.W = WA + A_AAA; g.K = 64; g.N = 768; g.kind = E_SIGB; g.e.o0 = ws + WS_Z + ZSZ; g.e.bias = p.in[10] + (size_t)i * 768; g.e.ldc = 768; return true; }
            if (jn == 2 && i == 1) { g.A = LIN + 256; g.lda = 320; g.W = WA + A_VUP; g.K = 64; g.N = 768; g.kind = E_SIGB; g.e.o0 = ws + WS_Z + 2 * ZSZ; g.e.bias = p.in[25]; g.e.ldc = 768; return true; }
            return false;
        }
        if (r == 7 && jn == 0) { g.A = LIN + 128; g.lda = 320; g.W = WA + A_GATE; g.K = 128; g.N = 768; g.kind = E_MULG; g.e.o0 = H; g.e.ldc = 1024; return true; }
        return false;
    }
    const int j = L - 2;
    if (r == 1) {
        if (jn == 0) { g.A = H; g.lda = 1024; g.W = WA + B_WIN; g.K = 1024; g.N = 768; g.kind = E_BF16; g.e.o0 = ws + WS_PROJB; g.e.ldc = 768; return true; }
        if (jn == 2 && j == 0) { g.A = (bf16_t*)(ws + WS_QFULL); g.lda = 1024; g.W = WA + B_KVD; g.K = 1024; g.N = 384; g.kind = E_F32; g.e.o0 = ws + WS_CKR; g.e.ldc = 384; return true; }
        return false;
    }
    if (r == 3) {
        if (jn == 0) { g.A = (bf16_t*)(ws + WS_CQ); g.lda = 512; g.W = WA + B_QUP; g.K = 512; g.N = 1152; g.kind = E_BF16; g.e.o0 = ws + WS_QFULL; g.e.ldc = 1152; return true; }
        if (jn == 1 && j == 0) { g.A = (bf16_t*)(ws + WS_CKV); g.lda = 256; g.W = WA + B_KVU; g.K = 256; g.N = 1536; g.kind = E_KV; g.e.o0 = ws + WS_KFULL; g.e.o1 = ws + WS_VT; return true; }
        return false;
    }
    return false;
}

__device__ void run_phase(const Params& p, int ph, char* smem) {
    char* ws = p.ws;
    bf16_t* H = (bf16_t*)(ws + WS_H);
    const float MEMSCL = 0.125f * 1.4426950408889634f, MLASCL = 0.10206207261596575f * 1.4426950408889634f;
    int rot = 0;
    const bool rw = ph >= 1 && ph < 25, mla = ph >= 25 && ph < 43;
    const int L = rw ? (ph - 1) / 12 : (mla ? 2 + (ph - 25) / 9 : 0), r = rw ? (ph - 1) % 12 : (mla ? (ph - 25) % 9 : -1);
    {
        const float* x = nullptr; int nrows = T; const float* g1 = nullptr; bf16_t* o1 = H; const float* g2 = nullptr; bf16_t* o2 = nullptr; float* of = nullptr;
        if (ph == 0) { x = p.in[1]; nrows = 1024; g1 = p.in[3]; o1 = (bf16_t*)(ws + WS_MEMN); }
        else if (ph == 43) { x = p.out; g1 = p.in[39]; of = p.out; }
        else if (rw && r == 0) { x = (L == 0) ? p.in[0] : p.out; g1 = p.in[4] + (size_t)L * 1024; }
        else if (rw && r == 9) { x = p.out; g1 = p.in[19] + (size_t)L * 1024; }
        else if (mla && r == 0) { x = p.out; g1 = p.in[30] + (size_t)(L - 2) * 1024; if (L == 2) { g2 = p.in[26]; o2 = (bf16_t*)(ws + WS_QFULL); } }
        else if (mla && r == 6) { x = p.out; g1 = p.in[36] + (size_t)(L - 2) * 1024; }
        if (x) rmsnorm_phase(x, nrows, g1, o1, g2, o2, of);
    }
    if (ph == 0) rope_phase(p);
    int cvb = blockIdx.x, cVG = gridDim.x;
    {
        int kind = -1, CL = 0;
        if (ph == 0) { kind = 0; CL = 0; }
        else if ((rw || mla) && r == 0) { kind = 1; CL = L; }
        else if (rw && r == 9) { kind = 0; CL = L + 1; }
        else if (mla && r == 6 && L == 2) { kind = 0; CL = 3; }
        const int GG = gridDim.x; const bool split = false;

        if (split && GG == 512) { const int b_ = blockIdx.x; cvb = (b_ >= 192 && b_ < 256) ? b_ - 192 : (b_ >= 448 ? b_ - 384 : -1); cVG = 128; }
        else { cvb = split ? (int)blockIdx.x - 192 : (int)blockIdx.x; cVG = split ? GG - 192 : GG; }
        if (kind >= 0 && cvb >= 0) { ConvJob c; for (int idx = 0; get_conv_job(p, kind, CL, idx, c); ++idx) run_conv(c, rot, smem, cvb, cVG); }
    }
    { GemmJob g; for (int jn = 0; jn < 3; ++jn) if (get_gemm_job(p, ph, jn, g)) { gemm_job(g, rot, smem); } }
    if ((rw || mla) && r == 3) {
        const bf16_t* Q = rw ? (const bf16_t*)(ws + WS_P) : (const bf16_t*)(ws + WS_PROJB);
        attn_phase<64, false>(Q, rw ? LDP : 768, rw ? 2560 : 512, (const bf16_t*)(ws + WS_KMEM), 256 * 64, (const bf16_t*)(ws + WS_VTMEM), 64 * 256, 256, 4, 256, nullptr, MEMSCL, H, 1024, 768, rot, smem, cvb, cVG);
    }
    if (mla && r == 4)
        attn_phase<96, true>((const bf16_t*)(ws + WS_QFULL), 1152, 0, (const bf16_t*)(ws + WS_KFULL), (size_t)S * 96, (const bf16_t*)(ws + WS_VT), (size_t)64 * S, S, 12, S, (const float*)(ws + WS_ROPE), MLASCL, H, 1024, 0, rot, smem, blockIdx.x, gridDim.x);
    if (rw && r == 2) lora_in_phase(p, L);
    if (rw && r == 4) prep_phase(p, L);
    if (rw && r == 5 && (blockIdx.x < 192 || cVG == (int)gridDim.x)) scan_phase(p, smem);
    if (rw && r == 6) post_phase(p, L);
    if (mla && r == 2) subnorm_phase(p, L - 2);
}

#define XB_TMO      128
#define XB_XCNT(j)  (256  + 64 * (j))
#define XB_XSUB(j)  (1280 + 64 * (j))
#define XB_XGEN(j)  (2304 + 64 * (j))
#define XB_TOP      3328
#define XB_TOPGEN   3392
#define XCD_BAR_WORDS 3456
#define XB_SPIN_CAP (1u << 18)
__device__ __forceinline__ unsigned xb_ld(unsigned* p)              { return __hip_atomic_load(p, __ATOMIC_RELAXED, __HIP_MEMORY_SCOPE_AGENT); }
__device__ __forceinline__ unsigned xb_add(unsigned* p, unsigned v) { return __hip_atomic_fetch_add(p, v, __ATOMIC_RELAXED, __HIP_MEMORY_SCOPE_AGENT); }
__device__ __forceinline__ unsigned xb_xcc_id() { return (unsigned)__builtin_amdgcn_s_getreg((3 << 11) | 20) & 0xFu; }
#define XB_SPIN(cond, bar) do { unsigned _sp = 0; while (cond) { __builtin_amdgcn_s_sleep(1); \
    if ((++_sp & 255u) == 0u) { if (xb_ld(&(bar)[XB_TMO])) break; if (_sp > XB_SPIN_CAP) { atomicAdd(&(bar)[XB_TMO], 1u); break; } } } } while (0)
struct XcdBarrier { unsigned* bar; unsigned x; volatile LAS unsigned* st; };
__device__ __forceinline__ XcdBarrier xcd_barrier_post(unsigned* bar, volatile LAS unsigned* st) {
    XcdBarrier b; b.bar = bar; b.x = xb_xcc_id(); b.st = st;
    if (threadIdx.x == 0) (void)xb_add(&bar[XB_XCNT(b.x)], 1u);
    return b;
}
__device__ __forceinline__ void xcd_barrier_complete(unsigned* bar, unsigned x, unsigned& nloc, unsigned& nx) {
    const unsigned G = gridDim.x * gridDim.y * gridDim.z;
    unsigned sum, cnt, mine, sp = 0u;
    for (;;) {
        sum = 0u; cnt = 0u; mine = 0u;
#pragma unroll
        for (unsigned j = 0; j < 16; ++j) { const unsigned c = xb_ld(&bar[XB_XCNT(j)]); sum += c; cnt += (c > 0u) ? 1u : 0u; mine = (j == x) ? c : mine; }
        if (sum == G) break;
        __builtin_amdgcn_s_sleep(1);
        if ((++sp & 255u) == 0u) { if (xb_ld(&bar[XB_TMO])) break; if (sp > XB_SPIN_CAP) { atomicAdd(&bar[XB_TMO], 1u); break; } }
    }
    nloc = mine > 0u ? mine : 1u; nx = cnt > 0u ? cnt : 1u;
}
__device__ __forceinline__ void xcd_barrier(const XcdBarrier& b) {
    asm volatile("s_waitcnt vmcnt(0)" ::: "memory");
    __syncthreads();
    if (threadIdx.x == 0) {
        unsigned* bar = b.bar;
        __builtin_amdgcn_s_waitcnt(0);
        unsigned nloc = b.st[0], nx = b.st[1];
        if (nloc == 0u) { xcd_barrier_complete(bar, b.x, nloc, nx); b.st[0] = nloc; b.st[1] = nx; }
        const unsigned old = xb_add(&bar[XB_XSUB(b.x)], 1u);
        const unsigned gen = old / nloc;
        if (old + 1u == (gen + 1u) * nloc) {
            __builtin_amdgcn_fence(__ATOMIC_RELEASE, "agent");
            asm volatile("s_waitcnt vmcnt(0)" ::: "memory");
            const unsigned og = xb_add(&bar[XB_TOP], 1u);
            const unsigned tg = og / nx;
            if (og + 1u == (tg + 1u) * nx) xb_add(&bar[XB_TOPGEN], 1u);
            else XB_SPIN(xb_ld(&bar[XB_TOPGEN]) == tg, bar);
            __builtin_amdgcn_fence(__ATOMIC_ACQUIRE, "agent");
            xb_add(&bar[XB_XGEN(b.x)], 1u);
            asm volatile("s_waitcnt vmcnt(0)" ::: "memory");
        } else {
            XB_SPIN(xb_ld(&bar[XB_XGEN(b.x)]) == gen, bar);
            __builtin_amdgcn_fence(__ATOMIC_ACQUIRE, "agent");
            asm volatile("s_waitcnt vmcnt(0)" ::: "memory");
        }
    }
    __syncthreads();
}

__global__ void __launch_bounds__(NT) yoco_mega(Params p) {
    extern __shared__ __attribute__((aligned(16))) char smem[];
    cg::grid_group grid = cg::this_grid();
    volatile LAS unsigned* st = (volatile LAS unsigned*)((LAS char*)smem + LDS_MAIN);
    if (threadIdx.x == 0) { st[0] = 0u; st[1] = 0u; }
    __syncthreads();
    const XcdBarrier xb = xcd_barrier_post((unsigned*)(p.ws + WS_BAR), st);
    if (p.ph_lo < 0) grid.sync();
    for (int ph = p.ph_lo; ph < p.ph_hi; ++ph) {
        int nrep = 1;
#if PROBE_DUP
        {
            const bool rw = ph >= 1 && ph < 25, mla = ph >= 25 && ph < 43;
            const int r = rw ? (ph - 1) % 12 : (mla ? (ph - 25) % 9 : -1);
            if ((PROBE_DUP & 1) && rw && r == 5) nrep = 2;
            if ((PROBE_DUP & 2) && ((rw && r == 10) || (mla && r == 7))) nrep = 2;
            if ((PROBE_DUP & 4) && mla && r == 4) nrep = 2;
            if ((PROBE_DUP & 8) && rw && r == 3) nrep = 2;
            if ((PROBE_DUP & 16) && ((rw && (r == 0 || r == 9)) || (mla && (r == 0 || r == 6)))) nrep = 2;
            if ((PROBE_DUP & 32) && ((rw && r == 2) || (mla && (r == 2 || r == 3)))) nrep = 2;
        }
#endif
        for (int rep = 0; rep < nrep; ++rep) {
            run_phase(p, ph, smem);
            if (rep + 1 < nrep || ph + 1 < p.ph_hi) xcd_barrier(xb);
        }
    }
}

#ifndef PROBE_DUP
#define PROBE_DUP 0
#endif
#ifndef MULTI_LAUNCH
#define MULTI_LAUNCH 0
#endif

extern "C" void kernel_launch(void* const* d_in, const int* in_sizes, int n_in, void* d_out, int out_size, void* d_ws, size_t ws_size, hipStream_t stream) {
    static int grid_blocks = 0;
    if (!grid_blocks) {
        int dev = 0, cus = 0, per_cu = 0;
        hipGetDevice(&dev);
        hipDeviceGetAttribute(&cus, hipDeviceAttributeMultiprocessorCount, dev);
        hipFuncSetAttribute((const void*)yoco_mega, hipFuncAttributeMaxDynamicSharedMemorySize, LDS_BYTES);
        hipOccupancyMaxActiveBlocksPerMultiprocessor(&per_cu, (const void*)yoco_mega, NT, LDS_BYTES);
        if (per_cu < 1) per_cu = 1;
        if (per_cu > 1) per_cu = 1;
        grid_blocks = cus * per_cu;
        if (ws_size < WS_END) fprintf(stderr, "kernel_launch: workspace too small: %zu < %zu\n", ws_size, (size_t)WS_END);
        if (n_in != 40) fprintf(stderr, "kernel_launch: expected 40 inputs, got %d\n", n_in);
    }
    Params p{};
    for (int i = 0; i < 40; ++i) p.in[i] = (const float*)d_in[i];
    p.out = (float*)d_out; p.ws = (char*)d_ws;
#if MULTI_LAUNCH
    for (int ph = 0; ph < 44; ++ph) {
        p.ph_lo = ph; p.ph_hi = ph + 1;
        hipLaunchKernelGGL(yoco_mega, dim3(grid_blocks), dim3(NT), LDS_BYTES, stream, p);
    }
#else
    p.ph_lo = 0; p.ph_hi = 44;
    (void)hipMemsetAsync((char*)d_ws + WS_BAR, 0, 16384, stream);
    void* args[] = {&p};
    hipError_t e = hipLaunchCooperativeKernel((const void*)yoco_mega, dim3(grid_blocks), dim3(NT), args, LDS_BYTES, stream);
    if (e != hipSuccess) fprintf(stderr, "cooperative launch failed: %s (grid %d)\n", hipGetErrorString(e), grid_blocks);
#endif
}
```

```cpp
#include <hip/hip_runtime.h>
#include <hip/hip_cooperative_groups.h>
#include <cstdio>
#include <cstdint>
namespace cg = cooperative_groups;
#define PROBE_DUP 0

typedef unsigned short bf16_t;
typedef short bf16x8 __attribute__((ext_vector_type(8)));
typedef float f32x16 __attribute__((ext_vector_type(16)));
typedef _Float16 h8 __attribute__((ext_vector_type(8)));
typedef unsigned u32x4 __attribute__((ext_vector_type(4)));
typedef float f32x2 __attribute__((ext_vector_type(2)));
typedef unsigned u32x2 __attribute__((ext_vector_type(2)));
#define LAS __attribute__((address_space(3)))
typedef float f32x4 __attribute__((ext_vector_type(4)));

constexpr int T = 32768, S = 8192;
constexpr int LDP = 2944;
constexpr int NT = 512, NWV = 8;
constexpr int LDS_MAIN = 147456;
constexpr int LDS_BYTES = LDS_MAIN + 16;

constexpr size_t WS_WA = 0;
constexpr size_t WS_WF = WS_WA + 10485760;
constexpr size_t WS_H = WS_WF + 17825792;
constexpr size_t WS_P = WS_H + 67108864;
constexpr size_t WS_Z = WS_P + 192937984;
constexpr size_t ZSZ = 50331648;
constexpr size_t WS_LIN = WS_Z + 4 * ZSZ;
constexpr size_t WS_RK = WS_LIN + 20971520;
constexpr size_t WS_ROPE = WS_RK + 1572864;
constexpr size_t WS_KMEM = WS_ROPE + 4194304;
constexpr size_t WS_VTMEM = WS_KMEM + 524288;
constexpr size_t WS_MEMN = WS_VTMEM + 524288;
constexpr size_t WS_HALO = WS_MEMN + 2097152;
constexpr size_t WS_BAR = WS_HALO + 1507328;
constexpr size_t WS_END = WS_BAR + 16384;
constexpr size_t WS_KFULL = WS_Z;
constexpr size_t WS_VT = WS_KFULL + 75497472;
constexpr size_t WS_PROJB = WS_VT + 50331648;
constexpr size_t WS_QFULL = WS_P;
constexpr size_t WS_CQ = WS_QFULL + 75497472;
constexpr size_t WS_CKR = WS_CQ + 33554432;
constexpr size_t WS_CKV = WS_CKR + 50331648;
constexpr size_t A_WIN = 0, A_DEC = 3014656, A_AAA = 3063808, A_GATE = 3112960, A_VUP = 3211264, A_MKV = 3260416, A_WOUT = 3784704;
constexpr size_t B_WIN = 0, B_QUP = 786432, B_MKV = 1376256, B_WOUT = 1900544, B_KVD = 2949120, B_KVU = 3342336;
constexpr size_t F_GU = 0, F_DOWN = 5767168;

struct Params { const float* in[40]; float* out; char* ws; int ph_lo, ph_hi; };

__device__ __forceinline__ bf16_t f2bf(float f) { unsigned u = __float_as_uint(f); u += 0x7fffu + ((u >> 16) & 1u); return (bf16_t)(u >> 16); }
__device__ __forceinline__ unsigned pk2(float lo, float hi) { unsigned r; asm("v_cvt_pk_bf16_f32 %0, %1, %2" : "=v"(r) : "v"(lo), "v"(hi)); return r; }
__device__ __forceinline__ float bflo(unsigned u) { return __uint_as_float(u << 16); }
__device__ __forceinline__ float bfhi(unsigned u) { return __uint_as_float(u & 0xffff0000u); }
__device__ __forceinline__ float bf2f(bf16_t v) { return __uint_as_float((unsigned)v << 16); }
__device__ __forceinline__ float reduce16(float x);
__device__ __forceinline__ float wave_sum(float v) {
    v = reduce16(v);
    const int b = __float_as_int(v);
    return (__int_as_float(__builtin_amdgcn_readlane(b, 0)) + __int_as_float(__builtin_amdgcn_readlane(b, 16))) +
           (__int_as_float(__builtin_amdgcn_readlane(b, 32)) + __int_as_float(__builtin_amdgcn_readlane(b, 48)));
}
template <int CTRL> __device__ __forceinline__ float dppmov(float x) { return __int_as_float(__builtin_amdgcn_update_dpp(0, __float_as_int(x), CTRL, 0xF, 0xF, true)); }
__device__ __forceinline__ float reduce16(float x) {
    x += dppmov<0xB1>(x); x += dppmov<0x4E>(x); x += dppmov<0x141>(x); x += dppmov<0x140>(x); return x;
}
__device__ __forceinline__ int opaque_tid() { int t = threadIdx.x; asm volatile("" : "+v"(t)); return t; }
__device__ __forceinline__ float sigmoidf_(float x) { return __builtin_amdgcn_rcpf(1.f + __expf(-x)); }

__device__ void rmsnorm_phase(const float* x, int nrows, const float* g1, bf16_t* o1, const float* g2, bf16_t* o2, float* of) {
    const int tid_ = opaque_tid(), lane = tid_ & 63, gw = blockIdx.x * NWV + (tid_ >> 6), nw = gridDim.x * NWV;
    for (int row = gw; row < nrows; row += nw) {
        const float4* xr = (const float4*)(x + (size_t)row * 1024);
        float4 v[4]; float ss = 0.f;
#pragma unroll
        for (int i = 0; i < 4; ++i) { v[i] = xr[lane + 64 * i]; ss += v[i].x * v[i].x + v[i].y * v[i].y + v[i].z * v[i].z + v[i].w * v[i].w; }
        ss = wave_sum(ss);
        const float rs = rsqrtf(ss * (1.f / 1024.f) + 1e-6f);
#pragma unroll
        for (int i = 0; i < 4; ++i) {
            const float4 g = ((const float4*)g1)[lane + 64 * i];
            const float a = v[i].x * rs, b = v[i].y * rs, c = v[i].z * rs, d = v[i].w * rs;
            if (of) { float4 o; o.x = a * g.x; o.y = b * g.y; o.z = c * g.z; o.w = d * g.w; ((float4*)(of + (size_t)row * 1024))[lane + 64 * i] = o; }
            else {
                uint2 w; w.x = pk2(a * g.x, b * g.y); w.y = pk2(c * g.z, d * g.w);
                *(uint2*)(o1 + (size_t)row * 1024 + (lane + 64 * i) * 4) = w;
                if (o2) { const float4 h = ((const float4*)g2)[lane + 64 * i]; uint2 w2; w2.x = pk2(a * h.x, b * h.y); w2.y = pk2(c * h.z, d * h.w);
                    *(uint2*)(o2 + (size_t)row * 1024 + (lane + 64 * i) * 4) = w2; }
            }
        }
    }
}

struct ConvJob { const float* src; int ld; int ncols; int kvalid; bf16_t* dst; int dstK; int ngran; int swiglu; const float* rscale; int rsmode; };
__device__ void run_conv(const ConvJob& j, int& rot, char* smem, int vb, int G) {
#ifdef NO_CONV
    return;
#endif

    bf16_t* lds = (bf16_t*)smem;
    const int tid = opaque_tid(), nkt = j.dstK >> 6, units = j.ngran * nkt;
    for (int u = (vb + G - rot) % G; u < units; u += G) {
        const int g = u / nkt, kt = u - g * nkt, k0 = kt * 64;
        int col0 = j.swiglu ? ((g & 1) * 2816 + 32 * (g >> 1)) : 32 * g;
        const bool colok = (col0 + 32 <= j.ncols);
#pragma unroll
        for (int i = 0; i < 4; ++i) {
            const int kr = (tid >> 5) + 16 * i, c = tid & 31, k = k0 + kr;
            float v = 0.f;
            if (colok && k < j.kvalid) {
                v = j.src[(size_t)k * j.ld + col0 + c];
                if (j.rsmode == 1) v *= (1.f - j.rscale[k]); else if (j.rsmode == 2) v *= j.rscale[k];
            }
            lds[c * 72 + kr] = f2bf(v);
        }
        __syncthreads();
        if (tid < 256) { const int c = tid >> 3, kc = (tid & 7) * 8;
          const uint4 w = *(const uint4*)(lds + c * 72 + kc);
          *(uint4*)(j.dst + (size_t)(g * 32 + c) * j.dstK + k0 + kc) = w; }
        __syncthreads();
    }
    rot = (rot + units) % G;
}
__device__ bool get_conv_job(const Params& p, int kind, int L, int idx, ConvJob& c) {
    bf16_t* WA = (bf16_t*)(p.ws + WS_WA); bf16_t* WF = (bf16_t*)(p.ws + WS_WF);
    c.swiglu = 0; c.rscale = nullptr; c.rsmode = 0;
    if (kind == 1) {
        if (idx == 0) { c.src = (L < 2) ? p.in[20] + (size_t)L * 1024 * 5632 : p.in[37] + (size_t)(L - 2) * 1024 * 5632; c.ld = 5632; c.ncols = 5632; c.kvalid = 1024; c.dst = WF + F_GU; c.dstK = 1024; c.ngran = 176; c.swiglu = 1; return true; }
        if (idx == 1) { c.src = (L < 2) ? p.in[21] + (size_t)L * 2816 * 1024 : p.in[38] + (size_t)(L - 2) * 2816 * 1024; c.ld = 1024; c.ncols = 1024; c.kvalid = 2816; c.dst = WF + F_DOWN; c.dstK = 2816; c.ngran = 32; return true; }
        return false;
    }
    if (L < 2) {
        const int i = L;
        switch (idx) {
        case 0: c.src = p.in[5] + (size_t)i * 1024 * 2816; c.ld = 2816; c.ncols = 2816; c.kvalid = 1024; c.dst = WA + A_WIN; c.dstK = 1024; c.ngran = 88; return true;
        case 1: c.src = p.in[7] + (size_t)i * 64 * 768; c.ld = 768; c.ncols = 768; c.kvalid = 64; c.dst = WA + A_DEC; c.dstK = 64; c.ngran = 24; return true;
        case 2: c.src = p.in[9] + (size_t)i * 64 * 768; c.ld = 768; c.ncols = 768; c.kvalid = 64; c.dst = WA + A_AAA; c.dstK = 64; c.ngran = 24; return true;
        case 3: c.src = p.in[11] + (size_t)i * 128 * 768; c.ld = 768; c.ncols = 768; c.kvalid = 128; c.dst = WA + A_GATE; c.dstK = 128; c.ngran = 24; return true;
        case 4: c.src = p.in[17] + (size_t)i * 1024 * 512; c.ld = 512; c.ncols = 512; c.kvalid = 1024; c.dst = WA + A_MKV; c.dstK = 1024; c.ngran = 16; return true;
        case 5: c.src = p.in[18] + (size_t)i * 1024 * 1024; c.ld = 1024; c.ncols = 1024; c.kvalid = 1024; c.dst = WA + A_WOUT; c.dstK = 1024; c.ngran = 32; return true;
        }
        if (i == 0) return false;
        switch (idx) {
        case 6: c.src = p.in[23]; c.ld = 32; c.ncols = 32; c.kvalid = 1024; c.dst = WA + A_WIN + (size_t)2816 * 1024; c.dstK = 1024; c.ngran = 1; c.rscale = p.in[22]; c.rsmode = 1; return true;
        case 7: c.src = p.in[23]; c.ld = 32; c.ncols = 32; c.kvalid = 1024; c.dst = WA + A_WIN + (size_t)2848 * 1024; c.dstK = 1024; c.ngran = 1; c.rscale = p.in[22]; c.rsmode = 2; return true;
        case 8: c.src = p.in[23]; c.ld = 32; c.ncols = 0; c.kvalid = 1024; c.dst = WA + A_WIN + (size_t)2880 * 1024; c.dstK = 1024; c.ngran = 2; return true;
        case 9: c.src = p.in[24]; c.ld = 768; c.ncols = 768; c.kvalid = 32; c.dst = WA + A_VUP; c.dstK = 64; c.ngran = 24; return true;
        }
        return false;
    }
    const int j = L - 2;
    switch (idx) {
    case 0: c.src = p.in[31] + (size_t)j * 1024 * 768; c.ld = 768; c.ncols = 768; c.kvalid = 1024; c.dst = WA + B_WIN; c.dstK = 1024; c.ngran = 24; return true;
    case 1: c.src = p.in[33] + (size_t)j * 512 * 1152; c.ld = 1152; c.ncols = 1152; c.kvalid = 512; c.dst = WA + B_QUP; c.dstK = 512; c.ngran = 36; return true;
    case 2: c.src = p.in[34] + (size_t)j * 1024 * 512; c.ld = 512; c.ncols = 512; c.kvalid = 1024; c.dst = WA + B_MKV; c.dstK = 1024; c.ngran = 16; return true;
    case 3: c.src = p.in[35] + (size_t)j * 1024 * 1024; c.ld = 1024; c.ncols = 1024; c.kvalid = 1024; c.dst = WA + B_WOUT; c.dstK = 1024; c.ngran = 32; return true;
    }
    if (j != 0) return false;
    if (idx == 4) { c.src = p.in[27]; c.ld = 288; c.ncols = 288; c.kvalid = 1024; c.dst = WA + B_KVD; c.dstK = 1024; c.ngran = 12; return true; }
    if (idx == 5) { c.src = p.in[29]; c.ld = 1536; c.ncols = 1536; c.kvalid = 256; c.dst = WA + B_KVU; c.dstK = 256; c.ngran = 48; return true; }
    return false;
}

enum { E_BF16 = 0, E_F32, E_RESID, E_SWIGLU, E_DECAY, E_SIGB, E_KV, E_MEMKV, E_MULG };
struct Epi { void* o0; void* o1; const float* bias; const float* resid; int ldc; bf16_t* halo; };
struct GemmJob { const bf16_t* A; int lda; const bf16_t* W; int K, M, N, kind; Epi e; };

template <int E, int MI> __device__ __forceinline__ void epilogue(const f32x16 (&acc)[MI][2], int m0, int n0, int wm, int wn, int lane, const Epi& e) {
    const int half = lane >> 5, l31 = lane & 31;
    if (E == E_SWIGLU) {
        bf16_t* o = (bf16_t*)e.o0; const int col = (n0 >> 1) + wn * 32 + l31;
#pragma unroll
        for (int mi = 0; mi < MI; ++mi) {
            int rb_ = m0 + wm * (MI * 32) + mi * 32 + 4 * half;
            asm volatile("" : "+v"(rb_));
#pragma unroll
            for (int i = 0; i < 16; i += 2) {
                const int row = rb_ + 8 * (i >> 2) + (i & 3);
                const float g0 = acc[mi][0][i], u0 = acc[mi][1][i], g1 = acc[mi][0][i + 1], u1 = acc[mi][1][i + 1];
                const unsigned w = pk2(g0 * sigmoidf_(g0) * u0, g1 * sigmoidf_(g1) * u1);
                o[(size_t)row * 2816 + col] = (bf16_t)w; o[(size_t)(row + 1) * 2816 + col] = (bf16_t)(w >> 16);
            }
        }
        return;
    }
#pragma unroll
    for (int mi = 0; mi < MI; ++mi)
#pragma unroll
        for (int ni = 0; ni < 2; ++ni) {
            const int col = n0 + wn * 64 + ni * 32 + l31;
            int rbase = m0 + wm * (MI * 32) + mi * 32 + 4 * half;
            asm volatile("" : "+v"(rbase));
            if (E == E_KV || E == E_MEMKV) {
                const bool isv = (E == E_KV) ? ((col & 127) >= 64) : (col >= 256);
                if (isv) {
#pragma unroll
                    for (int g = 0; g < 4; ++g) {
                        const int row = rbase + 8 * g;
                        uint2 w; w.x = pk2(acc[mi][ni][4 * g], acc[mi][ni][4 * g + 1]); w.y = pk2(acc[mi][ni][4 * g + 2], acc[mi][ni][4 * g + 3]);
                        size_t idx;
                        if (E == E_KV) { const int b = row >> 13, s = row & 8191, head = col >> 7, d = (col & 127) - 64; idx = ((size_t)(b * 12 + head) * 64 + d) * 8192 + s; }
                        else { const int b = row >> 8, mi_ = row & 255, head = (col - 256) >> 6, d = col & 63; idx = ((size_t)(b * 4 + head) * 64 + d) * 256 + mi_; }
                        *(uint2*)((bf16_t*)e.o1 + idx) = w;
                    }
                } else {
#pragma unroll
                    for (int i = 0; i < 16; ++i) {
                        const int row = rbase + 8 * (i >> 2) + (i & 3);
                        size_t idx;
                        if (E == E_KV) { const int b = row >> 13, s = row & 8191, head = col >> 7, c = col & 127; idx = ((size_t)(b * 12 + head) * 8192 + s) * 96 + c; }
                        else { const int b = row >> 8, mi_ = row & 255, head = col >> 6, d = col & 63; idx = ((size_t)(b * 4 + head) * 256 + mi_) * 64 + d; }
                        ((bf16_t*)e.o0)[idx] = f2bf(acc[mi][ni][i]);
                    }
                }
                continue;
            }
            float bias = 0.f;
            if (E == E_DECAY || E == E_SIGB) bias = e.bias[col];
#pragma unroll
            for (int i = 0; i < 16; ++i) {
                const int row = rbase + 8 * (i >> 2) + (i & 3);
                const float v = acc[mi][ni][i];
                const size_t idx = (size_t)row * e.ldc + col;
                if (E == E_BF16) {
                    if ((i & 1) == 0) {
                        const unsigned w = pk2(v, acc[mi][ni][i + 1]);
                        const bf16_t b0 = (bf16_t)w, b1 = (bf16_t)(w >> 16);
                        ((bf16_t*)e.o0)[idx] = b0; ((bf16_t*)e.o0)[idx + e.ldc] = b1;
                        if (e.halo && ((row + 1) & 127) == 127) e.halo[(size_t)((row + 1) >> 7) * e.ldc + col] = b1;
                    }
                } else if (E == E_F32) ((float*)e.o0)[idx] = v;
                else if (E == E_RESID) ((float*)e.o0)[idx] = e.resid[idx] + v;
                else if (E == E_DECAY) ((_Float16*)e.o0)[idx] = (_Float16)(0.60653066f * sigmoidf_(bias + v));
                else if (E == E_SIGB) ((bf16_t*)e.o0)[idx] = f2bf(sigmoidf_(bias + v));
                else if (E == E_MULG) { bf16_t* o = (bf16_t*)e.o0; o[idx] = f2bf(bf2f(o[idx]) * v); }
            }
        }
}

__device__ void gemm_job(const GemmJob& gj, int& rot, char* smem) {
#ifdef NO_GEMM
    return;
#endif
    const bf16_t* A = gj.A; const bf16_t* W = gj.W; const int lda = gj.lda, K = gj.K, M = gj.M, N = gj.N; const Epi& e = gj.e;
    const int tid = opaque_tid(), lane = tid & 63, wave = tid >> 6, wm = wave >> 2, wn = wave & 3;
    const int ntn = (N + 255) >> 8, ntm = M >> 8, KT = K >> 6, G = gridDim.x;
    bf16_t* sA = (bf16_t*)smem;
    bf16_t* sB = sA + 2 * 256 * 72;
    const int half = lane >> 5, l31 = lane & 31;
    const int bp = (blockIdx.x + G - rot) % G;
    const bool xmap = (ntm & 7) == 0;
    const int xcd = bp & 7, li = bp >> 3, GL = G >> 3, mpx = ntm >> 3, mgsz = mpx < 8 ? (mpx > 0 ? mpx : 1) : 8, gsz = mgsz * ntn;
    const int tcount = xmap ? mpx * ntn : ntm * ntn, tstart = xmap ? li : bp, tstep = xmap ? GL : G;
    for (int idx = tstart; idx < tcount; idx += tstep) {
        int tm, tn;
        if (xmap) { const int grp = idx / gsz, rem = idx - grp * gsz; tn = rem / mgsz; tm = xcd * mpx + grp * mgsz + (rem - tn * mgsz); }
        else { tm = idx / ntn; tn = idx - tm * ntn; }
        const int m0 = tm << 8, n0 = tn << 8;
        const bool wact = (n0 + wn * 64) < N;
        f32x16 acc[4][2];
#pragma unroll
        for (int a = 0; a < 4; ++a)
#pragma unroll
            for (int b = 0; b < 2; ++b)
#pragma unroll
                for (int i = 0; i < 16; ++i) acc[a][b][i] = 0.f;
        u32x4 ra[4], rb[4];
        const char* Ab = (const char*)(A + (size_t)m0 * lda);
        const char* Wb = (const char*)(W + (size_t)n0 * K);
        const unsigned aoff = (unsigned)(((tid >> 3) * lda + (tid & 7) * 8) * 2), woff = (unsigned)(((tid >> 3) * K + (tid & 7) * 8) * 2);
#define GLOAD_TILE(KT_) { _Pragma("unroll") for (int i = 0; i < 4; ++i) { \
            ra[i] = *(const u32x4*)(Ab + ((size_t)(64 * i) * lda + (size_t)(KT_) * 64) * 2 + aoff); \
            rb[i] = *(const u32x4*)(Wb + ((size_t)(64 * i) * K + (size_t)(KT_) * 64) * 2 + woff); } }
        GLOAD_TILE(0)
        const int lofs = (tid >> 3) * 72 + (tid & 7) * 8;
#pragma unroll
        for (int i = 0; i < 4; ++i) { *(u32x4*)(sA + lofs + 64 * i * 72) = ra[i]; *(u32x4*)(sB + lofs + 64 * i * 72) = rb[i]; }
        if (KT > 1) GLOAD_TILE(1)
        __syncthreads();
        for (int kt = 0; kt < KT; ++kt) {
            const int buf = kt & 1;
            if (kt + 1 < KT) {
                bf16_t* da = sA + (buf ^ 1) * 256 * 72 + lofs; bf16_t* db = sB + (buf ^ 1) * 256 * 72 + lofs;
#pragma unroll
                for (int i = 0; i < 4; ++i) { *(u32x4*)(da + 64 * i * 72) = ra[i]; *(u32x4*)(db + 64 * i * 72) = rb[i]; }
            }
            if (kt + 2 < KT) GLOAD_TILE(kt + 2)
            if (wact) {
                const bf16_t* a_ = sA + buf * 256 * 72 + (wm * 128 + l31) * 72 + half * 8;
                const bf16_t* b_ = sB + buf * 256 * 72 + (wn * 64 + l31) * 72 + half * 8;
#define LDF(P_, O_) (*(const bf16x8*)((P_) + (O_)))
#define MM(I_, J_, AF, BF) acc[I_][J_] = __builtin_amdgcn_mfma_f32_32x32x16_bf16(AF, BF, acc[I_][J_], 0, 0, 0);
                bf16x8 b0 = LDF(b_, 0), b1 = LDF(b_, 32 * 72), a0 = LDF(a_, 0), a1 = LDF(a_, 32 * 72), a2, a3;
#pragma unroll
                for (int kk = 0; kk < 4; ++kk) {
                    a2 = LDF(a_, 64 * 72 + kk * 16); a3 = LDF(a_, 96 * 72 + kk * 16);
                    __builtin_amdgcn_sched_barrier(0);
                    MM(0, 0, a0, b0) MM(0, 1, a0, b1) MM(1, 0, a1, b0) MM(1, 1, a1, b1)
                    __builtin_amdgcn_sched_barrier(0);
                    if (kk < 3) { a0 = LDF(a_, (kk + 1) * 16); a1 = LDF(a_, 32 * 72 + (kk + 1) * 16); }
                    bf16x8 c0 = b0, c1 = b1;
                    if (kk < 3) { b0 = LDF(b_, (kk + 1) * 16); b1 = LDF(b_, 32 * 72 + (kk + 1) * 16); }
                    __builtin_amdgcn_sched_barrier(0);
                    MM(2, 0, a2, c0) MM(2, 1, a2, c1) MM(3, 0, a3, c0) MM(3, 1, a3, c1)
                    __builtin_amdgcn_sched_barrier(0);
                }
#undef LDF
#undef MM
            }
            __syncthreads();
        }
#undef GLOAD_TILE
        if (wact) {
            switch (gj.kind) {
            case E_BF16: epilogue<E_BF16, 4>(acc, m0, n0, wm, wn, lane, e); break;
            case E_F32: epilogue<E_F32, 4>(acc, m0, n0, wm, wn, lane, e); break;
            case E_RESID: epilogue<E_RESID, 4>(acc, m0, n0, wm, wn, lane, e); break;
            case E_SWIGLU: epilogue<E_SWIGLU, 4>(acc, m0, n0, wm, wn, lane, e); break;
            case E_DECAY: epilogue<E_DECAY, 4>(acc, m0, n0, wm, wn, lane, e); break;
            case E_SIGB: epilogue<E_SIGB, 4>(acc, m0, n0, wm, wn, lane, e); break;
            case E_KV: epilogue<E_KV, 4>(acc, m0, n0, wm, wn, lane, e); break;
            case E_MEMKV: epilogue<E_MEMKV, 4>(acc, m0, n0, wm, wn, lane, e); break;
            default: epilogue<E_MULG, 4>(acc, m0, n0, wm, wn, lane, e); break;
            }
        }
    }
    rot = (rot + (xmap ? 8 * (tcount % GL) : tcount) ) % G;
}

template <int DQK, bool CAUSAL>
__device__ void attn_phase(const bf16_t* Q, int ldq, int qcol0, const bf16_t* Kb, size_t k_bh_stride, const bf16_t* VT, size_t vt_bh_stride, int vt_ld,
                           int nheads, int nkeys, const float* rope, float scl, bf16_t* O, int ldo, int ocol0, int& rot, char* smem, int vb, int G) {
#ifdef NO_ATTN
    return;
#endif

    constexpr int KS = DQK + 8, NKK = DQK / 16, KCH = DQK / 8, NCH = 64 * KCH, NKL = (NCH + NT - 1) / NT;
    const int tid = opaque_tid(), lane = tid & 63, wave = tid >> 6, half = lane >> 5, l31 = lane & 31;
    const int xaddr = (lane ^ 32) << 2;
    bf16_t* sK = (bf16_t*)smem;
    bf16_t* sV = sK + 2 * 64 * KS;
    const int nbh = 4 * nheads, upx = (nbh >> 3) * 32;
    const int bp = (vb + G - rot) % G, xcd = bp & 7, li = bp >> 3, GL = G >> 3;
    for (int idx = li; idx < upx; idx += GL) {
        const int hr = idx >> 5, qi = idx & 31, qb = (hr & 1) ? 31 - qi : qi, bh = xcd + 8 * hr, b = bh / nheads, h = bh - b * nheads;
        const int q0 = qb * 256 + wave * 32, q = q0 + l31;
        const size_t tokq = (size_t)b * S + q;
        bf16x8 qf[NKK];
        { const bf16_t* qp = Q + tokq * ldq + qcol0 + h * DQK + half * 8;
#pragma unroll
          for (int kk = 0; kk < NKK; ++kk) qf[kk] = *(const bf16x8*)(qp + kk * 16); }
        if (rope) {
            const float* rp = rope + tokq * 32 + half * 8;
            const float4 c0 = *(const float4*)rp, c1 = *(const float4*)(rp + 4), s0 = *(const float4*)(rp + 16), s1 = *(const float4*)(rp + 20);
            u32x4 qa = __builtin_bit_cast(u32x4, qf[NKK - 2]), qb_ = __builtin_bit_cast(u32x4, qf[NKK - 1]);
#define ROT2(D, CA, SA, CB, SB) { const float x1l = bflo(qa[D]), x1h = bfhi(qa[D]), x2l = bflo(qb_[D]), x2h = bfhi(qb_[D]); \
              qa[D] = pk2(x1l * CA - x2l * SA, x1h * CB - x2h * SB); qb_[D] = pk2(x2l * CA + x1l * SA, x2h * CB + x1h * SB); }
            ROT2(0, c0.x, s0.x, c0.y, s0.y) ROT2(1, c0.z, s0.z, c0.w, s0.w) ROT2(2, c1.x, s1.x, c1.y, s1.y) ROT2(3, c1.z, s1.z, c1.w, s1.w)
#undef ROT2
            qf[NKK - 2] = __builtin_bit_cast(bf16x8, qa); qf[NKK - 1] = __builtin_bit_cast(bf16x8, qb_);
        }
        const int ntiles = CAUSAL ? (qb * 4 + 4) : (nkeys >> 6);
        f32x16 o[2];
#pragma unroll
        for (int a = 0; a < 2; ++a)
#pragma unroll
            for (int i = 0; i < 16; ++i) o[a][i] = 0.f;
        float m = -1e30f, l = 0.f;
        const bf16_t* Kg = Kb + (size_t)bh * k_bh_stride;
        const bf16_t* Vg = VT + (size_t)bh * vt_bh_stride + (size_t)(tid >> 3) * vt_ld + (tid & 7) * 8;
        u32x4 rk[NKL], rv[1];
#pragma unroll
        for (int i = 0; i < NKL; ++i) { const int c = tid + NT * i; if (c < NCH) rk[i] = *(const u32x4*)(Kg + (size_t)c * 8); }
        rv[0] = *(const u32x4*)(Vg);
#pragma unroll
        for (int i = 0; i < NKL; ++i) { const int c = tid + NT * i; if (c < NCH) *(u32x4*)(sK + (c / KCH) * KS + (c % KCH) * 8) = rk[i]; }
        *(u32x4*)(sV + (tid >> 3) * 72 + (tid & 7) * 8) = rv[0];
        __syncthreads();
        for (int kt = 0; kt < ntiles; ++kt) {
            const int buf = kt & 1;
            if (kt + 1 < ntiles) {
#pragma unroll
                for (int i = 0; i < NKL; ++i) { const int c = tid + NT * i; if (c < NCH) rk[i] = *(const u32x4*)(Kg + (size_t)(kt + 1) * 64 * DQK + (size_t)c * 8); }
                rv[0] = *(const u32x4*)(Vg + (kt + 1) * 64);
            }
            if (!CAUSAL || kt * 64 <= q0 + 31) {
                const bf16_t* kb_ = sK + buf * 64 * KS + l31 * KS + half * 8;
                const bf16_t* vb_ = sV + buf * 64 * 72 + l31 * 72 + 4 * half;
                f32x16 s[2];
                bf16x8 kf0[NKK], kf1[NKK];
                __builtin_amdgcn_sched_barrier(0);
#pragma unroll
                for (int kk = 0; kk < NKK; ++kk) kf0[kk] = *(const bf16x8*)(kb_ + kk * 16);
#pragma unroll
                for (int kk = 0; kk < NKK; ++kk) kf1[kk] = *(const bf16x8*)(kb_ + 32 * KS + kk * 16);
                __builtin_amdgcn_sched_barrier(0);
#pragma unroll
                for (int i = 0; i < 16; ++i) { s[0][i] = 0.f; s[1][i] = 0.f; }
#pragma unroll
                for (int kk = 0; kk < NKK; ++kk) s[0] = __builtin_amdgcn_mfma_f32_32x32x16_bf16(kf0[kk], qf[kk], s[0], 0, 0, 0);
#pragma unroll
                for (int kk = 0; kk < NKK; ++kk) s[1] = __builtin_amdgcn_mfma_f32_32x32x16_bf16(kf1[kk], qf[kk], s[1], 0, 0, 0);
                uint2 vfr[2][2][2][2];
#pragma unroll
                for (int kb = 0; kb < 2; ++kb)
#pragma unroll
                    for (int g = 0; g < 2; ++g)
#pragma unroll
                        for (int db = 0; db < 2; ++db) {
                            const bf16_t* vp = vb_ + db * 32 * 72 + kb * 32 + 16 * g;
                            vfr[kb][g][db][0] = *(const uint2*)vp; vfr[kb][g][db][1] = *(const uint2*)(vp + 8);
                        }
                __builtin_amdgcn_sched_barrier(0);
                if (CAUSAL && kt * 64 + 63 > q0) {
#pragma unroll
                    for (int kb = 0; kb < 2; ++kb)
#pragma unroll
                        for (int i = 0; i < 16; ++i) { const int key = kt * 64 + kb * 32 + 8 * (i >> 2) + 4 * half + (i & 3); if (key > q) s[kb][i] = -1e30f; }
                }
                float mx = s[0][0];
#pragma unroll
                for (int kb = 0; kb < 2; ++kb)
#pragma unroll
                    for (int i = 0; i < 16; ++i) mx = fmaxf(mx, s[kb][i]);
                mx = fmaxf(mx, __int_as_float(__builtin_amdgcn_ds_bpermute(xaddr, __float_as_int(mx))));
                const float mn = fmaxf(m, mx), alpha = __builtin_amdgcn_exp2f((m - mn) * scl), mc = mn * scl;
                m = mn;
                f32x2 ls2 = {0.f, 0.f};
                const f32x2 scl2 = {scl, scl}, nmc2 = {-mc, -mc};
#pragma unroll
                for (int kb = 0; kb < 2; ++kb)
#pragma unroll
                    for (int i = 0; i < 16; i += 2) {
                        const f32x2 t = __builtin_elementwise_fma((f32x2){s[kb][i], s[kb][i + 1]}, scl2, nmc2);
                        const f32x2 pv = {__builtin_amdgcn_exp2f(t[0]), __builtin_amdgcn_exp2f(t[1])};
                        s[kb][i] = pv[0]; s[kb][i + 1] = pv[1]; ls2 += pv;
                    }
                const float ls = ls2[0] + ls2[1];
                l = l * alpha + ls;
#pragma unroll
                for (int a = 0; a < 2; ++a)
#pragma unroll
                    for (int i = 0; i < 16; ++i) o[a][i] *= alpha;
#pragma unroll
                for (int kb = 0; kb < 2; ++kb)
#pragma unroll
                    for (int g = 0; g < 2; ++g) {
                        u32x4 pu;
#pragma unroll
                        for (int j = 0; j < 4; ++j) pu[j] = pk2(s[kb][8 * g + 2 * j], s[kb][8 * g + 2 * j + 1]);
                        const bf16x8 pf = __builtin_bit_cast(bf16x8, pu);
#pragma unroll
                        for (int db = 0; db < 2; ++db) {
                            u32x4 vu; vu[0] = vfr[kb][g][db][0].x; vu[1] = vfr[kb][g][db][0].y; vu[2] = vfr[kb][g][db][1].x; vu[3] = vfr[kb][g][db][1].y;
                            o[db] = __builtin_amdgcn_mfma_f32_32x32x16_bf16(__builtin_bit_cast(bf16x8, vu), pf, o[db], 0, 0, 0);
                        }
                    }
            }
            if (kt + 1 < ntiles) {
                bf16_t* dk = sK + (buf ^ 1) * 64 * KS; bf16_t* dv = sV + (buf ^ 1) * 64 * 72;
#pragma unroll
                for (int i = 0; i < NKL; ++i) { const int c = tid + NT * i; if (c < NCH) *(u32x4*)(dk + (c / KCH) * KS + (c % KCH) * 8) = rk[i]; }
                *(u32x4*)(dv + (tid >> 3) * 72 + (tid & 7) * 8) = rv[0];
            }
            __syncthreads();
        }
        l += __int_as_float(__builtin_amdgcn_ds_bpermute(xaddr, __float_as_int(l)));
        const float inv = 1.f / l;
        bf16_t* op = O + tokq * ldo + ocol0 + h * 64 + 4 * half;
#pragma unroll
        for (int db = 0; db < 2; ++db)
#pragma unroll
            for (int g = 0; g < 4; ++g) {
                uint2 w; w.x = pk2(o[db][4 * g] * inv, o[db][4 * g + 1] * inv); w.y = pk2(o[db][4 * g + 2] * inv, o[db][4 * g + 3] * inv);
                *(uint2*)(op + db * 32 + 8 * g) = w;
            }
    }
    rot = (rot + 8 * (upx % GL)) % G;
}

__device__ void lora_in_phase(const Params& p, int layer) {
#ifdef NO_LIN
    return;
#endif

    const bf16_t* P = (const bf16_t*)(p.ws + WS_P); bf16_t* LIN = (bf16_t*)(p.ws + WS_LIN);
    const float* mu = p.in[6] + (size_t)layer * 2560 + 2304;
    const int tid_ = opaque_tid(), lane = tid_ & 63, gw = blockIdx.x * NWV + (tid_ >> 6), nw = gridDim.x * NWV;
    const float4 m4 = *(const float4*)(mu + lane * 4);
    for (int tok = gw; tok < T; tok += nw) {
        const int s = tok & (S - 1);
        const uint2 c = *(const uint2*)(P + (size_t)tok * LDP + 2304 + lane * 4);
        uint2 pv; pv.x = 0; pv.y = 0;
        if (s) pv = *(const uint2*)(P + (size_t)(tok - 1) * LDP + 2304 + lane * 4);
        float v0 = bflo(c.x), v1 = bfhi(c.x), v2 = bflo(c.y), v3 = bfhi(c.y);
        v0 += (bflo(pv.x) - v0) * m4.x; v1 += (bfhi(pv.x) - v1) * m4.y; v2 += (bflo(pv.y) - v2) * m4.z; v3 += (bfhi(pv.y) - v3) * m4.w;
        if (lane < 16) { v0 = tanhf(v0); v1 = tanhf(v1); v2 = tanhf(v2); v3 = tanhf(v3); }
        else if (lane >= 32) { v0 = sigmoidf_(v0); v1 = sigmoidf_(v1); v2 = sigmoidf_(v2); v3 = sigmoidf_(v3); }
        uint2 w; w.x = pk2(v0, v1); w.y = pk2(v2, v3);
        *(uint2*)(LIN + (size_t)tok * 320 + lane * 4) = w;
        if (layer == 1) {
            float vd = 0.f;
            if (lane < 32) { vd = bf2f(P[(size_t)tok * LDP + 2816 + lane]); if (s) vd += bf2f(P[(size_t)(tok - 1) * LDP + 2848 + lane]); }
            LIN[(size_t)tok * 320 + 256 + lane] = f2bf(vd);
        }
    }
}

__device__ void prep_phase(const Params& p, int layer) {
#ifdef NO_PREP
    return;
#endif

    bf16_t* P = (bf16_t*)(p.ws + WS_P);
    bf16_t* Z2 = (bf16_t*)(p.ws + WS_Z + ZSZ);
    bf16_t* Z3 = (bf16_t*)(p.ws + WS_Z + 2 * ZSZ);
    bf16_t* Z4 = (bf16_t*)(p.ws + WS_Z + 3 * ZSZ);
    const bf16_t* HALO = (const bf16_t*)(p.ws + WS_HALO);
    float* RK = (float*)(p.ws + WS_RK);
    const float* mu = p.in[6] + (size_t)layer * 2560;
    const float* kkw = p.in[12] + (size_t)layer * 768; const float* kaw = p.in[13] + (size_t)layer * 768; const float* rkw = p.in[14] + (size_t)layer * 768;
    const int tid = opaque_tid(), tokl = tid >> 4, cg4 = (tid & 15) * 4;
    struct HL { u32x2 cr, ck, cv, qr, qk, qv, lr2, vs2, vf2; };
    for (int u = blockIdx.x; u < 256 * 4; u += gridDim.x) {
        const int mt = u >> 2, h0 = (u & 3) * 3, m0 = mt * 128;
        for (int it = 3; it >= 0; --it) {
            const int tok = m0 + it * 32 + tokl, s = tok & (S - 1);
            const bool useh = (it == 0 && tokl == 0);
            auto load = [&](HL& L, int h) {
                const int hc = h * 64 + cg4;
                const bf16_t* pr = P + (size_t)tok * LDP + hc;
                L.cr = *(const u32x2*)pr; L.ck = *(const u32x2*)(pr + 768); L.cv = *(const u32x2*)(pr + 1536);
                L.qr = (u32x2){0u, 0u}; L.qk = L.qr; L.qv = L.qr;
                if (s) {
                    const bf16_t* pp = useh ? (HALO + (size_t)(mt - 1) * LDP + hc) : (P + (size_t)(tok - 1) * LDP + hc);
                    L.qr = *(const u32x2*)pp; L.qk = *(const u32x2*)(pp + 768); L.qv = *(const u32x2*)(pp + 1536);
                }
                const size_t zi = (size_t)tok * 768 + hc;
                L.lr2 = *(const u32x2*)(Z2 + zi);
                L.vs2 = (u32x2){0u, 0u}; L.vf2 = L.vs2;
                if (layer == 1) { L.vs2 = *(const u32x2*)(Z3 + zi); L.vf2 = *(const u32x2*)(Z4 + zi); }
            };
            auto comp = [&](const HL& L, int h) {
                const int hc = h * 64 + cg4;
                bf16_t* pr = P + (size_t)tok * LDP + hc;
                const size_t zi = (size_t)tok * 768 + hc;
                const float4 mur = *(const float4*)(mu + hc), muk = *(const float4*)(mu + 768 + hc), muv = *(const float4*)(mu + 1536 + hc);
                const float4 kkw4 = *(const float4*)(kkw + hc), kaw4 = *(const float4*)(kaw + hc), rkw4 = *(const float4*)(rkw + hc);
                float r[4] = {bflo(L.cr[0]), bfhi(L.cr[0]), bflo(L.cr[1]), bfhi(L.cr[1])}, k[4] = {bflo(L.ck[0]), bfhi(L.ck[0]), bflo(L.ck[1]), bfhi(L.ck[1])}, v[4] = {bflo(L.cv[0]), bfhi(L.cv[0]), bflo(L.cv[1]), bfhi(L.cv[1])};
                const float rp[4] = {bflo(L.qr[0]), bfhi(L.qr[0]), bflo(L.qr[1]), bfhi(L.qr[1])}, kp[4] = {bflo(L.qk[0]), bfhi(L.qk[0]), bflo(L.qk[1]), bfhi(L.qk[1])}, vp[4] = {bflo(L.qv[0]), bfhi(L.qv[0]), bflo(L.qv[1]), bfhi(L.qv[1])};
                const float mr[4] = {mur.x, mur.y, mur.z, mur.w}, mk[4] = {muk.x, muk.y, muk.z, muk.w}, mv[4] = {muv.x, muv.y, muv.z, muv.w};
                const float lr[4] = {bflo(L.lr2[0]), bfhi(L.lr2[0]), bflo(L.lr2[1]), bfhi(L.lr2[1])};
                const float vs[4] = {bflo(L.vs2[0]), bfhi(L.vs2[0]), bflo(L.vs2[1]), bfhi(L.vs2[1])}, vf[4] = {bflo(L.vf2[0]), bfhi(L.vf2[0]), bflo(L.vf2[1]), bfhi(L.vf2[1])};
                const float kkw_[4] = {kkw4.x, kkw4.y, kkw4.z, kkw4.w}, kaw_[4] = {kaw4.x, kaw4.y, kaw4.z, kaw4.w}, rkw_[4] = {rkw4.x, rkw4.y, rkw4.z, rkw4.w};
                float kk[4], n2 = 0.f, rks = 0.f, bb[4];
#pragma unroll
                for (int j = 0; j < 4; ++j) {
                    r[j] += (rp[j] - r[j]) * mr[j]; k[j] += (kp[j] - k[j]) * mk[j]; v[j] += (vp[j] - v[j]) * mv[j];
                    if (layer == 1) v[j] += (vf[j] - v[j]) * vs[j];
                    kk[j] = k[j] * kkw_[j]; n2 += kk[j] * kk[j];
                    k[j] = k[j] * (1.f + (lr[j] - 1.f) * kaw_[j]);
                    rks += r[j] * k[j] * rkw_[j];
                }
                n2 = reduce16(n2); rks = reduce16(rks);
                const float inv = 1.f / fmaxf(sqrtf(n2), 1e-12f);
#pragma unroll
                for (int j = 0; j < 4; ++j) { kk[j] *= inv; bb[j] = kk[j] * lr[j]; }
                u32x2 w;
                w[0] = pk2(r[0], r[1]); w[1] = pk2(r[2], r[3]); *(u32x2*)pr = w;
                w[0] = pk2(k[0], k[1]); w[1] = pk2(k[2], k[3]); *(u32x2*)(pr + 768) = w;
                w[0] = pk2(v[0], v[1]); w[1] = pk2(v[2], v[3]); *(u32x2*)(pr + 1536) = w;
                if (layer == 0) *(u32x2*)(Z4 + zi) = w;
                w[0] = pk2(bb[0], bb[1]); w[1] = pk2(bb[2], bb[3]); *(u32x2*)(Z2 + zi) = w;
                w[0] = pk2(kk[0], kk[1]); w[1] = pk2(kk[2], kk[3]); *(u32x2*)(Z3 + zi) = w;
                if ((tid & 15) == 0) RK[(size_t)tok * 12 + h] = rks;
            };
            HL La, Lb, Lc;
            load(La, h0); load(Lb, h0 + 1); load(Lc, h0 + 2);
            __syncthreads();
            comp(La, h0); comp(Lb, h0 + 1); comp(Lc, h0 + 2);
        }
        __syncthreads();
    }
}

__device__ void scan_phase(const Params& p, char* smem) {
#ifdef NO_SCAN
    return;
#endif
    const bf16_t* P = (const bf16_t*)(p.ws + WS_P);
    const _Float16* E = (const _Float16*)(p.ws + WS_Z);
    const bf16_t* Bv = (const bf16_t*)(p.ws + WS_Z + ZSZ);
    const bf16_t* KK = (const bf16_t*)(p.ws + WS_Z + 2 * ZSZ);
    bf16_t* Y = (bf16_t*)(p.ws + WS_H);
    constexpr int BUFF = 11264;
    float* sBase = (float*)smem; float* sYp = sBase + 2 * BUFF;
    const int tid = opaque_tid(), lane = tid & 63, wave = tid >> 6;
    const bool comp = wave < 4;
    const int row = (wave & 3) * 4 + (lane >> 4), kg = lane & 15;
    const int stid = tid & 255, st_l = stid >> 3, c8 = (stid & 7) * 8;
    for (int u = blockIdx.x; u < 192; u += gridDim.x) {
        const int b = u / 48, h = (u % 48) >> 2, qt = u & 3;
        const size_t tok0 = (size_t)b * S;
        f32x2 S01 = {0.f, 0.f}, S23 = {0.f, 0.f};
        u32x4 gr, gk, ga, gb, gv = {0u, 0u, 0u, 0u}; h8 ge;
        auto gload = [&](int ch) {
            const size_t tok = tok0 + ch * 32 + st_l;
            gr = *(const u32x4*)(P + tok * LDP + h * 64 + c8);
            gk = *(const u32x4*)(P + tok * LDP + 768 + h * 64 + c8);
            ga = *(const u32x4*)(KK + tok * 768 + h * 64 + c8);
            gb = *(const u32x4*)(Bv + tok * 768 + h * 64 + c8);
            ge = *(const h8*)(E + tok * 768 + h * 64 + c8);
            if (stid < 64) { const size_t tk = tok0 + ch * 32 + (stid >> 1); gv = *(const u32x4*)(P + tk * LDP + 1536 + h * 64 + qt * 16 + (stid & 1) * 8); }
        };
        auto st4 = [&](float* dst, const u32x4& g) {
            f32x4 a, c; a[0] = bflo(g[0]); a[1] = bfhi(g[0]); a[2] = bflo(g[1]); a[3] = bfhi(g[1]); c[0] = bflo(g[2]); c[1] = bfhi(g[2]); c[2] = bflo(g[3]); c[3] = bfhi(g[3]);
            *(f32x4*)dst = a; *(f32x4*)(dst + 4) = c;
        };
        auto stage = [&](float* buf) {
            const int o = st_l * 64 + c8;
            st4(buf + 8192 + o, gr); st4(buf + 2048 + o, gk); st4(buf + 4096 + o, ga); st4(buf + 6144 + o, gb);
            f32x4 a, c; a[0] = __expf(-(float)ge[0]); a[1] = __expf(-(float)ge[1]); a[2] = __expf(-(float)ge[2]); a[3] = __expf(-(float)ge[3]);
            c[0] = __expf(-(float)ge[4]); c[1] = __expf(-(float)ge[5]); c[2] = __expf(-(float)ge[6]); c[3] = __expf(-(float)ge[7]);
            *(f32x4*)(buf + o) = a; *(f32x4*)(buf + o + 4) = c;
            if (stid < 64) st4(buf + 10240 + (stid >> 1) * 16 + (stid & 1) * 8, gv);
        };
        auto flush = [&](const float* buf, int ch) {
            if (stid < 64) {
                const float* yp = buf + 10752 + (stid >> 1) * 16 + (stid & 1) * 8;
                const f32x4 a = *(const f32x4*)yp, c = *(const f32x4*)(yp + 4);
                u32x4 w; w[0] = pk2(a[0], a[1]); w[1] = pk2(a[2], a[3]); w[2] = pk2(c[0], c[1]); w[3] = pk2(c[2], c[3]);
                *(u32x4*)(Y + (tok0 + ch * 32 + (stid >> 1)) * 1024 + h * 64 + qt * 16 + (stid & 1) * 8) = w;
            }
        };
        if (!comp) { gload(0); stage(sBase); gload(1); }
        __syncthreads();
        for (int ch = 0; ch < 256; ++ch) {
            float* bufc = sBase + (ch & 1) * BUFF; float* bufo = sBase + ((ch & 1) ^ 1) * BUFF;
            if (comp) {
                float* sY = bufc + 10752;
                unsigned a_cur = (unsigned)(size_t)(LAS char*)(bufc + kg * 4), v_cur = (unsigned)(size_t)(LAS char*)(bufc + 10240 + row);
                f32x4 w0, k0, a0, b0, r0, w1, k1, a1, b1, r1, w2, k2, a2, b2, r2, w3, k3, a3, b3, r3; float v0, v1, v2, v3;
#define SCAN_LOAD(W, K, A, B, R, V, AD, VD) asm volatile("ds_read_b128 %0, %6\n\tds_read_b128 %1, %6 offset:8192\n\tds_read_b128 %2, %6 offset:16384\n\tds_read_b128 %3, %6 offset:24576\n\tds_read_b128 %4, %6 offset:32768\n\tds_read_b32 %5, %7" \
                    : "=&v"(W), "=&v"(K), "=&v"(A), "=&v"(B), "=&v"(R), "=&v"(V) : "v"(AD), "v"(VD) : "memory")
#define SCAN_WAIT(W, K, A, B, R, V, DEP) asm volatile("s_waitcnt lgkmcnt(6)" : "+v"(W), "+v"(K), "+v"(A), "+v"(B), "+v"(R), "+v"(V), "+v"(DEP) :: "memory")
#define SCAN_WAIT0(W, K, A, B, R, V, DEP) asm volatile("s_waitcnt lgkmcnt(0)" : "+v"(W), "+v"(K), "+v"(A), "+v"(B), "+v"(R), "+v"(V), "+v"(DEP) :: "memory")
#define SCAN_STEP(W, K, A, B, R, V, YV) { \
                    f32x2 t = S01 * (f32x2){A[0], A[1]}; t = __builtin_elementwise_fma(S23, (f32x2){A[2], A[3]}, t); \
                    const float d = reduce16(t[0] + t[1]); const f32x2 sa2 = {-d, -d}, v2_ = {V, V}; \
                    const f32x2 u01 = __builtin_elementwise_fma(sa2, (f32x2){B[0], B[1]}, v2_ * (f32x2){K[0], K[1]}); \
                    const f32x2 u23 = __builtin_elementwise_fma(sa2, (f32x2){B[2], B[3]}, v2_ * (f32x2){K[2], K[3]}); \
                    S01 = __builtin_elementwise_fma(S01, (f32x2){W[0], W[1]}, u01); S23 = __builtin_elementwise_fma(S23, (f32x2){W[2], W[3]}, u23); \
                    f32x2 y2 = S01 * (f32x2){R[0], R[1]}; y2 = __builtin_elementwise_fma(S23, (f32x2){R[2], R[3]}, y2); \
                    YV = y2[0] + y2[1]; }
                SCAN_LOAD(w0, k0, a0, b0, r0, v0, a_cur, v_cur);
                { const unsigned an = a_cur + 256, vn = v_cur + 64; SCAN_LOAD(w1, k1, a1, b1, r1, v1, an, vn); }
                float yv = 0.f;
                float* ypw = sYp + row * 16 + kg;
#pragma unroll 1
                for (int q = 0; q < 8; ++q) {
                    const int sb = (q & 3) * 4;
                    SCAN_WAIT(w0, k0, a0, b0, r0, v0, yv);
                    { const unsigned an = a_cur + 512, vn = v_cur + 128; SCAN_LOAD(w2, k2, a2, b2, r2, v2, an, vn); }
                    SCAN_STEP(w0, k0, a0, b0, r0, v0, yv)
                    ypw[sb * 256] = yv;
                    SCAN_WAIT(w1, k1, a1, b1, r1, v1, yv);
                    { const unsigned an = a_cur + 768, vn = v_cur + 192; SCAN_LOAD(w3, k3, a3, b3, r3, v3, an, vn); }
                    SCAN_STEP(w1, k1, a1, b1, r1, v1, yv)
                    ypw[(sb + 1) * 256] = yv;
                    SCAN_WAIT(w2, k2, a2, b2, r2, v2, yv);
                    a_cur += 1024; v_cur += 256;
                    SCAN_LOAD(w0, k0, a0, b0, r0, v0, a_cur, v_cur);
                    SCAN_STEP(w2, k2, a2, b2, r2, v2, yv)
                    ypw[(sb + 2) * 256] = yv;
                    SCAN_WAIT(w3, k3, a3, b3, r3, v3, yv);
                    { const unsigned an = a_cur + 256, vn = v_cur + 64; SCAN_LOAD(w1, k1, a1, b1, r1, v1, an, vn); }
                    SCAN_STEP(w3, k3, a3, b3, r3, v3, yv)
                    ypw[(sb + 3) * 256] = yv;
                    if ((q & 3) == 3) {
                        const int hh = q >> 2, stp = lane >> 2, rw_ = (wave & 3) * 4 + (lane & 3);
                        const f32x4* pp = (const f32x4*)(sYp + stp * 256 + rw_ * 16);
                        const f32x4 q0 = pp[0], q1 = pp[1], q2 = pp[2], q3 = pp[3];
                        const float ysum = ((q0[0] + q0[1]) + (q0[2] + q0[3])) + ((q1[0] + q1[1]) + (q1[2] + q1[3])) + ((q2[0] + q2[1]) + (q2[2] + q2[3])) + ((q3[0] + q3[1]) + (q3[2] + q3[3]));
                        sY[(hh * 16 + stp) * 16 + rw_] = ysum;
                    }
                }
                SCAN_WAIT0(w0, k0, a0, b0, r0, v0, yv);
                SCAN_WAIT0(w1, k1, a1, b1, r1, v1, yv);
#undef SCAN_WAIT0
#undef SCAN_LOAD
#undef SCAN_WAIT
#undef SCAN_STEP
            } else {
                if (ch > 0) flush(bufo, ch - 1);
                if (ch + 1 < 256) { stage(bufo); if (ch + 2 < 256) gload(ch + 2); }
            }
            __syncthreads();
        }
        if (!comp) flush(sBase + BUFF, 255);
        __syncthreads();
    }
}

__device__ void post_phase(const Params& p, int layer) {
#ifdef NO_POST
    return;
#endif

    bf16_t* H = (bf16_t*)(p.ws + WS_H); const bf16_t* P = (const bf16_t*)(p.ws + WS_P); const float* RK = (const float*)(p.ws + WS_RK);
    const float* lg = p.in[15] + (size_t)layer * 768; const float* lb = p.in[16] + (size_t)layer * 768;
    const int tid = opaque_tid(), cg4 = (tid & 15) * 4;
    const int npairs = T * 12;
    for (int pr = blockIdx.x * (NT / 16) + (tid >> 4); pr < npairs; pr += gridDim.x * (NT / 16)) {
        const int tok = pr / 12, h = pr - tok * 12, hc = h * 64 + cg4;
        bf16_t* yp = H + (size_t)tok * 1024 + hc;
        const uint2 y2 = *(const uint2*)yp, v2 = *(const uint2*)(P + (size_t)tok * LDP + 1536 + hc);
        const float y[4] = {bflo(y2.x), bfhi(y2.x), bflo(y2.y), bfhi(y2.y)}, v[4] = {bflo(v2.x), bfhi(v2.x), bflo(v2.y), bfhi(v2.y)};
        const float mean = reduce16((y[0] + y[1]) + (y[2] + y[3])) * (1.f / 64.f);
        float q = 0.f;
#pragma unroll
        for (int j = 0; j < 4; ++j) { const float d = y[j] - mean; q += d * d; }
        const float rstd = rsqrtf(reduce16(q) * (1.f / 64.f) + 64e-5f);
        const float rk = RK[(size_t)tok * 12 + h];
        const float4 g4 = *(const float4*)(lg + hc), b4 = *(const float4*)(lb + hc);
        const float g[4] = {g4.x, g4.y, g4.z, g4.w}, bb[4] = {b4.x, b4.y, b4.z, b4.w};
        float o[4];
#pragma unroll
        for (int j = 0; j < 4; ++j) o[j] = (y[j] - mean) * rstd * g[j] + bb[j] + rk * v[j];
        uint2 w; w.x = pk2(o[0], o[1]); w.y = pk2(o[2], o[3]);
        *(uint2*)yp = w;
    }
}

__device__ void subnorm_phase(const Params& p, int j) {
#ifdef NO_SUB
    return;
#endif

    const bf16_t* PB = (const bf16_t*)(p.ws + WS_PROJB); bf16_t* CQ = (bf16_t*)(p.ws + WS_CQ);
    const float* CKR = (const float*)(p.ws + WS_CKR); bf16_t* CKV = (bf16_t*)(p.ws + WS_CKV); bf16_t* KF = (bf16_t*)(p.ws + WS_KFULL);
    const float* rope = (const float*)(p.ws + WS_ROPE);
    const float* gq = p.in[32] + (size_t)j * 512; const float* gl = p.in[28];
    const int tid_ = opaque_tid(), lane = tid_ & 63, gw = blockIdx.x * NWV + (tid_ >> 6), nw = gridDim.x * NWV;
    for (int tok = gw; tok < T; tok += nw) {
        {
            const uint4 c = *(const uint4*)(PB + (size_t)tok * 768 + lane * 8);
            float v[8] = {bflo(c.x), bfhi(c.x), bflo(c.y), bfhi(c.y), bflo(c.z), bfhi(c.z), bflo(c.w), bfhi(c.w)};
            float ss = 0.f;
#pragma unroll
            for (int i = 0; i < 8; ++i) ss += v[i] * v[i];
            ss = wave_sum(ss);
            const float rs = rsqrtf(ss * (1.f / 512.f) + 1e-6f);
            const float4 g0 = *(const float4*)(gq + lane * 8), g1 = *(const float4*)(gq + lane * 8 + 4);
            uint4 w; w.x = pk2(v[0] * rs * g0.x, v[1] * rs * g0.y); w.y = pk2(v[2] * rs * g0.z, v[3] * rs * g0.w);
            w.z = pk2(v[4] * rs * g1.x, v[5] * rs * g1.y); w.w = pk2(v[6] * rs * g1.z, v[7] * rs * g1.w);
            *(uint4*)(CQ + (size_t)tok * 512 + lane * 8) = w;
        }
        if (j == 0) {
            const float4 c = *(const float4*)(CKR + (size_t)tok * 384 + lane * 4);
            float ss = c.x * c.x + c.y * c.y + c.z * c.z + c.w * c.w;
            ss = wave_sum(ss);
            const float rs = rsqrtf(ss * (1.f / 256.f) + 1e-6f);
            const float4 g = *(const float4*)(gl + lane * 4);
            uint2 w; w.x = pk2(c.x * rs * g.x, c.y * rs * g.y); w.y = pk2(c.z * rs * g.z, c.w * rs * g.w);
            *(uint2*)(CKV + (size_t)tok * 256 + lane * 4) = w;
            const int i = lane & 15, hg = lane >> 4;
            const float x1 = CKR[(size_t)tok * 384 + 256 + i], x2 = CKR[(size_t)tok * 384 + 272 + i];
            const float cs = rope[(size_t)tok * 32 + i], sn = rope[(size_t)tok * 32 + 16 + i];
            const bf16_t o1 = f2bf(x1 * cs - x2 * sn), o2 = f2bf(x2 * cs + x1 * sn);
            const int b = tok >> 13, s = tok & (S - 1);
#pragma unroll
            for (int hh = 0; hh < 3; ++hh) {
                bf16_t* kp = KF + ((size_t)(b * 12 + hg * 3 + hh) * S + s) * 96 + 64 + i;
                kp[0] = o1; kp[16] = o2;
            }
        }
    }
}

__device__ void rope_phase(const Params& p) {
    const int* pos = (const int*)p.in[2]; float* rope = (float*)(p.ws + WS_ROPE);
    const int tid_ = opaque_tid();
    for (int idx = blockIdx.x * NT + tid_; idx < T * 16; idx += gridDim.x * NT) {
        const int tok = idx >> 4, i = idx & 15;
        const float invf = powf(10000.f, -(float)i / 16.f);
        const float ang = (float)pos[tok] * invf;
        rope[(size_t)tok * 32 + i] = cosf(ang); rope[(size_t)tok * 32 + 16 + i] = sinf(ang);
    }
}

__device__ bool get_gemm_job(const Params& p, int ph, int jn, GemmJob& g) {
    char* ws = p.ws;
    bf16_t* WA = (bf16_t*)(ws + WS_WA); bf16_t* WF = (bf16_t*)(ws + WS_WF); bf16_t* H = (bf16_t*)(ws + WS_H); bf16_t* P = (bf16_t*)(ws + WS_P);
    bf16_t* LIN = (bf16_t*)(ws + WS_LIN); bf16_t* KMEM = (bf16_t*)(ws + WS_KMEM); bf16_t* VTMEM = (bf16_t*)(ws + WS_VTMEM); bf16_t* MEMN = (bf16_t*)(ws + WS_MEMN);
    g.M = T; g.e.o1 = nullptr; g.e.bias = nullptr; g.e.resid = nullptr; g.e.halo = nullptr; g.e.ldc = 0;
    const bool rw = ph < 25;
    const int L = rw ? (ph - 1) / 12 : 2 + (ph - 25) / 9, r = rw ? (ph - 1) % 12 : (ph - 25) % 9;
    const int r_wout = rw ? 8 : 5, r_gu = rw ? 10 : 7, r_down = rw ? 11 : 8;
    if (r == r_wout) { if (jn) return false; g.A = H; g.lda = 1024; g.W = WA + (rw ? A_WOUT : B_WOUT); g.K = 1024; g.N = 1024; g.kind = E_RESID; g.e.o0 = p.out; g.e.resid = (L == 0) ? p.in[0] : p.out; g.e.ldc = 1024; return true; }
    if (r == r_gu) { if (jn) return false; g.A = H; g.lda = 1024; g.W = WF + F_GU; g.K = 1024; g.N = 5632; g.kind = E_SWIGLU; g.e.o0 = P; g.e.ldc = 2816; return true; }
    if (r == r_down) { if (jn) return false; g.A = P; g.lda = 2816; g.W = WF + F_DOWN; g.K = 2816; g.N = 1024; g.kind = E_RESID; g.e.o0 = p.out; g.e.resid = p.out; g.e.ldc = 1024; return true; }
    if (r == 1 && jn == 1) { g.A = MEMN; g.lda = 1024; g.W = WA + (rw ? A_MKV : B_MKV); g.K = 1024; g.M = 1024; g.N = 512; g.kind = E_MEMKV; g.e.o0 = KMEM; g.e.o1 = VTMEM; return true; }
    if (rw) {
        const int i = L;
        if (r == 1 && jn == 0) { g.A = H; g.lda = 1024; g.W = WA + A_WIN; g.K = 1024; g.N = (i == 1) ? 2944 : 2816; g.kind = E_BF16; g.e.o0 = P; g.e.ldc = LDP; g.e.halo = (bf16_t*)(ws + WS_HALO); return true; }
        if (r == 3) {
            if (jn == 0) { g.A = LIN; g.lda = 320; g.W = WA + A_DEC; g.K = 64; g.N = 768; g.kind = E_DECAY; g.e.o0 = ws + WS_Z; g.e.bias = p.in[8] + (size_t)i * 768; g.e.ldc = 768; return true; }
            if (jn == 1) { g.A = LIN + 64; g.lda = 320; g.W = WA + A_AAA; g.K = 64; g.N = 768; g.kind = E_SIGB; g.e.o0 = ws + WS_Z + ZSZ; g.e.bias = p.in[10] + (size_t)i * 768; g.e.ldc = 768; return true; }
            if (jn == 2 && i == 1) { g.A = LIN + 256; g.lda = 320; g.W = WA + A_VUP; g.K = 64; g.N = 768; g.kind = E_SIGB; g.e.o0 = ws + WS_Z + 2 * ZSZ; g.e.bias = p.in[25]; g.e.ldc = 768; return true; }
            return false;
        }
        if (r == 7 && jn == 0) { g.A = LIN + 128; g.lda = 320; g.W = WA + A_GATE; g.K = 128; g.N = 768; g.kind = E_MULG; g.e.o0 = H; g.e.ldc = 1024; return true; }
        return false;
    }
    const int j = L - 2;
    if (r == 1) {
        if (jn == 0) { g.A = H; g.lda = 1024; g.W = WA + B_WIN; g.K = 1024; g.N = 768; g.kind = E_BF16; g.e.o0 = ws + WS_PROJB; g.e.ldc = 768; return true; }
        if (jn == 2 && j == 0) { g.A = (bf16_t*)(ws + WS_QFULL); g.lda = 1024; g.W = WA + B_KVD; g.K = 1024; g.N = 384; g.kind = E_F32; g.e.o0 = ws + WS_CKR; g.e.ldc = 384; return true; }
        return false;
    }
    if (r == 3) {
        if (jn == 0) { g.A = (bf16_t*)(ws + WS_CQ); g.lda = 512; g.W = WA + B_QUP; g.K = 512; g.N = 1152; g.kind = E_BF16; g.e.o0 = ws + WS_QFULL; g.e.ldc = 1152; return true; }
        if (jn == 1 && j == 0) { g.A = (bf16_t*)(ws + WS_CKV); g.lda = 256; g.W = WA + B_KVU; g.K = 256; g.N = 1536; g.kind = E_KV; g.e.o0 = ws + WS_KFULL; g.e.o1 = ws + WS_VT; return true; }
        return false;
    }
    return false;
}

__device__ void run_phase(const Params& p, int ph, char* smem) {
    char* ws = p.ws;
    bf16_t* H = (bf16_t*)(ws + WS_H);
    const float MEMSCL = 0.125f * 1.4426950408889634f, MLASCL = 0.10206207261596575f * 1.4426950408889634f;
    int rot = 0;
    const bool rw = ph >= 1 && ph < 25, mla = ph >= 25 && ph < 43;
    const int L = rw ? (ph - 1) / 12 : (mla ? 2 + (ph - 25) / 9 : 0), r = rw ? (ph - 1) % 12 : (mla ? (ph - 25) % 9 : -1);
    {
        const float* x = nullptr; int nrows = T; const float* g1 = nullptr; bf16_t* o1 = H; const float* g2 = nullptr; bf16_t* o2 = nullptr; float* of = nullptr;
        if (ph == 0) { x = p.in[1]; nrows = 1024; g1 = p.in[3]; o1 = (bf16_t*)(ws + WS_MEMN); }
        else if (ph == 43) { x = p.out; g1 = p.in[39]; of = p.out; }
        else if (rw && r == 0) { x = (L == 0) ? p.in[0] : p.out; g1 = p.in[4] + (size_t)L * 1024; }
        else if (rw && r == 9) { x = p.out; g1 = p.in[19] + (size_t)L * 1024; }
        else if (mla && r == 0) { x = p.out; g1 = p.in[30] + (size_t)(L - 2) * 1024; if (L == 2) { g2 = p.in[26]; o2 = (bf16_t*)(ws + WS_QFULL); } }
        else if (mla && r == 6) { x = p.out; g1 = p.in[36] + (size_t)(L - 2) * 1024; }
        if (x) rmsnorm_phase(x, nrows, g1, o1, g2, o2, of);
    }
    if (ph == 0) rope_phase(p);
    int cvb = blockIdx.x, cVG = gridDim.x;
    {
        int kind = -1, CL = 0;
        if (ph == 0) { kind = 0; CL = 0; }
        else if ((rw || mla) && r == 0) { kind = 1; CL = L; }
        else if (rw && r == 9) { kind = 0; CL = L + 1; }
        else if (mla && r == 6 && L == 2) { kind = 0; CL = 3; }
        const int GG = gridDim.x; const bool split = false;

        if (split && GG == 512) { const int b_ = blockIdx.x; cvb = (b_ >= 192 && b_ < 256) ? b_ - 192 : (b_ >= 448 ? b_ - 384 : -1); cVG = 128; }
        else { cvb = split ? (int)blockIdx.x - 192 : (int)blockIdx.x; cVG = split ? GG - 192 : GG; }
        if (kind >= 0 && cvb >= 0) { ConvJob c; for (int idx = 0; get_conv_job(p, kind, CL, idx, c); ++idx) run_conv(c, rot, smem, cvb, cVG); }
    }
    { GemmJob g; for (int jn = 0; jn < 3; ++jn) if (get_gemm_job(p, ph, jn, g)) { gemm_job(g, rot, smem); } }
    if ((rw || mla) && r == 3) {
        const bf16_t* Q = rw ? (const bf16_t*)(ws + WS_P) : (const bf16_t*)(ws + WS_PROJB);
        attn_phase<64, false>(Q, rw ? LDP : 768, rw ? 2560 : 512, (const bf16_t*)(ws + WS_KMEM), 256 * 64, (const bf16_t*)(ws + WS_VTMEM), 64 * 256, 256, 4, 256, nullptr, MEMSCL, H, 1024, 768, rot, smem, cvb, cVG);
    }
    if (mla && r == 4)
        attn_phase<96, true>((const bf16_t*)(ws + WS_QFULL), 1152, 0, (const bf16_t*)(ws + WS_KFULL), (size_t)S * 96, (const bf16_t*)(ws + WS_VT), (size_t)64 * S, S, 12, S, (const float*)(ws + WS_ROPE), MLASCL, H, 1024, 0, rot, smem, blockIdx.x, gridDim.x);
    if (rw && r == 2) lora_in_phase(p, L);
    if (rw && r == 4) prep_phase(p, L);
    if (rw && r == 5 && (blockIdx.x < 192 || cVG == (int)gridDim.x)) scan_phase(p, smem);
    if (rw && r == 6) post_phase(p, L);
    if (mla && r == 2) subnorm_phase(p, L - 2);
}

#define XB_TMO      128
#define XB_XCNT(j)  (256  + 64 * (j))
#define XB_XSUB(j)  (1280 + 64 * (j))
#define XB_XGEN(j)  (2304 + 64 * (j))
#define XB_TOP      3328
#define XB_TOPGEN   3392
#define XCD_BAR_WORDS 3456
#define XB_SPIN_CAP (1u << 18)
__device__ __forceinline__ unsigned xb_ld(unsigned* p)              { return __hip_atomic_load(p, __ATOMIC_RELAXED, __HIP_MEMORY_SCOPE_AGENT); }
__device__ __forceinline__ unsigned xb_add(unsigned* p, unsigned v) { return __hip_atomic_fetch_add(p, v, __ATOMIC_RELAXED, __HIP_MEMORY_SCOPE_AGENT); }
__device__ __forceinline__ unsigned xb_xcc_id() { return (unsigned)__builtin_amdgcn_s_getreg((3 << 11) | 20) & 0xFu; }
#define XB_SPIN(cond, bar) do { unsigned _sp = 0; while (cond) { __builtin_amdgcn_s_sleep(1); \
    if ((++_sp & 255u) == 0u) { if (xb_ld(&(bar)[XB_TMO])) break; if (_sp > XB_SPIN_CAP) { atomicAdd(&(bar)[XB_TMO], 1u); break; } } } } while (0)
struct XcdBarrier { unsigned* bar; unsigned x; volatile LAS unsigned* st; };
__device__ __forceinline__ XcdBarrier xcd_barrier_post(unsigned* bar, volatile LAS unsigned* st) {
    XcdBarrier b; b.bar = bar; b.x = xb_xcc_id(); b.st = st;
    if (threadIdx.x == 0) (void)xb_add(&bar[XB_XCNT(b.x)], 1u);
    return b;
}
__device__ __forceinline__ void xcd_barrier_complete(unsigned* bar, unsigned x, unsigned& nloc, unsigned& nx) {
    const unsigned G = gridDim.x * gridDim.y * gridDim.z;
    unsigned sum, cnt, mine, sp = 0u;
    for (;;) {
        sum = 0u; cnt = 0u; mine = 0u;
#pragma unroll
        for (unsigned j = 0; j < 16; ++j) { const unsigned c = xb_ld(&bar[XB_XCNT(j)]); sum += c; cnt += (c > 0u) ? 1u : 0u; mine = (j == x) ? c : mine; }
        if (sum == G) break;
        __builtin_amdgcn_s_sleep(1);
        if ((++sp & 255u) == 0u) { if (xb_ld(&bar[XB_TMO])) break; if (sp > XB_SPIN_CAP) { atomicAdd(&bar[XB_TMO], 1u); break; } }
    }
    nloc = mine > 0u ? mine : 1u; nx = cnt > 0u ? cnt : 1u;
}
__device__ __forceinline__ void xcd_barrier(const XcdBarrier& b) {
    asm volatile("s_waitcnt vmcnt(0)" ::: "memory");
    __syncthreads();
    if (threadIdx.x == 0) {
        unsigned* bar = b.bar;
        __builtin_amdgcn_s_waitcnt(0);
        unsigned nloc = b.st[0], nx = b.st[1];
        if (nloc == 0u) { xcd_barrier_complete(bar, b.x, nloc, nx); b.st[0] = nloc; b.st[1] = nx; }
        const unsigned old = xb_add(&bar[XB_XSUB(b.x)], 1u);
        const unsigned gen = old / nloc;
        if (old + 1u == (gen + 1u) * nloc) {
            __builtin_amdgcn_fence(__ATOMIC_RELEASE, "agent");
            asm volatile("s_waitcnt vmcnt(0)" ::: "memory");
            const unsigned og = xb_add(&bar[XB_TOP], 1u);
            const unsigned tg = og / nx;
            if (og + 1u == (tg + 1u) * nx) xb_add(&bar[XB_TOPGEN], 1u);
            else XB_SPIN(xb_ld(&bar[XB_TOPGEN]) == tg, bar);
            __builtin_amdgcn_fence(__ATOMIC_ACQUIRE, "agent");
            xb_add(&bar[XB_XGEN(b.x)], 1u);
            asm volatile("s_waitcnt vmcnt(0)" ::: "memory");
        } else {
            XB_SPIN(xb_ld(&bar[XB_XGEN(b.x)]) == gen, bar);
            __builtin_amdgcn_fence(__ATOMIC_ACQUIRE, "agent");
            asm volatile("s_waitcnt vmcnt(0)" ::: "memory");
        }
    }
    __syncthreads();
}

__global__ void __launch_bounds__(NT) yoco_mega(Params p) {
    extern __shared__ __attribute__((aligned(16))) char smem[];
    cg::grid_group grid = cg::this_grid();
    volatile LAS unsigned* st = (volatile LAS unsigned*)((LAS char*)smem + LDS_MAIN);
    if (threadIdx.x == 0) { st[0] = 0u; st[1] = 0u; }
    __syncthreads();
    const XcdBarrier xb = xcd_barrier_post((unsigned*)(p.ws + WS_BAR), st);
    if (p.ph_lo < 0) grid.sync();
    for (int ph = p.ph_lo; ph < p.ph_hi; ++ph) {
        int nrep = 1;
#if PROBE_DUP
        {
            const bool rw = ph >= 1 && ph < 25, mla = ph >= 25 && ph < 43;
            const int r = rw ? (ph - 1) % 12 : (mla ? (ph - 25) % 9 : -1);
            if ((PROBE_DUP & 1) && rw && r == 5) nrep = 2;
            if ((PROBE_DUP & 2) && ((rw && r == 10) || (mla && r == 7))) nrep = 2;
            if ((PROBE_DUP & 4) && mla && r == 4) nrep = 2;
            if ((PROBE_DUP & 8) && rw && r == 3) nrep = 2;
            if ((PROBE_DUP & 16) && ((rw && (r == 0 || r == 9)) || (mla && (r == 0 || r == 6)))) nrep = 2;
            if ((PROBE_DUP & 32) && ((rw && r == 2) || (mla && (r == 2 || r == 3)))) nrep = 2;
        }
#endif
        for (int rep = 0; rep < nrep; ++rep) {
            run_phase(p, ph, smem);
            if (rep + 1 < nrep || ph + 1 < p.ph_hi) xcd_barrier(xb);
        }
    }
}

#ifndef PROBE_DUP
#define PROBE_DUP 0
#endif
#ifndef MULTI_LAUNCH
#define MULTI_LAUNCH 0
#endif

extern "C" void kernel_launch(void* const* d_in, const int* in_sizes, int n_in, void* d_out, int out_size, void* d_ws, size_t ws_size, hipStream_t stream) {
    static int grid_blocks = 0;
    if (!grid_blocks) {
        int dev = 0, cus = 0, per_cu = 0;
        hipGetDevice(&dev);
        hipDeviceGetAttribute(&cus, hipDeviceAttributeMultiprocessorCount, dev);
        hipFuncSetAttribute((const void*)yoco_mega, hipFuncAttributeMaxDynamicSharedMemorySize, LDS_BYTES);
        hipOccupancyMaxActiveBlocksPerMultiprocessor(&per_cu, (const void*)yoco_mega, NT, LDS_BYTES);
        if (per_cu < 1) per_cu = 1;
        if (per_cu > 1) per_cu = 1;
        grid_blocks = cus * per_cu;
        if (ws_size < WS_END) fprintf(stderr, "kernel_launch: workspace too small: %zu < %zu\n", ws_size, (size_t)WS_END);
        if (n_in != 40) fprintf(stderr, "kernel_launch: expected 40 inputs, got %d\n", n_in);
    }
    Params p{};
    for (int i = 0; i < 40; ++i) p.in[i] = (const float*)d_in[i];
    p.out = (float*)d_out; p.ws = (char*)d_ws;
#if MULTI_LAUNCH
    for (int ph = 0; ph < 44; ++ph) {
        p.ph_lo = ph; p.ph_hi = ph + 1;
        hipLaunchKernelGGL(yoco_mega, dim3(grid_blocks), dim3(NT), LDS_BYTES, stream, p);
    }
#else
    p.ph_lo = 0; p.ph_hi = 44;
    (void)hipMemsetAsync((char*)d_ws + WS_BAR, 0, 16384, stream);
    void* args[] = {&p};
    hipError_t e = hipLaunchCooperativeKernel((const void*)yoco_mega, dim3(grid_blocks), dim3(NT), args, LDS_BYTES, stream);
    if (e != hipSuccess) fprintf(stderr, "cooperative launch failed: %s (grid %d)\n", hipGetErrorString(e), grid_blocks);
#endif
}
```

```cpp
#include <hip/hip_runtime.h>
#include <hip/hip_cooperative_groups.h>
#include <cstdio>
#include <cstdint>
namespace cg = cooperative_groups;
#define PROBE_DUP 0

typedef unsigned short bf16_t;
typedef short bf16x8 __attribute__((ext_vector_type(8)));
typedef float f32x16 __attribute__((ext_vector_type(16)));
typedef _Float16 h8 __attribute__((ext_vector_type(8)));
typedef unsigned u32x4 __attribute__((ext_vector_type(4)));
typedef float f32x2 __attribute__((ext_vector_type(2)));
typedef unsigned u32x2 __attribute__((ext_vector_type(2)));
#define LAS __attribute__((address_space(3)))
typedef float f32x4 __attribute__((ext_vector_type(4)));

constexpr int T = 32768, S = 8192;
constexpr int LDP = 2944;
constexpr int NT = 512, NWV = 8;
constexpr int LDS_MAIN = 147456;
constexpr int LDS_BYTES = LDS_MAIN + 16;

constexpr size_t WS_WA = 0;
constexpr size_t WS_WF = WS_WA + 10485760;
constexpr size_t WS_H = WS_WF + 17825792;
constexpr size_t WS_P = WS_H + 67108864;
constexpr size_t WS_Z = WS_P + 192937984;
constexpr size_t ZSZ = 50331648;
constexpr size_t WS_LIN = WS_Z + 4 * ZSZ;
constexpr size_t WS_RK = WS_LIN + 20971520;
constexpr size_t WS_ROPE = WS_RK + 1572864;
constexpr size_t WS_KMEM = WS_ROPE + 4194304;
constexpr size_t WS_VTMEM = WS_KMEM + 524288;
constexpr size_t WS_MEMN = WS_VTMEM + 524288;
constexpr size_t WS_HALO = WS_MEMN + 2097152;
constexpr size_t WS_BAR = WS_HALO + 1507328;
constexpr size_t WS_END = WS_BAR + 16384;
constexpr size_t WS_KFULL = WS_Z;
constexpr size_t WS_VT = WS_KFULL + 75497472;
constexpr size_t WS_PROJB = WS_VT + 50331648;
constexpr size_t WS_QFULL = WS_P;
constexpr size_t WS_CQ = WS_QFULL + 75497472;
constexpr size_t WS_CKR = WS_CQ + 33554432;
constexpr size_t WS_CKV = WS_CKR + 50331648;
constexpr size_t A_WIN = 0, A_DEC = 3014656, A_AAA = 3063808, A_GATE = 3112960, A_VUP = 3211264, A_MKV = 3260416, A_WOUT = 3784704;
constexpr size_t B_WIN = 0, B_QUP = 786432, B_MKV = 1376256, B_WOUT = 1900544, B_KVD = 2949120, B_KVU = 3342336;
constexpr size_t F_GU = 0, F_DOWN = 5767168;

struct Params { const float* in[40]; float* out; char* ws; int ph_lo, ph_hi; };

__device__ __forceinline__ bf16_t f2bf(float f) { unsigned u = __float_as_uint(f); u += 0x7fffu + ((u >> 16) & 1u); return (bf16_t)(u >> 16); }
__device__ __forceinline__ unsigned pk2(float lo, float hi) { unsigned r; asm("v_cvt_pk_bf16_f32 %0, %1, %2" : "=v"(r) : "v"(lo), "v"(hi)); return r; }
__device__ __forceinline__ float bflo(unsigned u) { return __uint_as_float(u << 16); }
__device__ __forceinline__ float bfhi(unsigned u) { return __uint_as_float(u & 0xffff0000u); }
__device__ __forceinline__ float bf2f(bf16_t v) { return __uint_as_float((unsigned)v << 16); }
__device__ __forceinline__ float reduce16(float x);
__device__ __forceinline__ float wave_sum(float v) {
    v = reduce16(v);
    const int b = __float_as_int(v);
    return (__int_as_float(__builtin_amdgcn_readlane(b, 0)) + __int_as_float(__builtin_amdgcn_readlane(b, 16))) +
           (__int_as_float(__builtin_amdgcn_readlane(b, 32)) + __int_as_float(__builtin_amdgcn_readlane(b, 48)));
}
template <int CTRL> __device__ __forceinline__ float dppmov(float x) { return __int_as_float(__builtin_amdgcn_update_dpp(0, __float_as_int(x), CTRL, 0xF, 0xF, true)); }
__device__ __forceinline__ float reduce16(float x) {
    x += dppmov<0xB1>(x); x += dppmov<0x4E>(x); x += dppmov<0x141>(x); x += dppmov<0x140>(x); return x;
}
__device__ __forceinline__ int opaque_tid() { int t = threadIdx.x; asm volatile("" : "+v"(t)); return t; }
__device__ __forceinline__ float sigmoidf_(float x) { return __builtin_amdgcn_rcpf(1.f + __expf(-x)); }

__device__ void rmsnorm_phase(const float* x, int nrows, const float* g1, bf16_t* o1, const float* g2, bf16_t* o2, float* of) {
    const int tid_ = opaque_tid(), lane = tid_ & 63, gw = blockIdx.x * NWV + (tid_ >> 6), nw = gridDim.x * NWV;
    for (int row = gw; row < nrows; row += nw) {
        const float4* xr = (const float4*)(x + (size_t)row * 1024);
        float4 v[4]; float ss = 0.f;
#pragma unroll
        for (int i = 0; i < 4; ++i) { v[i] = xr[lane + 64 * i]; ss += v[i].x * v[i].x + v[i].y * v[i].y + v[i].z * v[i].z + v[i].w * v[i].w; }
        ss = wave_sum(ss);
        const float rs = rsqrtf(ss * (1.f / 1024.f) + 1e-6f);
#pragma unroll
        for (int i = 0; i < 4; ++i) {
            const float4 g = ((const float4*)g1)[lane + 64 * i];
            const float a = v[i].x * rs, b = v[i].y * rs, c = v[i].z * rs, d = v[i].w * rs;
            if (of) { float4 o; o.x = a * g.x; o.y = b * g.y; o.z = c * g.z; o.w = d * g.w; ((float4*)(of + (size_t)row * 1024))[lane + 64 * i] = o; }
            else {
                uint2 w; w.x = pk2(a * g.x, b * g.y); w.y = pk2(c * g.z, d * g.w);
                *(uint2*)(o1 + (size_t)row * 1024 + (lane + 64 * i) * 4) = w;
                if (o2) { const float4 h = ((const float4*)g2)[lane + 64 * i]; uint2 w2; w2.x = pk2(a * h.x, b * h.y); w2.y = pk2(c * h.z, d * h.w);
                    *(uint2*)(o2 + (size_t)row * 1024 + (lane + 64 * i) * 4) = w2; }
            }
        }
    }
}

struct ConvJob { const float* src; int ld; int ncols; int kvalid; bf16_t* dst; int dstK; int ngran; int swiglu; const float* rscale; int rsmode; };
__device__ void run_conv(const ConvJob& j, int& rot, char* smem, int vb, int G) {
#ifdef NO_CONV
    return;
#endif

    bf16_t* lds = (bf16_t*)smem;
    const int tid = opaque_tid(), nkt = j.dstK >> 6, units = j.ngran * nkt;
    for (int u = (vb + G - rot) % G; u < units; u += G) {
        const int g = u / nkt, kt = u - g * nkt, k0 = kt * 64;
        int col0 = j.swiglu ? ((g & 1) * 2816 + 32 * (g >> 1)) : 32 * g;
        const bool colok = (col0 + 32 <= j.ncols);
#pragma unroll
        for (int i = 0; i < 4; ++i) {
            const int kr = (tid >> 5) + 16 * i, c = tid & 31, k = k0 + kr;
            float v = 0.f;
            if (colok && k < j.kvalid) {
                v = j.src[(size_t)k * j.ld + col0 + c];
                if (j.rsmode == 1) v *= (1.f - j.rscale[k]); else if (j.rsmode == 2) v *= j.rscale[k];
            }
            lds[c * 72 + kr] = f2bf(v);
        }
        __syncthreads();
        if (tid < 256) { const int c = tid >> 3, kc = (tid & 7) * 8;
          const uint4 w = *(const uint4*)(lds + c * 72 + kc);
          *(uint4*)(j.dst + (size_t)(g * 32 + c) * j.dstK + k0 + kc) = w; }
        __syncthreads();
    }
    rot = (rot + units) % G;
}
__device__ bool get_conv_job(const Params& p, int kind, int L, int idx, ConvJob& c) {
    bf16_t* WA = (bf16_t*)(p.ws + WS_WA); bf16_t* WF = (bf16_t*)(p.ws + WS_WF);
    c.swiglu = 0; c.rscale = nullptr; c.rsmode = 0;
    if (kind == 1) {
        if (idx == 0) { c.src = (L < 2) ? p.in[20] + (size_t)L * 1024 * 5632 : p.in[37] + (size_t)(L - 2) * 1024 * 5632; c.ld = 5632; c.ncols = 5632; c.kvalid = 1024; c.dst = WF + F_GU; c.dstK = 1024; c.ngran = 176; c.swiglu = 1; return true; }
        if (idx == 1) { c.src = (L < 2) ? p.in[21] + (size_t)L * 2816 * 1024 : p.in[38] + (size_t)(L - 2) * 2816 * 1024; c.ld = 1024; c.ncols = 1024; c.kvalid = 2816; c.dst = WF + F_DOWN; c.dstK = 2816; c.ngran = 32; return true; }
        return false;
    }
    if (L < 2) {
        const int i = L;
        switch (idx) {
        case 0: c.src = p.in[5] + (size_t)i * 1024 * 2816; c.ld = 2816; c.ncols = 2816; c.kvalid = 1024; c.dst = WA + A_WIN; c.dstK = 1024; c.ngran = 88; return true;
        case 1: c.src = p.in[7] + (size_t)i * 64 * 768; c.ld = 768; c.ncols = 768; c.kvalid = 64; c.dst = WA + A_DEC; c.dstK = 64; c.ngran = 24; return true;
        case 2: c.src = p.in[9] + (size_t)i * 64 * 768; c.ld = 768; c.ncols = 768; c.kvalid = 64; c.dst = WA + A_AAA; c.dstK = 64; c.ngran = 24; return true;
        case 3: c.src = p.in[11] + (size_t)i * 128 * 768; c.ld = 768; c.ncols = 768; c.kvalid = 128; c.dst = WA + A_GATE; c.dstK = 128; c.ngran = 24; return true;
        case 4: c.src = p.in[17] + (size_t)i * 1024 * 512; c.ld = 512; c.ncols = 512; c.kvalid = 1024; c.dst = WA + A_MKV; c.dstK = 1024; c.ngran = 16; return true;
        case 5: c.src = p.in[18] + (size_t)i * 1024 * 1024; c.ld = 1024; c.ncols = 1024; c.kvalid = 1024; c.dst = WA + A_WOUT; c.dstK = 1024; c.ngran = 32; return true;
        }
        if (i == 0) return false;
        switch (idx) {
        case 6: c.src = p.in[23]; c.ld = 32; c.ncols = 32; c.kvalid = 1024; c.dst = WA + A_WIN + (size_t)2816 * 1024; c.dstK = 1024; c.ngran = 1; c.rscale = p.in[22]; c.rsmode = 1; return true;
        case 7: c.src = p.in[23]; c.ld = 32; c.ncols = 32; c.kvalid = 1024; c.dst = WA + A_WIN + (size_t)2848 * 1024; c.dstK = 1024; c.ngran = 1; c.rscale = p.in[22]; c.rsmode = 2; return true;
        case 8: c.src = p.in[23]; c.ld = 32; c.ncols = 0; c.kvalid = 1024; c.dst = WA + A_WIN + (size_t)2880 * 1024; c.dstK = 1024; c.ngran = 2; return true;
        case 9: c.src = p.in[24]; c.ld = 768; c.ncols = 768; c.kvalid = 32; c.dst = WA + A_VUP; c.dstK = 64; c.ngran = 24; return true;
        }
        return false;
    }
    const int j = L - 2;
    switch (idx) {
    case 0: c.src = p.in[31] + (size_t)j * 1024 * 768; c.ld = 768; c.ncols = 768; c.kvalid = 1024; c.dst = WA + B_WIN; c.dstK = 1024; c.ngran = 24; return true;
    case 1: c.src = p.in[33] + (size_t)j * 512 * 1152; c.ld = 1152; c.ncols = 1152; c.kvalid = 512; c.dst = WA + B_QUP; c.dstK = 512; c.ngran = 36; return true;
    case 2: c.src = p.in[34] + (size_t)j * 1024 * 512; c.ld = 512; c.ncols = 512; c.kvalid = 1024; c.dst = WA + B_MKV; c.dstK = 1024; c.ngran = 16; return true;
    case 3: c.src = p.in[35] + (size_t)j * 1024 * 1024; c.ld = 1024; c.ncols = 1024; c.kvalid = 1024; c.dst = WA + B_WOUT; c.dstK = 1024; c.ngran = 32; return true;
    }
    if (j != 0) return false;
    if (idx == 4) { c.src = p.in[27]; c.ld = 288; c.ncols = 288; c.kvalid = 1024; c.dst = WA + B_KVD; c.dstK = 1024; c.ngran = 12; return true; }
    if (idx == 5) { c.src = p.in[29]; c.ld = 1536; c.ncols = 1536; c.kvalid = 256; c.dst = WA + B_KVU; c.dstK = 256; c.ngran = 48; return true; }
    return false;
}

enum { E_BF16 = 0, E_F32, E_RESID, E_SWIGLU, E_DECAY, E_SIGB, E_KV, E_MEMKV, E_MULG };
struct Epi { void* o0; void* o1; const float* bias; const float* resid; int ldc; bf16_t* halo; };
struct GemmJob { const bf16_t* A; int lda; const bf16_t* W; int K, M, N, kind; Epi e; };

template <int E, int MI> __device__ __forceinline__ void epilogue(const f32x16 (&acc)[MI][2], int m0, int n0, int wm, int wn, int lane, const Epi& e) {
    const int half = lane >> 5, l31 = lane & 31;
    if (E == E_SWIGLU) {
        bf16_t* o = (bf16_t*)e.o0; const int col = (n0 >> 1) + wn * 32 + l31;
#pragma unroll
        for (int mi = 0; mi < MI; ++mi) {
            int rb_ = m0 + wm * (MI * 32) + mi * 32 + 4 * half;
            asm volatile("" : "+v"(rb_));
#pragma unroll
            for (int i = 0; i < 16; i += 2) {
                const int row = rb_ + 8 * (i >> 2) + (i & 3);
                const float g0 = acc[mi][0][i], u0 = acc[mi][1][i], g1 = acc[mi][0][i + 1], u1 = acc[mi][1][i + 1];
                const unsigned w = pk2(g0 * sigmoidf_(g0) * u0, g1 * sigmoidf_(g1) * u1);
                o[(size_t)row * 2816 + col] = (bf16_t)w; o[(size_t)(row + 1) * 2816 + col] = (bf16_t)(w >> 16);
            }
        }
        return;
    }
    if (E == E_RESID) {
        const float* rs = e.resid; float* oo = (float*)e.o0;
        float rc[16], rn[16];
        { int rb0 = m0 + wm * (MI * 32) + 4 * half; asm volatile("" : "+v"(rb0));
          const int col = n0 + wn * 64 + l31;
#pragma unroll
          for (int i = 0; i < 16; ++i) rc[i] = rs[(size_t)(rb0 + 8 * (i >> 2) + (i & 3)) * e.ldc + col]; }
#pragma unroll
        for (int g = 0; g < 2 * MI; ++g) {
            const int mi = g >> 1, ni = g & 1;
            if (g + 1 < 2 * MI) {
                const int mi2 = (g + 1) >> 1, ni2 = (g + 1) & 1;
                int rb2 = m0 + wm * (MI * 32) + mi2 * 32 + 4 * half; asm volatile("" : "+v"(rb2));
                const int col2 = n0 + wn * 64 + ni2 * 32 + l31;
#pragma unroll
                for (int i = 0; i < 16; ++i) rn[i] = rs[(size_t)(rb2 + 8 * (i >> 2) + (i & 3)) * e.ldc + col2];
            }
            int rb1 = m0 + wm * (MI * 32) + mi * 32 + 4 * half; asm volatile("" : "+v"(rb1));
            const int col = n0 + wn * 64 + ni * 32 + l31;
#pragma unroll
            for (int i = 0; i < 16; ++i) oo[(size_t)(rb1 + 8 * (i >> 2) + (i & 3)) * e.ldc + col] = rc[i] + acc[mi][ni][i];
#pragma unroll
            for (int i = 0; i < 16; ++i) rc[i] = rn[i];
        }
        return;
    }
#pragma unroll
    for (int mi = 0; mi < MI; ++mi)
#pragma unroll
        for (int ni = 0; ni < 2; ++ni) {
            const int col = n0 + wn * 64 + ni * 32 + l31;
            int rbase = m0 + wm * (MI * 32) + mi * 32 + 4 * half;
            asm volatile("" : "+v"(rbase));
            if (E == E_KV || E == E_MEMKV) {
                const bool isv = (E == E_KV) ? ((col & 127) >= 64) : (col >= 256);
                if (isv) {
#pragma unroll
                    for (int g = 0; g < 4; ++g) {
                        const int row = rbase + 8 * g;
                        uint2 w; w.x = pk2(acc[mi][ni][4 * g], acc[mi][ni][4 * g + 1]); w.y = pk2(acc[mi][ni][4 * g + 2], acc[mi][ni][4 * g + 3]);
                        size_t idx;
                        if (E == E_KV) { const int b = row >> 13, s = row & 8191, head = col >> 7, d = (col & 127) - 64; idx = ((size_t)(b * 12 + head) * 64 + d) * 8192 + s; }
                        else { const int b = row >> 8, mi_ = row & 255, head = (col - 256) >> 6, d = col & 63; idx = ((size_t)(b * 4 + head) * 64 + d) * 256 + mi_; }
                        *(uint2*)((bf16_t*)e.o1 + idx) = w;
                    }
                } else {
#pragma unroll
                    for (int i = 0; i < 16; ++i) {
                        const int row = rbase + 8 * (i >> 2) + (i & 3);
                        size_t idx;
                        if (E == E_KV) { const int b = row >> 13, s = row & 8191, head = col >> 7, c = col & 127; idx = ((size_t)(b * 12 + head) * 8192 + s) * 96 + c; }
                        else { const int b = row >> 8, mi_ = row & 255, head = col >> 6, d = col & 63; idx = ((size_t)(b * 4 + head) * 256 + mi_) * 64 + d; }
                        ((bf16_t*)e.o0)[idx] = f2bf(acc[mi][ni][i]);
                    }
                }
                continue;
            }
            float bias = 0.f;
            if (E == E_DECAY || E == E_SIGB) bias = e.bias[col];
#pragma unroll
            for (int i = 0; i < 16; ++i) {
                const int row = rbase + 8 * (i >> 2) + (i & 3);
                const float v = acc[mi][ni][i];
                const size_t idx = (size_t)row * e.ldc + col;
                if (E == E_BF16) {
                    if ((i & 1) == 0) {
                        const unsigned w = pk2(v, acc[mi][ni][i + 1]);
                        const bf16_t b0 = (bf16_t)w, b1 = (bf16_t)(w >> 16);
                        ((bf16_t*)e.o0)[idx] = b0; ((bf16_t*)e.o0)[idx + e.ldc] = b1;
                        if (e.halo && ((row + 1) & 127) == 127) e.halo[(size_t)((row + 1) >> 7) * e.ldc + col] = b1;
                    }
                } else if (E == E_F32) ((float*)e.o0)[idx] = v;
                else if (E == E_RESID) ((float*)e.o0)[idx] = e.resid[idx] + v;
                else if (E == E_DECAY) ((_Float16*)e.o0)[idx] = (_Float16)(0.60653066f * sigmoidf_(bias + v));
                else if (E == E_SIGB) ((bf16_t*)e.o0)[idx] = f2bf(sigmoidf_(bias + v));
                else if (E == E_MULG) { bf16_t* o = (bf16_t*)e.o0; o[idx] = f2bf(bf2f(o[idx]) * v); }
            }
        }
}

__device__ void gemm_job(const GemmJob& gj, int& rot, char* smem) {
#ifdef NO_GEMM
    return;
#endif
    const bf16_t* A = gj.A; const bf16_t* W = gj.W; const int lda = gj.lda, K = gj.K, M = gj.M, N = gj.N; const Epi& e = gj.e;
    const int tid = opaque_tid(), lane = tid & 63, wave = tid >> 6, wm = wave >> 2, wn = wave & 3;
    const int ntn = (N + 255) >> 8, ntm = M >> 8, KT = K >> 6, G = gridDim.x;
    bf16_t* sA = (bf16_t*)smem;
    bf16_t* sB = sA + 2 * 256 * 72;
    const int half = lane >> 5, l31 = lane & 31;
    const int bp = (blockIdx.x + G - rot) % G;
    const bool xmap = (ntm & 7) == 0;
    const int xcd = bp & 7, li = bp >> 3, GL = G >> 3, mpx = ntm >> 3, mgsz = mpx < 8 ? (mpx > 0 ? mpx : 1) : 8, gsz = mgsz * ntn;
    const int tcount = xmap ? mpx * ntn : ntm * ntn, tstart = xmap ? li : bp, tstep = xmap ? GL : G;
    for (int idx = tstart; idx < tcount; idx += tstep) {
        int tm, tn;
        if (xmap) { const int grp = idx / gsz, rem = idx - grp * gsz; tn = rem / mgsz; tm = xcd * mpx + grp * mgsz + (rem - tn * mgsz); }
        else { tm = idx / ntn; tn = idx - tm * ntn; }
        const int m0 = tm << 8, n0 = tn << 8;
        const bool wact = (n0 + wn * 64) < N;
        f32x16 acc[4][2];
#pragma unroll
        for (int a = 0; a < 4; ++a)
#pragma unroll
            for (int b = 0; b < 2; ++b)
#pragma unroll
                for (int i = 0; i < 16; ++i) acc[a][b][i] = 0.f;
        u32x4 ra[4], rb[4];
        const char* Ab = (const char*)(A + (size_t)m0 * lda);
        const char* Wb = (const char*)(W + (size_t)n0 * K);
        const unsigned aoff = (unsigned)(((tid >> 3) * lda + (tid & 7) * 8) * 2), woff = (unsigned)(((tid >> 3) * K + (tid & 7) * 8) * 2);
#define GLOAD_TILE(KT_) { _Pragma("unroll") for (int i = 0; i < 4; ++i) { \
            ra[i] = *(const u32x4*)(Ab + ((size_t)(64 * i) * lda + (size_t)(KT_) * 64) * 2 + aoff); \
            rb[i] = *(const u32x4*)(Wb + ((size_t)(64 * i) * K + (size_t)(KT_) * 64) * 2 + woff); } }
        GLOAD_TILE(0)
        const int lofs = (tid >> 3) * 72 + (tid & 7) * 8;
#pragma unroll
        for (int i = 0; i < 4; ++i) { *(u32x4*)(sA + lofs + 64 * i * 72) = ra[i]; *(u32x4*)(sB + lofs + 64 * i * 72) = rb[i]; }
        if (KT > 1) GLOAD_TILE(1)
        __syncthreads();
        for (int kt = 0; kt < KT; ++kt) {
            const int buf = kt & 1;
            if (kt + 1 < KT) {
                bf16_t* da = sA + (buf ^ 1) * 256 * 72 + lofs; bf16_t* db = sB + (buf ^ 1) * 256 * 72 + lofs;
#pragma unroll
                for (int i = 0; i < 4; ++i) { *(u32x4*)(da + 64 * i * 72) = ra[i]; *(u32x4*)(db + 64 * i * 72) = rb[i]; }
            }
            if (kt + 2 < KT) GLOAD_TILE(kt + 2)
            if (wact) {
                const bf16_t* a_ = sA + buf * 256 * 72 + (wm * 128 + l31) * 72 + half * 8;
                const bf16_t* b_ = sB + buf * 256 * 72 + (wn * 64 + l31) * 72 + half * 8;
#define LDF(P_, O_) (*(const bf16x8*)((P_) + (O_)))
#define MM(I_, J_, AF, BF) acc[I_][J_] = __builtin_amdgcn_mfma_f32_32x32x16_bf16(AF, BF, acc[I_][J_], 0, 0, 0);
                bf16x8 b0 = LDF(b_, 0), b1 = LDF(b_, 32 * 72), a0 = LDF(a_, 0), a1 = LDF(a_, 32 * 72), a2, a3;
#pragma unroll
                for (int kk = 0; kk < 4; ++kk) {
                    a2 = LDF(a_, 64 * 72 + kk * 16); a3 = LDF(a_, 96 * 72 + kk * 16);
                    __builtin_amdgcn_sched_barrier(0);
                    MM(0, 0, a0, b0) MM(0, 1, a0, b1) MM(1, 0, a1, b0) MM(1, 1, a1, b1)
                    __builtin_amdgcn_sched_barrier(0);
                    if (kk < 3) { a0 = LDF(a_, (kk + 1) * 16); a1 = LDF(a_, 32 * 72 + (kk + 1) * 16); }
                    bf16x8 c0 = b0, c1 = b1;
                    if (kk < 3) { b0 = LDF(b_, (kk + 1) * 16); b1 = LDF(b_, 32 * 72 + (kk + 1) * 16); }
                    __builtin_amdgcn_sched_barrier(0);
                    MM(2, 0, a2, c0) MM(2, 1, a2, c1) MM(3, 0, a3, c0) MM(3, 1, a3, c1)
                    __builtin_amdgcn_sched_barrier(0);
                }
#undef LDF
#undef MM
            }
            __syncthreads();
        }
#undef GLOAD_TILE
        if (wact) {
            switch (gj.kind) {
            case E_BF16: epilogue<E_BF16, 4>(acc, m0, n0, wm, wn, lane, e); break;
            case E_F32: epilogue<E_F32, 4>(acc, m0, n0, wm, wn, lane, e); break;
            case E_RESID: epilogue<E_RESID, 4>(acc, m0, n0, wm, wn, lane, e); break;
            case E_SWIGLU: epilogue<E_SWIGLU, 4>(acc, m0, n0, wm, wn, lane, e); break;
            case E_DECAY: epilogue<E_DECAY, 4>(acc, m0, n0, wm, wn, lane, e); break;
            case E_SIGB: epilogue<E_SIGB, 4>(acc, m0, n0, wm, wn, lane, e); break;
            case E_KV: epilogue<E_KV, 4>(acc, m0, n0, wm, wn, lane, e); break;
            case E_MEMKV: epilogue<E_MEMKV, 4>(acc, m0, n0, wm, wn, lane, e); break;
            default: epilogue<E_MULG, 4>(acc, m0, n0, wm, wn, lane, e); break;
            }
        }
    }
    rot = (rot + (xmap ? 8 * (tcount % GL) : tcount) ) % G;
}

template <int DQK, bool CAUSAL>
__device__ void attn_phase(const bf16_t* Q, int ldq, int qcol0, const bf16_t* Kb, size_t k_bh_stride, const bf16_t* VT, size_t vt_bh_stride, int vt_ld,
                           int nheads, int nkeys, const float* rope, float scl, bf16_t* O, int ldo, int ocol0, int& rot, char* smem, int vb, int G) {
#ifdef NO_ATTN
    return;
#endif

    constexpr int KS = DQK + 8, NKK = DQK / 16, KCH = DQK / 8, NCH = 64 * KCH, NKL = (NCH + NT - 1) / NT;
    const int tid = opaque_tid(), lane = tid & 63, wave = tid >> 6, half = lane >> 5, l31 = lane & 31;
    const int xaddr = (lane ^ 32) << 2;
    bf16_t* sK = (bf16_t*)smem;
    bf16_t* sV = sK + 2 * 64 * KS;
    const int nbh = 4 * nheads, upx = (nbh >> 3) * 32;
    const int bp = (vb + G - rot) % G, xcd = bp & 7, li = bp >> 3, GL = G >> 3;
    for (int idx = li; idx < upx; idx += GL) {
        const int hr = idx >> 5, qi = idx & 31, qb = (hr & 1) ? 31 - qi : qi, bh = xcd + 8 * hr, b = bh / nheads, h = bh - b * nheads;
        const int q0 = qb * 256 + wave * 32, q = q0 + l31;
        const size_t tokq = (size_t)b * S + q;
        bf16x8 qf[NKK];
        { const bf16_t* qp = Q + tokq * ldq + qcol0 + h * DQK + half * 8;
#pragma unroll
          for (int kk = 0; kk < NKK; ++kk) qf[kk] = *(const bf16x8*)(qp + kk * 16); }
        if (rope) {
            const float* rp = rope + tokq * 32 + half * 8;
            const float4 c0 = *(const float4*)rp, c1 = *(const float4*)(rp + 4), s0 = *(const float4*)(rp + 16), s1 = *(const float4*)(rp + 20);
            u32x4 qa = __builtin_bit_cast(u32x4, qf[NKK - 2]), qb_ = __builtin_bit_cast(u32x4, qf[NKK - 1]);
#define ROT2(D, CA, SA, CB, SB) { const float x1l = bflo(qa[D]), x1h = bfhi(qa[D]), x2l = bflo(qb_[D]), x2h = bfhi(qb_[D]); \
              qa[D] = pk2(x1l * CA - x2l * SA, x1h * CB - x2h * SB); qb_[D] = pk2(x2l * CA + x1l * SA, x2h * CB + x1h * SB); }
            ROT2(0, c0.x, s0.x, c0.y, s0.y) ROT2(1, c0.z, s0.z, c0.w, s0.w) ROT2(2, c1.x, s1.x, c1.y, s1.y) ROT2(3, c1.z, s1.z, c1.w, s1.w)
#undef ROT2
            qf[NKK - 2] = __builtin_bit_cast(bf16x8, qa); qf[NKK - 1] = __builtin_bit_cast(bf16x8, qb_);
        }
        const int ntiles = CAUSAL ? (qb * 4 + 4) : (nkeys >> 6);
        f32x16 o[2];
#pragma unroll
        for (int a = 0; a < 2; ++a)
#pragma unroll
            for (int i = 0; i < 16; ++i) o[a][i] = 0.f;
        float m = -1e30f, l = 0.f;
        const bf16_t* Kg = Kb + (size_t)bh * k_bh_stride;
        const bf16_t* Vg = VT + (size_t)bh * vt_bh_stride + (size_t)(tid >> 3) * vt_ld + (tid & 7) * 8;
        u32x4 rk[NKL], rv[1];
#pragma unroll
        for (int i = 0; i < NKL; ++i) { const int c = tid + NT * i; if (c < NCH) rk[i] = *(const u32x4*)(Kg + (size_t)c * 8); }
        rv[0] = *(const u32x4*)(Vg);
#pragma unroll
        for (int i = 0; i < NKL; ++i) { const int c = tid + NT * i; if (c < NCH) *(u32x4*)(sK + (c / KCH) * KS + (c % KCH) * 8) = rk[i]; }
        *(u32x4*)(sV + (tid >> 3) * 72 + (tid & 7) * 8) = rv[0];
        __syncthreads();
        for (int kt = 0; kt < ntiles; ++kt) {
            const int buf = kt & 1;
            if (kt + 1 < ntiles) {
#pragma unroll
                for (int i = 0; i < NKL; ++i) { const int c = tid + NT * i; if (c < NCH) rk[i] = *(const u32x4*)(Kg + (size_t)(kt + 1) * 64 * DQK + (size_t)c * 8); }
                rv[0] = *(const u32x4*)(Vg + (kt + 1) * 64);
            }
            if (!CAUSAL || kt * 64 <= q0 + 31) {
                const bf16_t* kb_ = sK + buf * 64 * KS + l31 * KS + half * 8;
                const bf16_t* vb_ = sV + buf * 64 * 72 + l31 * 72 + 4 * half;
                f32x16 s[2];
                bf16x8 kf0[NKK], kf1[NKK];
                __builtin_amdgcn_sched_barrier(0);
#pragma unroll
                for (int kk = 0; kk < NKK; ++kk) kf0[kk] = *(const bf16x8*)(kb_ + kk * 16);
#pragma unroll
                for (int kk = 0; kk < NKK; ++kk) kf1[kk] = *(const bf16x8*)(kb_ + 32 * KS + kk * 16);
                __builtin_amdgcn_sched_barrier(0);
#pragma unroll
                for (int i = 0; i < 16; ++i) { s[0][i] = 0.f; s[1][i] = 0.f; }
#pragma unroll
                for (int kk = 0; kk < NKK; ++kk) s[0] = __builtin_amdgcn_mfma_f32_32x32x16_bf16(kf0[kk], qf[kk], s[0], 0, 0, 0);
#pragma unroll
                for (int kk = 0; kk < NKK; ++kk) s[1] = __builtin_amdgcn_mfma_f32_32x32x16_bf16(kf1[kk], qf[kk], s[1], 0, 0, 0);
                uint2 vfr[2][2][2][2];
#pragma unroll
                for (int kb = 0; kb < 2; ++kb)
#pragma unroll
                    for (int g = 0; g < 2; ++g)
#pragma unroll
                        for (int db = 0; db < 2; ++db) {
                            const bf16_t* vp = vb_ + db * 32 * 72 + kb * 32 + 16 * g;
                            vfr[kb][g][db][0] = *(const uint2*)vp; vfr[kb][g][db][1] = *(const uint2*)(vp + 8);
                        }
                __builtin_amdgcn_sched_barrier(0);
                if (CAUSAL && kt * 64 + 63 > q0) {
#pragma unroll
                    for (int kb = 0; kb < 2; ++kb)
#pragma unroll
                        for (int i = 0; i < 16; ++i) { const int key = kt * 64 + kb * 32 + 8 * (i >> 2) + 4 * half + (i & 3); if (key > q) s[kb][i] = -1e30f; }
                }
                float mx = s[0][0];
#pragma unroll
                for (int kb = 0; kb < 2; ++kb)
#pragma unroll
                    for (int i = 0; i < 16; ++i) mx = fmaxf(mx, s[kb][i]);
                mx = fmaxf(mx, __int_as_float(__builtin_amdgcn_ds_bpermute(xaddr, __float_as_int(mx))));
                const float mn = fmaxf(m, mx), alpha = __builtin_amdgcn_exp2f((m - mn) * scl), mc = mn * scl;
                m = mn;
                f32x2 ls2 = {0.f, 0.f};
                const f32x2 scl2 = {scl, scl}, nmc2 = {-mc, -mc};
#pragma unroll
                for (int kb = 0; kb < 2; ++kb)
#pragma unroll
                    for (int i = 0; i < 16; i += 2) {
                        const f32x2 t = __builtin_elementwise_fma((f32x2){s[kb][i], s[kb][i + 1]}, scl2, nmc2);
                        const f32x2 pv = {__builtin_amdgcn_exp2f(t[0]), __builtin_amdgcn_exp2f(t[1])};
                        s[kb][i] = pv[0]; s[kb][i + 1] = pv[1]; ls2 += pv;
                    }
                const float ls = ls2[0] + ls2[1];
                l = l * alpha + ls;
#pragma unroll
                for (int a = 0; a < 2; ++a)
#pragma unroll
                    for (int i = 0; i < 16; ++i) o[a][i] *= alpha;
#pragma unroll
                for (int kb = 0; kb < 2; ++kb)
#pragma unroll
                    for (int g = 0; g < 2; ++g) {
                        u32x4 pu;
#pragma unroll
                        for (int j = 0; j < 4; ++j) pu[j] = pk2(s[kb][8 * g + 2 * j], s[kb][8 * g + 2 * j + 1]);
                        const bf16x8 pf = __builtin_bit_cast(bf16x8, pu);
#pragma unroll
                        for (int db = 0; db < 2; ++db) {
                            u32x4 vu; vu[0] = vfr[kb][g][db][0].x; vu[1] = vfr[kb][g][db][0].y; vu[2] = vfr[kb][g][db][1].x; vu[3] = vfr[kb][g][db][1].y;
                            o[db] = __builtin_amdgcn_mfma_f32_32x32x16_bf16(__builtin_bit_cast(bf16x8, vu), pf, o[db], 0, 0, 0);
                        }
                    }
            }
            if (kt + 1 < ntiles) {
                bf16_t* dk = sK + (buf ^ 1) * 64 * KS; bf16_t* dv = sV + (buf ^ 1) * 64 * 72;
#pragma unroll
                for (int i = 0; i < NKL; ++i) { const int c = tid + NT * i; if (c < NCH) *(u32x4*)(dk + (c / KCH) * KS + (c % KCH) * 8) = rk[i]; }
                *(u32x4*)(dv + (tid >> 3) * 72 + (tid & 7) * 8) = rv[0];
            }
            __syncthreads();
        }
        l += __int_as_float(__builtin_amdgcn_ds_bpermute(xaddr, __float_as_int(l)));
        const float inv = 1.f / l;
        bf16_t* op = O + tokq * ldo + ocol0 + h * 64 + 4 * half;
#pragma unroll
        for (int db = 0; db < 2; ++db)
#pragma unroll
            for (int g = 0; g < 4; ++g) {
                uint2 w; w.x = pk2(o[db][4 * g] * inv, o[db][4 * g + 1] * inv); w.y = pk2(o[db][4 * g + 2] * inv, o[db][4 * g + 3] * inv);
                *(uint2*)(op + db * 32 + 8 * g) = w;
            }
    }
    rot = (rot + 8 * (upx % GL)) % G;
}

__device__ void lora_in_phase(const Params& p, int layer) {
#ifdef NO_LIN
    return;
#endif

    const bf16_t* P = (const bf16_t*)(p.ws + WS_P); bf16_t* LIN = (bf16_t*)(p.ws + WS_LIN);
    const float* mu = p.in[6] + (size_t)layer * 2560 + 2304;
    const int tid_ = opaque_tid(), lane = tid_ & 63, gw = blockIdx.x * NWV + (tid_ >> 6), nw = gridDim.x * NWV;
    const float4 m4 = *(const float4*)(mu + lane * 4);
    for (int tok = gw; tok < T; tok += nw) {
        const int s = tok & (S - 1);
        const uint2 c = *(const uint2*)(P + (size_t)tok * LDP + 2304 + lane * 4);
        uint2 pv; pv.x = 0; pv.y = 0;
        if (s) pv = *(const uint2*)(P + (size_t)(tok - 1) * LDP + 2304 + lane * 4);
        float v0 = bflo(c.x), v1 = bfhi(c.x), v2 = bflo(c.y), v3 = bfhi(c.y);
        v0 += (bflo(pv.x) - v0) * m4.x; v1 += (bfhi(pv.x) - v1) * m4.y; v2 += (bflo(pv.y) - v2) * m4.z; v3 += (bfhi(pv.y) - v3) * m4.w;
        if (lane < 16) { v0 = tanhf(v0); v1 = tanhf(v1); v2 = tanhf(v2); v3 = tanhf(v3); }
        else if (lane >= 32) { v0 = sigmoidf_(v0); v1 = sigmoidf_(v1); v2 = sigmoidf_(v2); v3 = sigmoidf_(v3); }
        uint2 w; w.x = pk2(v0, v1); w.y = pk2(v2, v3);
        *(uint2*)(LIN + (size_t)tok * 320 + lane * 4) = w;
        if (layer == 1) {
            float vd = 0.f;
            if (lane < 32) { vd = bf2f(P[(size_t)tok * LDP + 2816 + lane]); if (s) vd += bf2f(P[(size_t)(tok - 1) * LDP + 2848 + lane]); }
            LIN[(size_t)tok * 320 + 256 + lane] = f2bf(vd);
        }
    }
}

__device__ void prep_phase(const Params& p, int layer) {
#ifdef NO_PREP
    return;
#endif

    bf16_t* P = (bf16_t*)(p.ws + WS_P);
    bf16_t* Z2 = (bf16_t*)(p.ws + WS_Z + ZSZ);
    bf16_t* Z3 = (bf16_t*)(p.ws + WS_Z + 2 * ZSZ);
    bf16_t* Z4 = (bf16_t*)(p.ws + WS_Z + 3 * ZSZ);
    const bf16_t* HALO = (const bf16_t*)(p.ws + WS_HALO);
    float* RK = (float*)(p.ws + WS_RK);
    const float* mu = p.in[6] + (size_t)layer * 2560;
    const float* kkw = p.in[12] + (size_t)layer * 768; const float* kaw = p.in[13] + (size_t)layer * 768; const float* rkw = p.in[14] + (size_t)layer * 768;
    const int tid = opaque_tid(), tokl = tid >> 4, cg4 = (tid & 15) * 4;
    struct HL { u32x2 cr, ck, cv, qr, qk, qv, lr2, vs2, vf2; };
    for (int u = blockIdx.x; u < 256 * 4; u += gridDim.x) {
        const int mt = u >> 2, h0 = (u & 3) * 3, m0 = mt * 128;
        for (int it = 3; it >= 0; --it) {
            const int tok = m0 + it * 32 + tokl, s = tok & (S - 1);
            const bool useh = (it == 0 && tokl == 0);
            auto load = [&](HL& L, int h) {
                const int hc = h * 64 + cg4;
                const bf16_t* pr = P + (size_t)tok * LDP + hc;
                L.cr = *(const u32x2*)pr; L.ck = *(const u32x2*)(pr + 768); L.cv = *(const u32x2*)(pr + 1536);
                L.qr = (u32x2){0u, 0u}; L.qk = L.qr; L.qv = L.qr;
                if (s) {
                    const bf16_t* pp = useh ? (HALO + (size_t)(mt - 1) * LDP + hc) : (P + (size_t)(tok - 1) * LDP + hc);
                    L.qr = *(const u32x2*)pp; L.qk = *(const u32x2*)(pp + 768); L.qv = *(const u32x2*)(pp + 1536);
                }
                const size_t zi = (size_t)tok * 768 + hc;
                L.lr2 = *(const u32x2*)(Z2 + zi);
                L.vs2 = (u32x2){0u, 0u}; L.vf2 = L.vs2;
                if (layer == 1) { L.vs2 = *(const u32x2*)(Z3 + zi); L.vf2 = *(const u32x2*)(Z4 + zi); }
            };
            auto comp = [&](const HL& L, int h) {
                const int hc = h * 64 + cg4;
                bf16_t* pr = P + (size_t)tok * LDP + hc;
                const size_t zi = (size_t)tok * 768 + hc;
                const float4 mur = *(const float4*)(mu + hc), muk = *(const float4*)(mu + 768 + hc), muv = *(const float4*)(mu + 1536 + hc);
                const float4 kkw4 = *(const float4*)(kkw + hc), kaw4 = *(const float4*)(kaw + hc), rkw4 = *(const float4*)(rkw + hc);
                float r[4] = {bflo(L.cr[0]), bfhi(L.cr[0]), bflo(L.cr[1]), bfhi(L.cr[1])}, k[4] = {bflo(L.ck[0]), bfhi(L.ck[0]), bflo(L.ck[1]), bfhi(L.ck[1])}, v[4] = {bflo(L.cv[0]), bfhi(L.cv[0]), bflo(L.cv[1]), bfhi(L.cv[1])};
                const float rp[4] = {bflo(L.qr[0]), bfhi(L.qr[0]), bflo(L.qr[1]), bfhi(L.qr[1])}, kp[4] = {bflo(L.qk[0]), bfhi(L.qk[0]), bflo(L.qk[1]), bfhi(L.qk[1])}, vp[4] = {bflo(L.qv[0]), bfhi(L.qv[0]), bflo(L.qv[1]), bfhi(L.qv[1])};
                const float mr[4] = {mur.x, mur.y, mur.z, mur.w}, mk[4] = {muk.x, muk.y, muk.z, muk.w}, mv[4] = {muv.x, muv.y, muv.z, muv.w};
                const float lr[4] = {bflo(L.lr2[0]), bfhi(L.lr2[0]), bflo(L.lr2[1]), bfhi(L.lr2[1])};
                const float vs[4] = {bflo(L.vs2[0]), bfhi(L.vs2[0]), bflo(L.vs2[1]), bfhi(L.vs2[1])}, vf[4] = {bflo(L.vf2[0]), bfhi(L.vf2[0]), bflo(L.vf2[1]), bfhi(L.vf2[1])};
                const float kkw_[4] = {kkw4.x, kkw4.y, kkw4.z, kkw4.w}, kaw_[4] = {kaw4.x, kaw4.y, kaw4.z, kaw4.w}, rkw_[4] = {rkw4.x, rkw4.y, rkw4.z, rkw4.w};
                float kk[4], n2 = 0.f, rks = 0.f, bb[4];
#pragma unroll
                for (int j = 0; j < 4; ++j) {
                    r[j] += (rp[j] - r[j]) * mr[j]; k[j] += (kp[j] - k[j]) * mk[j]; v[j] += (vp[j] - v[j]) * mv[j];
                    if (layer == 1) v[j] += (vf[j] - v[j]) * vs[j];
                    kk[j] = k[j] * kkw_[j]; n2 += kk[j] * kk[j];
                    k[j] = k[j] * (1.f + (lr[j] - 1.f) * kaw_[j]);
                    rks += r[j] * k[j] * rkw_[j];
                }
                n2 = reduce16(n2); rks = reduce16(rks);
                const float inv = 1.f / fmaxf(sqrtf(n2), 1e-12f);
#pragma unroll
                for (int j = 0; j < 4; ++j) { kk[j] *= inv; bb[j] = kk[j] * lr[j]; }
                u32x2 w;
                w[0] = pk2(r[0], r[1]); w[1] = pk2(r[2], r[3]); *(u32x2*)pr = w;
                w[0] = pk2(k[0], k[1]); w[1] = pk2(k[2], k[3]); *(u32x2*)(pr + 768) = w;
                w[0] = pk2(v[0], v[1]); w[1] = pk2(v[2], v[3]); *(u32x2*)(pr + 1536) = w;
                if (layer == 0) *(u32x2*)(Z4 + zi) = w;
                w[0] = pk2(bb[0], bb[1]); w[1] = pk2(bb[2], bb[3]); *(u32x2*)(Z2 + zi) = w;
                w[0] = pk2(kk[0], kk[1]); w[1] = pk2(kk[2], kk[3]); *(u32x2*)(Z3 + zi) = w;
                if ((tid & 15) == 0) RK[(size_t)tok * 12 + h] = rks;
            };
            HL La, Lb, Lc;
            load(La, h0); load(Lb, h0 + 1); load(Lc, h0 + 2);
            __syncthreads();
            comp(La, h0); comp(Lb, h0 + 1); comp(Lc, h0 + 2);
        }
        __syncthreads();
    }
}

__device__ void scan_phase(const Params& p, char* smem) {
#ifdef NO_SCAN
    return;
#endif
    const bf16_t* P = (const bf16_t*)(p.ws + WS_P);
    const _Float16* E = (const _Float16*)(p.ws + WS_Z);
    const bf16_t* Bv = (const bf16_t*)(p.ws + WS_Z + ZSZ);
    const bf16_t* KK = (const bf16_t*)(p.ws + WS_Z + 2 * ZSZ);
    bf16_t* Y = (bf16_t*)(p.ws + WS_H);
    constexpr int BUFF = 11264;
    float* sBase = (float*)smem; float* sYp = sBase + 2 * BUFF;
    const int tid = opaque_tid(), lane = tid & 63, wave = tid >> 6;
    const bool comp = wave < 4;
    const int row = (wave & 3) * 4 + (lane >> 4), kg = lane & 15;
    const int stid = tid & 255, st_l = stid >> 3, c8 = (stid & 7) * 8;
    for (int u = blockIdx.x; u < 192; u += gridDim.x) {
        const int b = u / 48, h = (u % 48) >> 2, qt = u & 3;
        const size_t tok0 = (size_t)b * S;
        f32x2 S01 = {0.f, 0.f}, S23 = {0.f, 0.f};
        u32x4 gr, gk, ga, gb, gv = {0u, 0u, 0u, 0u}; h8 ge;
        auto gload = [&](int ch) {
            const size_t tok = tok0 + ch * 32 + st_l;
            gr = *(const u32x4*)(P + tok * LDP + h * 64 + c8);
            gk = *(const u32x4*)(P + tok * LDP + 768 + h * 64 + c8);
            ga = *(const u32x4*)(KK + tok * 768 + h * 64 + c8);
            gb = *(const u32x4*)(Bv + tok * 768 + h * 64 + c8);
            ge = *(const h8*)(E + tok * 768 + h * 64 + c8);
            if (stid < 64) { const size_t tk = tok0 + ch * 32 + (stid >> 1); gv = *(const u32x4*)(P + tk * LDP + 1536 + h * 64 + qt * 16 + (stid & 1) * 8); }
        };
        auto st4 = [&](float* dst, const u32x4& g) {
            f32x4 a, c; a[0] = bflo(g[0]); a[1] = bfhi(g[0]); a[2] = bflo(g[1]); a[3] = bfhi(g[1]); c[0] = bflo(g[2]); c[1] = bfhi(g[2]); c[2] = bflo(g[3]); c[3] = bfhi(g[3]);
            *(f32x4*)dst = a; *(f32x4*)(dst + 4) = c;
        };
        auto stage = [&](float* buf) {
            const int o = st_l * 64 + c8;
            st4(buf + 8192 + o, gr); st4(buf + 2048 + o, gk); st4(buf + 4096 + o, ga); st4(buf + 6144 + o, gb);
            f32x4 a, c; a[0] = __expf(-(float)ge[0]); a[1] = __expf(-(float)ge[1]); a[2] = __expf(-(float)ge[2]); a[3] = __expf(-(float)ge[3]);
            c[0] = __expf(-(float)ge[4]); c[1] = __expf(-(float)ge[5]); c[2] = __expf(-(float)ge[6]); c[3] = __expf(-(float)ge[7]);
            *(f32x4*)(buf + o) = a; *(f32x4*)(buf + o + 4) = c;
            if (stid < 64) st4(buf + 10240 + (stid >> 1) * 16 + (stid & 1) * 8, gv);
        };
        auto flush = [&](const float* buf, int ch) {
            if (stid < 64) {
                const float* yp = buf + 10752 + (stid >> 1) * 16 + (stid & 1) * 8;
                const f32x4 a = *(const f32x4*)yp, c = *(const f32x4*)(yp + 4);
                u32x4 w; w[0] = pk2(a[0], a[1]); w[1] = pk2(a[2], a[3]); w[2] = pk2(c[0], c[1]); w[3] = pk2(c[2], c[3]);
                *(u32x4*)(Y + (tok0 + ch * 32 + (stid >> 1)) * 1024 + h * 64 + qt * 16 + (stid & 1) * 8) = w;
            }
        };
        if (!comp) { gload(0); stage(sBase); gload(1); }
        __syncthreads();
        for (int ch = 0; ch < 256; ++ch) {
            float* bufc = sBase + (ch & 1) * BUFF; float* bufo = sBase + ((ch & 1) ^ 1) * BUFF;
            if (comp) {
                float* sY = bufc + 10752;
                unsigned a_cur = (unsigned)(size_t)(LAS char*)(bufc + kg * 4), v_cur = (unsigned)(size_t)(LAS char*)(bufc + 10240 + row);
                f32x4 w0, k0, a0, b0, r0, w1, k1, a1, b1, r1, w2, k2, a2, b2, r2, w3, k3, a3, b3, r3; float v0, v1, v2, v3;
#define SCAN_LOAD(W, K, A, B, R, V, AD, VD) asm volatile("ds_read_b128 %0, %6\n\tds_read_b128 %1, %6 offset:8192\n\tds_read_b128 %2, %6 offset:16384\n\tds_read_b128 %3, %6 offset:24576\n\tds_read_b128 %4, %6 offset:32768\n\tds_read_b32 %5, %7" \
                    : "=&v"(W), "=&v"(K), "=&v"(A), "=&v"(B), "=&v"(R), "=&v"(V) : "v"(AD), "v"(VD) : "memory")
#define SCAN_WAIT(W, K, A, B, R, V, DEP) asm volatile("s_waitcnt lgkmcnt(6)" : "+v"(W), "+v"(K), "+v"(A), "+v"(B), "+v"(R), "+v"(V), "+v"(DEP) :: "memory")
#define SCAN_WAIT0(W, K, A, B, R, V, DEP) asm volatile("s_waitcnt lgkmcnt(0)" : "+v"(W), "+v"(K), "+v"(A), "+v"(B), "+v"(R), "+v"(V), "+v"(DEP) :: "memory")
#define SCAN_STEP(W, K, A, B, R, V, YV) { \
                    f32x2 t = S01 * (f32x2){A[0], A[1]}; t = __builtin_elementwise_fma(S23, (f32x2){A[2], A[3]}, t); \
                    const float d = reduce16(t[0] + t[1]); const f32x2 sa2 = {-d, -d}, v2_ = {V, V}; \
                    const f32x2 u01 = __builtin_elementwise_fma(sa2, (f32x2){B[0], B[1]}, v2_ * (f32x2){K[0], K[1]}); \
                    const f32x2 u23 = __builtin_elementwise_fma(sa2, (f32x2){B[2], B[3]}, v2_ * (f32x2){K[2], K[3]}); \
                    S01 = __builtin_elementwise_fma(S01, (f32x2){W[0], W[1]}, u01); S23 = __builtin_elementwise_fma(S23, (f32x2){W[2], W[3]}, u23); \
                    f32x2 y2 = S01 * (f32x2){R[0], R[1]}; y2 = __builtin_elementwise_fma(S23, (f32x2){R[2], R[3]}, y2); \
                    YV = y2[0] + y2[1]; }
                SCAN_LOAD(w0, k0, a0, b0, r0, v0, a_cur, v_cur);
                { const unsigned an = a_cur + 256, vn = v_cur + 64; SCAN_LOAD(w1, k1, a1, b1, r1, v1, an, vn); }
                float yv = 0.f;
                float* ypw = sYp + row * 16 + kg;
#pragma unroll 1
                for (int q = 0; q < 8; ++q) {
                    const int sb = (q & 3) * 4;
                    SCAN_WAIT(w0, k0, a0, b0, r0, v0, yv);
                    { const unsigned an = a_cur + 512, vn = v_cur + 128; SCAN_LOAD(w2, k2, a2, b2, r2, v2, an, vn); }
                    SCAN_STEP(w0, k0, a0, b0, r0, v0, yv)
                    ypw[sb * 256] = yv;
                    SCAN_WAIT(w1, k1, a1, b1, r1, v1, yv);
                    { const unsigned an = a_cur + 768, vn = v_cur + 192; SCAN_LOAD(w3, k3, a3, b3, r3, v3, an, vn); }
                    SCAN_STEP(w1, k1, a1, b1, r1, v1, yv)
                    ypw[(sb + 1) * 256] = yv;
                    SCAN_WAIT(w2, k2, a2, b2, r2, v2, yv);
                    a_cur += 1024; v_cur += 256;
                    SCAN_LOAD(w0, k0, a0, b0, r0, v0, a_cur, v_cur);
                    SCAN_STEP(w2, k2, a2, b2, r2, v2, yv)
                    ypw[(sb + 2) * 256] = yv;
                    SCAN_WAIT(w3, k3, a3, b3, r3, v3, yv);
                    { const unsigned an = a_cur + 256, vn = v_cur + 64; SCAN_LOAD(w1, k1, a1, b1, r1, v1, an, vn); }
                    SCAN_STEP(w3, k3, a3, b3, r3, v3, yv)
                    ypw[(sb + 3) * 256] = yv;
                    if ((q & 3) == 3) {
                        const int hh = q >> 2, stp = lane >> 2, rw_ = (wave & 3) * 4 + (lane & 3);
                        const f32x4* pp = (const f32x4*)(sYp + stp * 256 + rw_ * 16);
                        const f32x4 q0 = pp[0], q1 = pp[1], q2 = pp[2], q3 = pp[3];
                        const float ysum = ((q0[0] + q0[1]) + (q0[2] + q0[3])) + ((q1[0] + q1[1]) + (q1[2] + q1[3])) + ((q2[0] + q2[1]) + (q2[2] + q2[3])) + ((q3[0] + q3[1]) + (q3[2] + q3[3]));
                        sY[(hh * 16 + stp) * 16 + rw_] = ysum;
                    }
                }
                SCAN_WAIT0(w0, k0, a0, b0, r0, v0, yv);
                SCAN_WAIT0(w1, k1, a1, b1, r1, v1, yv);
#undef SCAN_WAIT0
#undef SCAN_LOAD
#undef SCAN_WAIT
#undef SCAN_STEP
            } else {
                if (ch > 0) flush(bufo, ch - 1);
                if (ch + 1 < 256) { stage(bufo); if (ch + 2 < 256) gload(ch + 2); }
            }
            __syncthreads();
        }
        if (!comp) flush(sBase + BUFF, 255);
        __syncthreads();
    }
}

__device__ void post_phase(const Params& p, int layer) {
#ifdef NO_POST
    return;
#endif

    bf16_t* H = (bf16_t*)(p.ws + WS_H); const bf16_t* P = (const bf16_t*)(p.ws + WS_P); const float* RK = (const float*)(p.ws + WS_RK);
    const float* lg = p.in[15] + (size_t)layer * 768; const float* lb = p.in[16] + (size_t)layer * 768;
    const int tid = opaque_tid(), cg4 = (tid & 15) * 4;
    const int npairs = T * 12;
    for (int pr = blockIdx.x * (NT / 16) + (tid >> 4); pr < npairs; pr += gridDim.x * (NT / 16)) {
        const int tok = pr / 12, h = pr - tok * 12, hc = h * 64 + cg4;
        bf16_t* yp = H + (size_t)tok * 1024 + hc;
        const uint2 y2 = *(const uint2*)yp, v2 = *(const uint2*)(P + (size_t)tok * LDP + 1536 + hc);
        const float y[4] = {bflo(y2.x), bfhi(y2.x), bflo(y2.y), bfhi(y2.y)}, v[4] = {bflo(v2.x), bfhi(v2.x), bflo(v2.y), bfhi(v2.y)};
        const float mean = reduce16((y[0] + y[1]) + (y[2] + y[3])) * (1.f / 64.f);
        float q = 0.f;
#pragma unroll
        for (int j = 0; j < 4; ++j) { const float d = y[j] - mean; q += d * d; }
        const float rstd = rsqrtf(reduce16(q) * (1.f / 64.f) + 64e-5f);
        const float rk = RK[(size_t)tok * 12 + h];
        const float4 g4 = *(const float4*)(lg + hc), b4 = *(const float4*)(lb + hc);
        const float g[4] = {g4.x, g4.y, g4.z, g4.w}, bb[4] = {b4.x, b4.y, b4.z, b4.w};
        float o[4];
#pragma unroll
        for (int j = 0; j < 4; ++j) o[j] = (y[j] - mean) * rstd * g[j] + bb[j] + rk * v[j];
        uint2 w; w.x = pk2(o[0], o[1]); w.y = pk2(o[2], o[3]);
        *(uint2*)yp = w;
    }
}

__device__ void subnorm_phase(const Params& p, int j) {
#ifdef NO_SUB
    return;
#endif

    const bf16_t* PB = (const bf16_t*)(p.ws + WS_PROJB); bf16_t* CQ = (bf16_t*)(p.ws + WS_CQ);
    const float* CKR = (const float*)(p.ws + WS_CKR); bf16_t* CKV = (bf16_t*)(p.ws + WS_CKV); bf16_t* KF = (bf16_t*)(p.ws + WS_KFULL);
    const float* rope = (const float*)(p.ws + WS_ROPE);
    const float* gq = p.in[32] + (size_t)j * 512; const float* gl = p.in[28];
    const int tid_ = opaque_tid(), lane = tid_ & 63, gw = blockIdx.x * NWV + (tid_ >> 6), nw = gridDim.x * NWV;
    for (int tok = gw; tok < T; tok += nw) {
        {
            const uint4 c = *(const uint4*)(PB + (size_t)tok * 768 + lane * 8);
            float v[8] = {bflo(c.x), bfhi(c.x), bflo(c.y), bfhi(c.y), bflo(c.z), bfhi(c.z), bflo(c.w), bfhi(c.w)};
            float ss = 0.f;
#pragma unroll
            for (int i = 0; i < 8; ++i) ss += v[i] * v[i];
            ss = wave_sum(ss);
            const float rs = rsqrtf(ss * (1.f / 512.f) + 1e-6f);
            const float4 g0 = *(const float4*)(gq + lane * 8), g1 = *(const float4*)(gq + lane * 8 + 4);
            uint4 w; w.x = pk2(v[0] * rs * g0.x, v[1] * rs * g0.y); w.y = pk2(v[2] * rs * g0.z, v[3] * rs * g0.w);
            w.z = pk2(v[4] * rs * g1.x, v[5] * rs * g1.y); w.w = pk2(v[6] * rs * g1.z, v[7] * rs * g1.w);
            *(uint4*)(CQ + (size_t)tok * 512 + lane * 8) = w;
        }
        if (j == 0) {
            const float4 c = *(const float4*)(CKR + (size_t)tok * 384 + lane * 4);
            float ss = c.x * c.x + c.y * c.y + c.z * c.z + c.w * c.w;
            ss = wave_sum(ss);
            const float rs = rsqrtf(ss * (1.f / 256.f) + 1e-6f);
            const float4 g = *(const float4*)(gl + lane * 4);
            uint2 w; w.x = pk2(c.x * rs * g.x, c.y * rs * g.y); w.y = pk2(c.z * rs * g.z, c.w * rs * g.w);
            *(uint2*)(CKV + (size_t)tok * 256 + lane * 4) = w;
            const int i = lane & 15, hg = lane >> 4;
            const float x1 = CKR[(size_t)tok * 384 + 256 + i], x2 = CKR[(size_t)tok * 384 + 272 + i];
            const float cs = rope[(size_t)tok * 32 + i], sn = rope[(size_t)tok * 32 + 16 + i];
            const bf16_t o1 = f2bf(x1 * cs - x2 * sn), o2 = f2bf(x2 * cs + x1 * sn);
            const int b = tok >> 13, s = tok & (S - 1);
#pragma unroll
            for (int hh = 0; hh < 3; ++hh) {
                bf16_t* kp = KF + ((size_t)(b * 12 + hg * 3 + hh) * S + s) * 96 + 64 + i;
                kp[0] = o1; kp[16] = o2;
            }
        }
    }
}

__device__ void rope_phase(const Params& p) {
    const int* pos = (const int*)p.in[2]; float* rope = (float*)(p.ws + WS_ROPE);
    const int tid_ = opaque_tid();
    for (int idx = blockIdx.x * NT + tid_; idx < T * 16; idx += gridDim.x * NT) {
        const int tok = idx >> 4, i = idx & 15;
        const float invf = powf(10000.f, -(float)i / 16.f);
        const float ang = (float)pos[tok] * invf;
        rope[(size_t)tok * 32 + i] = cosf(ang); rope[(size_t)tok * 32 + 16 + i] = sinf(ang);
    }
}

__device__ bool get_gemm_job(const Params& p, int ph, int jn, GemmJob& g) {
    char* ws = p.ws;
    bf16_t* WA = (bf16_t*)(ws + WS_WA); bf16_t* WF = (bf16_t*)(ws + WS_WF); bf16_t* H = (bf16_t*)(ws + WS_H); bf16_t* P = (bf16_t*)(ws + WS_P);
    bf16_t* LIN = (bf16_t*)(ws + WS_LIN); bf16_t* KMEM = (bf16_t*)(ws + WS_KMEM); bf16_t* VTMEM = (bf16_t*)(ws + WS_VTMEM); bf16_t* MEMN = (bf16_t*)(ws + WS_MEMN);
    g.M = T; g.e.o1 = nullptr; g.e.bias = nullptr; g.e.resid = nullptr; g.e.halo = nullptr; g.e.ldc = 0;
    const bool rw = ph < 25;
    const int L = rw ? (ph - 1) / 12 : 2 + (ph - 25) / 9, r = rw ? (ph - 1) % 12 : (ph - 25) % 9;
    const int r_wout = rw ? 8 : 5, r_gu = rw ? 10 : 7, r_down = rw ? 11 : 8;
    if (r == r_wout) { if (jn) return false; g.A = H; g.lda = 1024; g.W = WA + (rw ? A_WOUT : B_WOUT); g.K = 1024; g.N = 1024; g.kind = E_RESID; g.e.o0 = p.out; g.e.resid = (L == 0) ? p.in[0] : p.out; g.e.ldc = 1024; return true; }
    if (r == r_gu) { if (jn) return false; g.A = H; g.lda = 1024; g.W = WF + F_GU; g.K = 1024; g.N = 5632; g.kind = E_SWIGLU; g.e.o0 = P; g.e.ldc = 2816; return true; }
    if (r == r_down) { if (jn) return false; g.A = P; g.lda = 2816; g.W = WF + F_DOWN; g.K = 2816; g.N = 1024; g.kind = E_RESID; g.e.o0 = p.out; g.e.resid = p.out; g.e.ldc = 1024; return true; }
    if (r == 1 && jn == 1) { g.A = MEMN; g.lda = 1024; g.W = WA + (rw ? A_MKV : B_MKV); g.K = 1024; g.M = 1024; g.N = 512; g.kind = E_MEMKV; g.e.o0 = KMEM; g.e.o1 = VTMEM; return true; }
    if (rw) {
        const int i = L;
        if (r == 1 && jn == 0) { g.A = H; g.lda = 1024; g.W = WA + A_WIN; g.K = 1024; g.N = (i == 1) ? 2944 : 2816; g.kind = E_BF16; g.e.o0 = P; g.e.ldc = LDP; g.e.halo = (bf16_t*)(ws + WS_HALO); return true; }
        if (r == 3) {
            if (jn == 0) { g.A = LIN; g.lda = 320; g.W = WA + A_DEC; g.K = 64; g.N = 768; g.kind = E_DECAY; g.e.o0 = ws + WS_Z; g.e.bias = p.in[8] + (size_t)i * 768; g.e.ldc = 768; return true; }
            if (jn == 1) { g.A = LIN + 64; g.lda = 320; g.W = WA + A_AAA; g.K = 64; g.N = 768; g.kind = E_SIGB; g.e.o0 = ws + WS_Z + ZSZ; g.e.bias = p.in[10] + (size_t)i * 768; g.e.ldc = 768; return true; }
            if (jn == 2 && i == 1) { g.A = LIN + 256; g.lda = 320; g.W = WA + A_VUP; g.K = 64; g.N = 768; g.kind = E_SIGB; g.e.o0 = ws + WS_Z + 2 * ZSZ; g.e.bias = p.in[25]; g.e.ldc = 768; return true; }
            return false;
        }
        if (r == 7 && jn == 0) { g.A = LIN + 128; g.lda = 320; g.W = WA + A_GATE; g.K = 128; g.N = 768; g.kind = E_MULG; g.e.o0 = H; g.e.ldc = 1024; return true; }
        return false;
    }
    const int j = L - 2;
    if (r == 1) {
        if (jn == 0) { g.A = H; g.lda = 1024; g.W = WA + B_WIN; g.K = 1024; g.N = 768; g.kind = E_BF16; g.e.o0 = ws + WS_PROJB; g.e.ldc = 768; return true; }
        if (jn == 2 && j == 0) { g.A = (bf16_t*)(ws + WS_QFULL); g.lda = 1024; g.W = WA + B_KVD; g.K = 1024; g.N = 384; g.kind = E_F32; g.e.o0 = ws + WS_CKR; g.e.ldc = 384; return true; }
        return false;
    }
    if (r == 3) {
        if (jn == 0) { g.A = (bf16_t*)(ws + WS_CQ); g.lda = 512; g.W = WA + B_QUP; g.K = 512; g.N = 1152; g.kind = E_BF16; g.e.o0 = ws + WS_QFULL; g.e.ldc = 1152; return true; }
        if (jn == 1 && j == 0) { g.A = (bf16_t*)(ws + WS_CKV); g.lda = 256; g.W = WA + B_KVU; g.K = 256; g.N = 1536; g.kind = E_KV; g.e.o0 = ws + WS_KFULL; g.e.o1 = ws + WS_VT; return true; }
        return false;
    }
    return false;
}

__device__ void run_phase(const Params& p, int ph, char* smem) {
    char* ws = p.ws;
    bf16_t* H = (bf16_t*)(ws + WS_H);
    const float MEMSCL = 0.125f * 1.4426950408889634f, MLASCL = 0.10206207261596575f * 1.4426950408889634f;
    int rot = 0;
    const bool rw = ph >= 1 && ph < 25, mla = ph >= 25 && ph < 43;
    const int L = rw ? (ph - 1) / 12 : (mla ? 2 + (ph - 25) / 9 : 0), r = rw ? (ph - 1) % 12 : (mla ? (ph - 25) % 9 : -1);
    {
        const float* x = nullptr; int nrows = T; const float* g1 = nullptr; bf16_t* o1 = H; const float* g2 = nullptr; bf16_t* o2 = nullptr; float* of = nullptr;
        if (ph == 0) { x = p.in[1]; nrows = 1024; g1 = p.in[3]; o1 = (bf16_t*)(ws + WS_MEMN); }
        else if (ph == 43) { x = p.out; g1 = p.in[39]; of = p.out; }
        else if (rw && r == 0) { x = (L == 0) ? p.in[0] : p.out; g1 = p.in[4] + (size_t)L * 1024; }
        else if (rw && r == 9) { x = p.out; g1 = p.in[19] + (size_t)L * 1024; }
        else if (mla && r == 0) { x = p.out; g1 = p.in[30] + (size_t)(L - 2) * 1024; if (L == 2) { g2 = p.in[26]; o2 = (bf16_t*)(ws + WS_QFULL); } }
        else if (mla && r == 6) { x = p.out; g1 = p.in[36] + (size_t)(L - 2) * 1024; }
        if (x) rmsnorm_phase(x, nrows, g1, o1, g2, o2, of);
    }
    if (ph == 0) rope_phase(p);
    int cvb = blockIdx.x, cVG = gridDim.x;
    {
        int kind = -1, CL = 0;
        if (ph == 0) { kind = 0; CL = 0; }
        else if ((rw || mla) && r == 0) { kind = 1; CL = L; }
        else if (rw && r == 9) { kind = 0; CL = L + 1; }
        else if (mla && r == 6 && L == 2) { kind = 0; CL = 3; }
        const int GG = gridDim.x; const bool split = false;

        if (split && GG == 512) { const int b_ = blockIdx.x; cvb = (b_ >= 192 && b_ < 256) ? b_ - 192 : (b_ >= 448 ? b_ - 384 : -1); cVG = 128; }
        else { cvb = split ? (int)blockIdx.x - 192 : (int)blockIdx.x; cVG = split ? GG - 192 : GG; }
        if (kind >= 0 && cvb >= 0) { ConvJob c; for (int idx = 0; get_conv_job(p, kind, CL, idx, c); ++idx) run_conv(c, rot, smem, cvb, cVG); }
    }
    { GemmJob g; for (int jn = 0; jn < 3; ++jn) if (get_gemm_job(p, ph, jn, g)) { gemm_job(g, rot, smem); } }
    if ((rw || mla) && r == 3) {
        const bf16_t* Q = rw ? (const bf16_t*)(ws + WS_P) : (const bf16_t*)(ws + WS_PROJB);
        attn_phase<64, false>(Q, rw ? LDP : 768, rw ? 2560 : 512, (const bf16_t*)(ws + WS_KMEM), 256 * 64, (const bf16_t*)(ws + WS_VTMEM), 64 * 256, 256, 4, 256, nullptr, MEMSCL, H, 1024, 768, rot, smem, cvb, cVG);
    }
    if (mla && r == 4)
        attn_phase<96, true>((const bf16_t*)(ws + WS_QFULL), 1152, 0, (const bf16_t*)(ws + WS_KFULL), (size_t)S * 96, (const bf16_t*)(ws + WS_VT), (size_t)64 * S, S, 12, S, (const float*)(ws + WS_ROPE), MLASCL, H, 1024, 0, rot, smem, blockIdx.x, gridDim.x);
    if (rw && r == 2) lora_in_phase(p, L);
    if (rw && r == 4) prep_phase(p, L);
    if (rw && r == 5 && (blockIdx.x < 192 || cVG == (int)gridDim.x)) scan_phase(p, smem);
    if (rw && r == 6) post_phase(p, L);
    if (mla && r == 2) subnorm_phase(p, L - 2);
}

#define XB_TMO      128
#define XB_XCNT(j)  (256  + 64 * (j))
#define XB_XSUB(j)  (1280 + 64 * (j))
#define XB_XGEN(j)  (2304 + 64 * (j))
#define XB_TOP      3328
#define XB_TOPGEN   3392
#define XCD_BAR_WORDS 3456
#define XB_SPIN_CAP (1u << 18)
__device__ __forceinline__ unsigned xb_ld(unsigned* p)              { return __hip_atomic_load(p, __ATOMIC_RELAXED, __HIP_MEMORY_SCOPE_AGENT); }
__device__ __forceinline__ unsigned xb_add(unsigned* p, unsigned v) { return __hip_atomic_fetch_add(p, v, __ATOMIC_RELAXED, __HIP_MEMORY_SCOPE_AGENT); }
__device__ __forceinline__ unsigned xb_xcc_id() { return (unsigned)__builtin_amdgcn_s_getreg((3 << 11) | 20) & 0xFu; }
#define XB_SPIN(cond, bar) do { unsigned _sp = 0; while (cond) { __builtin_amdgcn_s_sleep(1); \
    if ((++_sp & 255u) == 0u) { if (xb_ld(&(bar)[XB_TMO])) break; if (_sp > XB_SPIN_CAP) { atomicAdd(&(bar)[XB_TMO], 1u); break; } } } } while (0)
struct XcdBarrier { unsigned* bar; unsigned x; volatile LAS unsigned* st; };
__device__ __forceinline__ XcdBarrier xcd_barrier_post(unsigned* bar, volatile LAS unsigned* st) {
    XcdBarrier b; b.bar = bar; b.x = xb_xcc_id(); b.st = st;
    if (threadIdx.x == 0) (void)xb_add(&bar[XB_XCNT(b.x)], 1u);
    return b;
}
__device__ __forceinline__ void xcd_barrier_complete(unsigned* bar, unsigned x, unsigned& nloc, unsigned& nx) {
    const unsigned G = gridDim.x * gridDim.y * gridDim.z;
    unsigned sum, cnt, mine, sp = 0u;
    for (;;) {
        sum = 0u; cnt = 0u; mine = 0u;
#pragma unroll
        for (unsigned j = 0; j < 16; ++j) { const unsigned c = xb_ld(&bar[XB_XCNT(j)]); sum += c; cnt += (c > 0u) ? 1u : 0u; mine = (j == x) ? c : mine; }
        if (sum == G) break;
        __builtin_amdgcn_s_sleep(1);
        if ((++sp & 255u) == 0u) { if (xb_ld(&bar[XB_TMO])) break; if (sp > XB_SPIN_CAP) { atomicAdd(&bar[XB_TMO], 1u); break; } }
    }
    nloc = mine > 0u ? mine : 1u; nx = cnt > 0u ? cnt : 1u;
}
__device__ __forceinline__ void xcd_barrier(const XcdBarrier& b) {
    asm volatile("s_waitcnt vmcnt(0)" ::: "memory");
    __syncthreads();
    if (threadIdx.x == 0) {
        unsigned* bar = b.bar;
        __builtin_amdgcn_s_waitcnt(0);
        unsigned nloc = b.st[0], nx = b.st[1];
        if (nloc == 0u) { xcd_barrier_complete(bar, b.x, nloc, nx); b.st[0] = nloc; b.st[1] = nx; }
        const unsigned old = xb_add(&bar[XB_XSUB(b.x)], 1u);
        const unsigned gen = old / nloc;
        if (old + 1u == (gen + 1u) * nloc) {
            __builtin_amdgcn_fence(__ATOMIC_RELEASE, "agent");
            asm volatile("s_waitcnt vmcnt(0)" ::: "memory");
            const unsigned og = xb_add(&bar[XB_TOP], 1u);
            const unsigned tg = og / nx;
            if (og + 1u == (tg + 1u) * nx) xb_add(&bar[XB_TOPGEN], 1u);
            else XB_SPIN(xb_ld(&bar[XB_TOPGEN]) == tg, bar);
            __builtin_amdgcn_fence(__ATOMIC_ACQUIRE, "agent");
            xb_add(&bar[XB_XGEN(b.x)], 1u);
            asm volatile("s_waitcnt vmcnt(0)" ::: "memory");
        } else {
            XB_SPIN(xb_ld(&bar[XB_XGEN(b.x)]) == gen, bar);
            __builtin_amdgcn_fence(__ATOMIC_ACQUIRE, "agent");
            asm volatile("s_waitcnt vmcnt(0)" ::: "memory");
        }
    }
    __syncthreads();
}

__global__ void __launch_bounds__(NT) yoco_mega(Params p) {
    extern __shared__ __attribute__((aligned(16))) char smem[];
    cg::grid_group grid = cg::this_grid();
    volatile LAS unsigned* st = (volatile LAS unsigned*)((LAS char*)smem + LDS_MAIN);
    if (threadIdx.x == 0) { st[0] = 0u; st[1] = 0u; }
    __syncthreads();
    const XcdBarrier xb = xcd_barrier_post((unsigned*)(p.ws + WS_BAR), st);
    if (p.ph_lo < 0) grid.sync();
    for (int ph = p.ph_lo; ph < p.ph_hi; ++ph) {
        int nrep = 1;
#if PROBE_DUP
        {
            const bool rw = ph >= 1 && ph < 25, mla = ph >= 25 && ph < 43;
            const int r = rw ? (ph - 1) % 12 : (mla ? (ph - 25) % 9 : -1);
            if ((PROBE_DUP & 1) && rw && r == 5) nrep = 2;
            if ((PROBE_DUP & 2) && ((rw && r == 10) || (mla && r == 7))) nrep = 2;
            if ((PROBE_DUP & 4) && mla && r == 4) nrep = 2;
            if ((PROBE_DUP & 8) && rw && r == 3) nrep = 2;
            if ((PROBE_DUP & 16) && ((rw && (r == 0 || r == 9)) || (mla && (r == 0 || r == 6)))) nrep = 2;
            if ((PROBE_DUP & 32) && ((rw && r == 2) || (mla && (r == 2 || r == 3)))) nrep = 2;
        }
#endif
        for (int rep = 0; rep < nrep; ++rep) {
            run_phase(p, ph, smem);
            if (rep + 1 < nrep || ph + 1 < p.ph_hi) xcd_barrier(xb);
        }
    }
}

#ifndef PROBE_DUP
#define PROBE_DUP 0
#endif
#ifndef MULTI_LAUNCH
#define MULTI_LAUNCH 0
#endif

extern "C" void kernel_launch(void* const* d_in, const int* in_sizes, int n_in, void* d_out, int out_size, void* d_ws, size_t ws_size, hipStream_t stream) {
    static int grid_blocks = 0;
    if (!grid_blocks) {
        int dev = 0, cus = 0, per_cu = 0;
        hipGetDevice(&dev);
        hipDeviceGetAttribute(&cus, hipDeviceAttributeMultiprocessorCount, dev);
        hipFuncSetAttribute((const void*)yoco_mega, hipFuncAttributeMaxDynamicSharedMemorySize, LDS_BYTES);
        hipOccupancyMaxActiveBlocksPerMultiprocessor(&per_cu, (const void*)yoco_mega, NT, LDS_BYTES);
        if (per_cu < 1) per_cu = 1;
        if (per_cu > 1) per_cu = 1;
        grid_blocks = cus * per_cu;
        if (ws_size < WS_END) fprintf(stderr, "kernel_launch: workspace too small: %zu < %zu\n", ws_size, (size_t)WS_END);
        if (n_in != 40) fprintf(stderr, "kernel_launch: expected 40 inputs, got %d\n", n_in);
    }
    Params p{};
    for (int i = 0; i < 40; ++i) p.in[i] = (const float*)d_in[i];
    p.out = (float*)d_out; p.ws = (char*)d_ws;
#if MULTI_LAUNCH
    for (int ph = 0; ph < 44; ++ph) {
        p.ph_lo = ph; p.ph_hi = ph + 1;
        hipLaunchKernelGGL(yoco_mega, dim3(grid_blocks), dim3(NT), LDS_BYTES, stream, p);
    }
#else
    p.ph_lo = 0; p.ph_hi = 44;
    (void)hipMemsetAsync((char*)d_ws + WS_BAR, 0, 16384, stream);
    void* args[] = {&p};
    hipError_t e = hipLaunchCooperativeKernel((const void*)yoco_mega, dim3(grid_blocks), dim3(NT), args, LDS_BYTES, stream);
    if (e != hipSuccess) fprintf(stderr, "cooperative launch failed: %s (grid %d)\n", hipGetErrorString(e), grid_blocks);
#endif
}
```
